# Optimizing an MI355X kernel written in HIP

```python
import math
import jax, jax.numpy as jnp
from jax import lax
import numpy as np

D_MODEL = 1024
BATCH = 16
SEQ = 4096
DEPTH = 1
DEC_BATCH = 8
DEC_SEQ = 32
PAST_LEN = 1024

CHUNK = 64
WINDOW = 128
WINDOW_CHUNKS = WINDOW // CHUNK
ATTN_WIDTH = D_MODEL // 2
SSM_WIDTH = D_MODEL - ATTN_WIDTH
HEAD_DIM = 64
N_HEADS = ATTN_WIDTH // HEAD_DIM
N_KV_HEADS = 2
GQA_REP = N_HEADS // N_KV_HEADS
SSM_CH = 16
SSM_GROUPS = SSM_WIDTH // SSM_CH
SSM_STATE = 64
D_FF = -(-8 * D_MODEL // (3 * 256)) * 256
ROPE_THETA = 10000.0
EPS = 1e-6
Q_COLS = N_HEADS * HEAD_DIM
KV_COLS = N_KV_HEADS * HEAD_DIM
IN_COLS = Q_COLS + 2 * KV_COLS + SSM_WIDTH

kernel_name = "hybrid_streaming_s5_swa_step"


def _rmsnorm(x, g):
    xf = x.astype(jnp.float32)
    y = xf * lax.rsqrt(jnp.mean(xf * xf, axis=-1, keepdims=True) + EPS)
    return (y * g.astype(jnp.float32)).astype(x.dtype)


def _rope(x, pos):
    half = HEAD_DIM // 2
    inv = ROPE_THETA ** (-jnp.arange(half, dtype=jnp.float32) * 2.0 / HEAD_DIM)
    ang = pos.astype(jnp.float32)[:, None] * inv[None, :]
    cos = jnp.cos(ang)[None, :, None, :]
    sin = jnp.sin(ang)[None, :, None, :]
    xf = x.astype(jnp.float32)
    x1, x2 = xf[..., :half], xf[..., half:]
    return jnp.concatenate([x1 * cos - x2 * sin, x2 * cos + x1 * sin], axis=-1).astype(x.dtype)


def _sink_attention(q, k, v, valid, sinks):
    s = jnp.einsum('bnqgrd,bnkgd->bngrqk', q.astype(jnp.float32), k.astype(jnp.float32)) * (HEAD_DIM ** -0.5)
    s = jnp.where(valid[None, :, None, None, None, :], s, -jnp.inf)
    sink = sinks.astype(jnp.float32).reshape(N_KV_HEADS, GQA_REP)[None, None, :, :, None]
    m = jnp.maximum(jnp.max(s, axis=-1), sink)
    p = jnp.exp(s - m[..., None])
    p = p / (jnp.sum(p, axis=-1) + jnp.exp(sink - m))[..., None]
    o = jnp.einsum('bngrqk,bnkgd->bnqgrd', p, v.astype(jnp.float32))
    return o.astype(q.dtype)


def _swa_prompt(q, k, v, sinks):
    bsz, s = q.shape[0], q.shape[1]
    nc = s // CHUNK
    qb = q.reshape(bsz, nc, CHUNK, N_KV_HEADS, GQA_REP, HEAD_DIM)

    def band(t):
        tp = jnp.pad(t, ((0, 0), (WINDOW, 0), (0, 0), (0, 0)))
        tp = tp.reshape(bsz, nc + WINDOW_CHUNKS, CHUNK, N_KV_HEADS, HEAD_DIM)
        return jnp.concatenate([tp[:, j:j + nc] for j in range(WINDOW_CHUNKS + 1)], axis=2)

    key_chunk = (jnp.arange(nc)[:, None]
                 + jnp.repeat(jnp.arange(WINDOW_CHUNKS + 1), CHUNK)[None, :] - WINDOW_CHUNKS)
    o = _sink_attention(qb, band(k), band(v), key_chunk >= 0, sinks)
    return o.reshape(bsz, s, ATTN_WIDTH)


def _swa_sample(q, k, v, past_k, past_v, sinks):
    bsz, s = q.shape[0], q.shape[1]
    qb = q.reshape(bsz, 1, s, N_KV_HEADS, GQA_REP, HEAD_DIM)
    kb = jnp.concatenate([past_k.astype(k.dtype), k], axis=1)[:, None]
    vb = jnp.concatenate([past_v.astype(v.dtype), v], axis=1)[:, None]
    valid = jnp.ones((1, kb.shape[2]), dtype=bool)
    o = _sink_attention(qb, kb, vb, valid, sinks)
    return o.reshape(bsz, s, ATTN_WIDTH)


def _ssm_combine(left, right):
    a1, b1 = left
    a2, b2 = right
    return a1 * a2, a2 * b1 + b2


def _s5(u, h0, a_re, a_im, log_dt, b_re, b_im, c_re, c_im, d_skip):
    bsz, s = u.shape[0], u.shape[1]
    f32 = jnp.float32
    uf = u.astype(f32).reshape(bsz, s, SSM_GROUPS, SSM_CH)
    lam = lax.complex(a_re.astype(f32), a_im.astype(f32))
    dt = jnp.exp(log_dt.astype(f32))[:, None]
    lam_bar = jnp.exp(lam * dt)
    b_bar = ((lam_bar - 1.0) / lam)[:, :, None] * lax.complex(b_re.astype(f32), b_im.astype(f32))
    bu = jnp.einsum('gph,bsgh->bsgp', b_bar, uf.astype(jnp.complex64))
    a = jnp.broadcast_to(lam_bar[None, None], (1, s, SSM_GROUPS, SSM_STATE))
    a_cum, xs = lax.associative_scan(_ssm_combine, (a, bu), axis=1)
    if h0 is not None:
        xs = xs + a_cum * h0[:, None]
    c = lax.complex(c_re.astype(f32), c_im.astype(f32))
    y = jnp.einsum('ghp,bsgp->bsgh', c, xs).real + d_skip.astype(f32).reshape(SSM_GROUPS, SSM_CH) * uf
    return y.reshape(bsz, s, SSM_WIDTH), xs[:, -1]


def _layer(x, c, pos, past_k, past_v, h0, lw):
    bsz, s = x.shape[0], x.shape[1]
    mod = jax.nn.silu(c) @ lw['w_ada'] + lw['b_ada']
    sh1, sc1, g1, sh2, sc2, g2 = jnp.split(mod[:, None, :], 6, axis=-1)

    h = _rmsnorm(x, lw['ln1_g']) * (1.0 + sc1) + sh1
    proj = h @ lw['w_in']
    q, k, v, u = jnp.split(proj, [Q_COLS, Q_COLS + KV_COLS, Q_COLS + 2 * KV_COLS], axis=-1)
    q = _rope(_rmsnorm(q.reshape(bsz, s, N_HEADS, HEAD_DIM), lw['q_norm_g']), pos)
    k = _rope(_rmsnorm(k.reshape(bsz, s, N_KV_HEADS, HEAD_DIM), lw['k_norm_g']), pos)
    v = v.reshape(bsz, s, N_KV_HEADS, HEAD_DIM)
    if past_k is None:
        attn = _swa_prompt(q, k, v, lw['attn_sinks'])
        k_rows, v_rows = k[:, -WINDOW:], v[:, -WINDOW:]
    else:
        attn = _swa_sample(q, k, v, past_k, past_v, lw['attn_sinks'])
        k_rows, v_rows = k, v

    ssm_y, h_last = _s5(u, h0, lw['ssm_A_re'], lw['ssm_A_im'], lw['ssm_log_dt'], lw['ssm_B_re'],
                        lw['ssm_B_im'], lw['ssm_C_re'], lw['ssm_C_im'], lw['ssm_D'])
    g = jax.nn.gelu(ssm_y)
    ssm_o = (g * jax.nn.sigmoid(g @ lw['ssm_glu_w'].astype(jnp.float32) + lw['ssm_glu_b'].astype(jnp.float32))).astype(x.dtype)

    merged = jnp.concatenate([_rmsnorm(attn, lw['attn_out_g']), _rmsnorm(ssm_o, lw['ssm_out_g'])], axis=-1)
    x = x + g1 * (merged @ lw['w_out'])

    h2 = _rmsnorm(x, lw['ln2_g']) * (1.0 + sc2) + sh2
    ff = (jax.nn.silu(h2 @ lw['w_gate']) * (h2 @ lw['w_up'])) @ lw['w_down']
    x = x + g2 * ff
    state = jnp.stack([h_last.real, h_last.imag], axis=-1)
    return x, k_rows, v_rows, state


def setup_inputs(seed: int = 0) -> dict:
    key = jax.random.key(seed)
    ks = iter(jax.random.split(key, 40))
    f32 = jnp.float32
    nrm = lambda shape, scale: jax.random.normal(next(ks), shape, f32) * scale
    gain = lambda shape: 1.0 + nrm(shape, 0.02)
    n_idx = jnp.arange(SSM_STATE, dtype=f32)
    return {
        "x_prompt": nrm((BATCH, SEQ, D_MODEL), 1.0),
        "x_sample": nrm((DEC_BATCH, DEC_SEQ, D_MODEL), 1.0),
        "cache_k": nrm((DEPTH, DEC_BATCH, WINDOW, N_KV_HEADS, HEAD_DIM), 1.0),
        "cache_v": nrm((DEPTH, DEC_BATCH, WINDOW, N_KV_HEADS, HEAD_DIM), 1.0),
        "state_ssm": nrm((DEPTH, DEC_BATCH, SSM_GROUPS, SSM_STATE, 2), 0.5),
        "c_prompt": nrm((BATCH, D_MODEL), 1.0),
        "c_sample": nrm((DEC_BATCH, D_MODEL), 1.0),
        "w_ada": nrm((DEPTH, D_MODEL, 6 * D_MODEL), 0.5 * D_MODEL ** -0.5),
        "b_ada": nrm((DEPTH, 6 * D_MODEL), 0.02),
        "ln1_g": gain((DEPTH, D_MODEL)),
        "w_in": nrm((DEPTH, D_MODEL, IN_COLS), D_MODEL ** -0.5),
        "q_norm_g": gain((DEPTH, HEAD_DIM)),
        "k_norm_g": gain((DEPTH, HEAD_DIM)),
        "attn_sinks": nrm((DEPTH, N_HEADS), 0.5),
        "ssm_A_re": -0.5 + nrm((DEPTH, SSM_GROUPS, SSM_STATE), 0.01),
        "ssm_A_im": jnp.pi * n_idx + nrm((DEPTH, SSM_GROUPS, SSM_STATE), 0.01),
        "ssm_log_dt": jax.random.uniform(next(ks), (DEPTH, SSM_GROUPS), f32, math.log(1e-3), math.log(1e-1)),
        "ssm_B_re": nrm((DEPTH, SSM_GROUPS, SSM_STATE, SSM_CH), (2 * SSM_CH) ** -0.5),
        "ssm_B_im": nrm((DEPTH, SSM_GROUPS, SSM_STATE, SSM_CH), (2 * SSM_CH) ** -0.5),
        "ssm_C_re": nrm((DEPTH, SSM_GROUPS, SSM_CH, SSM_STATE), SSM_STATE ** -0.5),
        "ssm_C_im": nrm((DEPTH, SSM_GROUPS, SSM_CH, SSM_STATE), SSM_STATE ** -0.5),
        "ssm_D": nrm((DEPTH, SSM_WIDTH), 1.0),
        "ssm_glu_w": nrm((DEPTH, SSM_WIDTH, SSM_WIDTH), SSM_WIDTH ** -0.5),
        "ssm_glu_b": nrm((DEPTH, SSM_WIDTH), 0.02),
        "attn_out_g": gain((DEPTH, ATTN_WIDTH)),
        "ssm_out_g": gain((DEPTH, SSM_WIDTH)),
        "w_out": nrm((DEPTH, D_MODEL, D_MODEL), D_MODEL ** -0.5),
        "ln2_g": gain((DEPTH, D_MODEL)),
        "w_gate": nrm((DEPTH, D_MODEL, D_FF), D_MODEL ** -0.5),
        "w_up": nrm((DEPTH, D_MODEL, D_FF), D_MODEL ** -0.5),
        "w_down": nrm((DEPTH, D_FF, D_MODEL), D_FF ** -0.5),
    }


def reference(x_prompt, x_sample, cache_k, cache_v, state_ssm, c_prompt, c_sample,
              w_ada, b_ada, ln1_g, w_in, q_norm_g, k_norm_g, attn_sinks,
              ssm_A_re, ssm_A_im, ssm_log_dt, ssm_B_re, ssm_B_im, ssm_C_re, ssm_C_im,
              ssm_D, ssm_glu_w, ssm_glu_b, attn_out_g, ssm_out_g, w_out,
              ln2_g, w_gate, w_up, w_down):
    y_prompt, y_sample = x_prompt, x_sample
    pos_prompt = jnp.arange(x_prompt.shape[1])
    pos_sample = PAST_LEN + jnp.arange(x_sample.shape[1])
    kp_l, vp_l, hp_l, ks_l, vs_l, hs_l = [], [], [], [], [], []
    for l in range(DEPTH):
        lw = dict(w_ada=w_ada[l], b_ada=b_ada[l], ln1_g=ln1_g[l], w_in=w_in[l],
                  q_norm_g=q_norm_g[l], k_norm_g=k_norm_g[l], attn_sinks=attn_sinks[l],
                  ssm_A_re=ssm_A_re[l], ssm_A_im=ssm_A_im[l], ssm_log_dt=ssm_log_dt[l],
                  ssm_B_re=ssm_B_re[l], ssm_B_im=ssm_B_im[l], ssm_C_re=ssm_C_re[l],
                  ssm_C_im=ssm_C_im[l], ssm_D=ssm_D[l], ssm_glu_w=ssm_glu_w[l],
                  ssm_glu_b=ssm_glu_b[l], attn_out_g=attn_out_g[l], ssm_out_g=ssm_out_g[l],
                  w_out=w_out[l], ln2_g=ln2_g[l], w_gate=w_gate[l], w_up=w_up[l],
                  w_down=w_down[l])
        y_prompt, kp, vp, hp = _layer(y_prompt, c_prompt, pos_prompt, None, None, None, lw)
        h0 = lax.complex(state_ssm[l, ..., 0].astype(jnp.float32), state_ssm[l, ..., 1].astype(jnp.float32))
        y_sample, ksn, vsn, hsn = _layer(y_sample, c_sample, pos_sample, cache_k[l], cache_v[l], h0, lw)
        kp_l.append(kp); vp_l.append(vp); hp_l.append(hp)
        ks_l.append(ksn); vs_l.append(vsn); hs_l.append(hsn)
    return (y_prompt, y_sample, jnp.stack(kp_l), jnp.stack(vp_l), jnp.stack(hp_l),
            jnp.stack(ks_l), jnp.stack(vs_l), jnp.stack(hs_l))
```

```cpp
#include <hip/hip_runtime.h>
#include <cstdio>
#include <cstdint>
#include <cmath>

namespace nv {
constexpr int D = 1024, NB = 16, SEQ = 4096, DB = 8, DS = 32, PAST = 1024;
constexpr int MP = NB * SEQ, MS = DB * DS, M = MP + MS;
constexpr int NIN = 1280, FF = 2816, NMOD = 6 * D;
constexpr float EPS = 1e-6f;
constexpr size_t O_Y = 0, O_YS = (size_t)MP * D, O_KP = O_YS + (size_t)MS * D, O_VP = O_KP + 262144, O_HP = O_VP + 262144,
                 O_KS = O_HP + 65536, O_VS = O_KS + 32768, O_HS = O_VS + 32768;

struct P {
    const float* in[31];
    float* out;
    float *mod, *r1, *r2, *proj, *attn, *g, *so, *merged, *act;
};

__device__ __forceinline__ int modrow(int m) { return m < MP ? m / SEQ : NB + (m - MP) / DS; }
__device__ __forceinline__ int posof(int m) { return m < MP ? m % SEQ : PAST + (m - MP) % DS; }
__device__ __forceinline__ const float* xrow(const P& p, int m) { return m < MP ? p.in[0] + (size_t)m * D : p.in[1] + (size_t)(m - MP) * D; }
__device__ __forceinline__ float silu(float v) { return v / (1.f + expf(-v)); }
__device__ __forceinline__ float wsum(float v) {
#pragma unroll
    for (int o = 1; o < 64; o <<= 1) v += __shfl_xor(v, o);
    return v;
}
__device__ __forceinline__ float wmax(float v) {
#pragma unroll
    for (int o = 1; o < 64; o <<= 1) v = fmaxf(v, __shfl_xor(v, o));
    return v;
}

__global__ void k_mod(P p) {
    int idx = blockIdx.x * 256 + threadIdx.x; if (idx >= 24 * NMOD) return;
    int r = idx / NMOD, c = idx % NMOD;
    const float* cv = r < NB ? p.in[5] + (size_t)r * D : p.in[6] + (size_t)(r - NB) * D;
    const float* w = p.in[7];
    float acc = 0.f;
    for (int k = 0; k < D; ++k) acc += silu(cv[k]) * w[(size_t)k * NMOD + c];
    p.mod[idx] = acc + p.in[8][c];
}
__global__ void k_rowrms(P p, int which) {
    int m = blockIdx.x * 4 + (threadIdx.x >> 6), lane = threadIdx.x & 63; if (m >= M) return;
    const float* x = which == 0 ? xrow(p, m) : p.out + (size_t)m * D;
    float s = 0.f;
    for (int k = lane; k < D; k += 64) s += x[k] * x[k];
    s = wsum(s);
    if (lane == 0) (which == 0 ? p.r1 : p.r2)[m] = rsqrtf(s / D + EPS);
}

template <class AF, class EF>
__global__ void __launch_bounds__(256) k_gemm(AF af, const float* __restrict__ W, int K, int N, EF ef) {
    __shared__ float sA[16][68], sB[16][68];
    const int tx = threadIdx.x & 15, ty = threadIdx.x >> 4, m0 = blockIdx.y * 64, n0 = blockIdx.x * 64;
    float acc[4][4] = {};
    for (int k0 = 0; k0 < K; k0 += 16) {
        for (int i = threadIdx.x; i < 1024; i += 256) {
            int kk = i & 15, mm = i >> 4; sA[kk][mm] = af(m0 + mm, k0 + kk);
            int nn = i & 63, kb = i >> 6; sB[kb][nn] = W[(size_t)(k0 + kb) * N + n0 + nn];
        }
        __syncthreads();
#pragma unroll
        for (int kk = 0; kk < 16; ++kk) {
            float a[4], b[4];
#pragma unroll
            for (int i = 0; i < 4; ++i) { a[i] = sA[kk][ty * 4 + i]; b[i] = sB[kk][tx * 4 + i]; }
#pragma unroll
            for (int i = 0; i < 4; ++i)
#pragma unroll
                for (int j = 0; j < 4; ++j) acc[i][j] += a[i] * b[j];
        }
        __syncthreads();
    }
#pragma unroll
    for (int i = 0; i < 4; ++i)
#pragma unroll
        for (int j = 0; j < 4; ++j) ef(m0 + ty * 4 + i, n0 + tx * 4 + j, acc[i][j]);
}
struct AF_norm1 { P p; __device__ float operator()(int m, int k) const { int mr = modrow(m); const float* md = p.mod + (size_t)mr * NMOD;
    return xrow(p, m)[k] * p.r1[m] * p.in[9][k] * (1.f + md[D + k]) + md[k]; } };
struct AF_norm2 { P p; __device__ float operator()(int m, int k) const { int mr = modrow(m); const float* md = p.mod + (size_t)mr * NMOD;
    return p.out[(size_t)m * D + k] * p.r2[m] * p.in[27][k] * (1.f + md[4 * D + k]) + md[3 * D + k]; } };
struct AF_plain { const float* A; size_t ld; __device__ float operator()(int m, int k) const { return A[(size_t)m * ld + k]; } };
struct EF_store { float* C; size_t ld; __device__ void operator()(int m, int n, float v) const { C[(size_t)m * ld + n] = v; } };
struct EF_glu { P p; __device__ void operator()(int m, int n, float v) const { float g = p.g[(size_t)m * 512 + n]; p.so[(size_t)m * 512 + n] = g / (1.f + expf(-(v + p.in[23][n]))); } };
struct EF_res1 { P p; __device__ void operator()(int m, int n, float v) const { p.out[(size_t)m * D + n] = xrow(p, m)[n] + p.mod[(size_t)modrow(m) * NMOD + 2 * D + n] * v; } };
struct EF_gate { P p; __device__ void operator()(int m, int n, float v) const { p.act[(size_t)m * FF + n] = silu(v); } };
struct EF_up { P p; __device__ void operator()(int m, int n, float v) const { p.act[(size_t)m * FF + n] *= v; } };
struct EF_res2 { P p; __device__ void operator()(int m, int n, float v) const { p.out[(size_t)m * D + n] += p.mod[(size_t)modrow(m) * NMOD + 5 * D + n] * v; } };

__global__ void k_qkrope(P p) {
    int w = blockIdx.x * 4 + (threadIdx.x >> 6), lane = threadIdx.x & 63; if (w >= M * 10) return;
    int m = w / 10, hh = w % 10;
    float* v = p.proj + (size_t)m * NIN + hh * 64;
    float x = v[lane];
    float r = rsqrtf(wsum(x * x) / 64.f + EPS);
    float y = x * r * (hh < 8 ? p.in[11] : p.in[12])[lane];
    int i = lane & 31; double ang = (double)posof(m) * pow(10000.0, -(double)i / 32.0);
    float cs = (float)cos(ang), sn = (float)sin(ang);
    float other = __shfl_xor(y, 32);
    float o = lane < 32 ? y * cs - other * sn : y * cs + other * sn;
    v[lane] = o;
    if (hh >= 8) {
        int kv = hh - 8; float vv = p.proj[(size_t)m * NIN + 640 + kv * 64 + lane];
        if (m < MP) { int b = m / SEQ, t = m % SEQ; if (t >= SEQ - 128) { size_t off = (((size_t)b * 128 + (t - (SEQ - 128))) * 2 + kv) * 64 + lane; p.out[O_KP + off] = o; p.out[O_VP + off] = vv; } }
        else { size_t off = ((size_t)(m - MP) * 2 + kv) * 64 + lane; p.out[O_KS + off] = o; p.out[O_VS + off] = vv; }
    }
}
__global__ void __launch_bounds__(64) k_attn(P p) {
    __shared__ float sp[192]; __shared__ float sq[64];
    int m = blockIdx.x / 8, h = blockIdx.x % 8, kv = h / 4, lane = threadIdx.x;
    sq[lane] = p.proj[(size_t)m * NIN + h * 64 + lane];
    __syncthreads();
    int nk; int b, t;
    if (m < MP) { b = m / SEQ; t = m % SEQ; int c = t / 64; int c0 = c - 2 < 0 ? 0 : c - 2; nk = (c - c0 + 1) * 64; }
    else { b = (m - MP) / DS; t = (m - MP) % DS; nk = 160; }
    float sink = p.in[13][h];
    float sv[3]; float mx = sink;
#pragma unroll
    for (int j = 0; j < 3; ++j) { int k = lane + 64 * j; sv[j] = -INFINITY;
        if (k < nk) { const float* kp;
            if (m < MP) { int c = t / 64, c0 = c - 2 < 0 ? 0 : c - 2; kp = p.proj + ((size_t)b * SEQ + c0 * 64 + k) * NIN + 512 + kv * 64; }
            else if (k < 128) kp = p.in[2] + (((size_t)b * 128 + k) * 2 + kv) * 64;
            else kp = p.proj + ((size_t)MP + b * DS + (k - 128)) * NIN + 512 + kv * 64;
            float s = 0.f; for (int d = 0; d < 64; ++d) s += sq[d] * kp[d]; sv[j] = s * 0.125f; }
        mx = fmaxf(mx, sv[j]); }
    mx = wmax(mx);
    float sum = 0.f;
#pragma unroll
    for (int j = 0; j < 3; ++j) { float e = (lane + 64 * j < nk) ? expf(sv[j] - mx) : 0.f; sp[lane + 64 * j] = e; sum += e; }
    sum = wsum(sum) + expf(sink - mx);
    __syncthreads();
    float o = 0.f;
    for (int k = 0; k < nk; ++k) { const float* vp;
        if (m < MP) { int c = t / 64, c0 = c - 2 < 0 ? 0 : c - 2; vp = p.proj + ((size_t)b * SEQ + c0 * 64 + k) * NIN + 640 + kv * 64; }
        else if (k < 128) vp = p.in[3] + (((size_t)b * 128 + k) * 2 + kv) * 64;
        else vp = p.proj + ((size_t)MP + b * DS + (k - 128)) * NIN + 640 + kv * 64;
        o += sp[k] * vp[lane]; }
    p.attn[(size_t)m * 512 + h * 64 + lane] = o / sum;
}
__global__ void __launch_bounds__(64) k_ssm(P p) {
    int u = blockIdx.x, lane = threadIdx.x;
    bool samp = u >= NB * 32; int b = samp ? (u - NB * 32) / 32 : u / 32, g = u % 32;
    double are = p.in[14][g * 64 + lane], aim = p.in[15][g * 64 + lane], dt = exp((double)p.in[16][g]);
    double er = exp(are * dt), lbr = er * cos(aim * dt), lbi = er * sin(aim * dt);
    double nr = lbr - 1.0, ni = lbi, den = are * are + aim * aim, fr = (nr * are + ni * aim) / den, fi = (ni * are - nr * aim) / den;
    float bbr[16], bbi[16], cr[16], ci[16];
#pragma unroll
    for (int h = 0; h < 16; ++h) { double br = p.in[17][(g * 64 + lane) * 16 + h], bi = p.in[18][(g * 64 + lane) * 16 + h];
        bbr[h] = (float)(fr * br - fi * bi); bbi[h] = (float)(fr * bi + fi * br);
        cr[h] = p.in[19][(g * 16 + h) * 64 + lane]; ci[h] = p.in[20][(g * 16 + h) * 64 + lane]; }
    float lr = (float)lbr, li = (float)lbi, hr = 0.f, hi = 0.f;
    if (samp) { hr = p.in[4][((b * 32 + g) * 64 + lane) * 2]; hi = p.in[4][((b * 32 + g) * 64 + lane) * 2 + 1]; }
    int nt = samp ? DS : SEQ; size_t row0 = samp ? (size_t)MP + b * DS : (size_t)b * SEQ;
    for (int t = 0; t < nt; ++t) {
        const float* up = p.proj + (row0 + t) * NIN + 768 + g * 16;
        float ur[16]; float sr = 0.f, si = 0.f;
#pragma unroll
        for (int h = 0; h < 16; ++h) { ur[h] = up[h]; sr += bbr[h] * ur[h]; si += bbi[h] * ur[h]; }
        float nr2 = lr * hr - li * hi + sr, ni2 = lr * hi + li * hr + si; hr = nr2; hi = ni2;
        float myy = 0.f;
#pragma unroll
        for (int h = 0; h < 16; ++h) { float y = wsum(cr[h] * hr - ci[h] * hi); if (lane == h) myy = y + p.in[21][g * 16 + h] * ur[h]; }
        if (lane < 16) { float y = myy; float gl = 0.5f * y * (1.f + tanhf(0.7978845608028654f * (y + 0.044715f * y * y * y))); p.g[(row0 + t) * 512 + g * 16 + lane] = gl; }
    }
    size_t so = samp ? O_HS + ((size_t)(b * 32 + g) * 64 + lane) * 2 : O_HP + ((size_t)(b * 32 + g) * 64 + lane) * 2;
    p.out[so] = hr; p.out[so + 1] = hi;
}
__global__ void k_merge(P p) {
    int m = blockIdx.x * 4 + (threadIdx.x >> 6), lane = threadIdx.x & 63; if (m >= M) return;
    float a[8], s[8], sa = 0.f, ss = 0.f;
#pragma unroll
    for (int j = 0; j < 8; ++j) { a[j] = p.attn[(size_t)m * 512 + lane + 64 * j]; s[j] = p.so[(size_t)m * 512 + lane + 64 * j]; sa += a[j] * a[j]; ss += s[j] * s[j]; }
    float ra = rsqrtf(wsum(sa) / 512.f + EPS), rs = rsqrtf(wsum(ss) / 512.f + EPS);
#pragma unroll
    for (int j = 0; j < 8; ++j) { int c = lane + 64 * j; p.merged[(size_t)m * D + c] = a[j] * ra * p.in[24][c]; p.merged[(size_t)m * D + 512 + c] = s[j] * rs * p.in[25][c]; }
}
}

extern "C" void kernel_launch(void* const* d_in, const int* in_sizes, int n_in, void* d_out, int out_size, void* d_ws, size_t ws_size, hipStream_t stream) {
    using namespace nv;
    P p{};
    for (int i = 0; i < 31; ++i) p.in[i] = (const float*)d_in[i];
    p.out = (float*)d_out;
    char* ws = (char*)d_ws; const size_t MB = 1u << 20;
    if (ws_size < 972 * MB) { fprintf(stderr, "ws too small: %zu\n", ws_size); return; }
    p.proj = (float*)(ws);
    p.attn = (float*)(ws + 322 * MB);
    p.g = (float*)(ws + 451 * MB);
    p.so = (float*)(ws + 580 * MB);
    p.merged = (float*)(ws + 709 * MB);
    p.act = (float*)(ws);
    p.mod = (float*)(ws + 966 * MB); p.r1 = p.mod + 24 * NMOD; p.r2 = p.r1 + M;
    k_mod<<<(24 * NMOD + 255) / 256, 256, 0, stream>>>(p);
    k_rowrms<<<(M + 3) / 4, 256, 0, stream>>>(p, 0);
    k_gemm<<<dim3(NIN / 64, M / 64), 256, 0, stream>>>(AF_norm1{p}, p.in[10], D, NIN, EF_store{p.proj, NIN});
    k_qkrope<<<(M * 10 + 3) / 4, 256, 0, stream>>>(p);
    k_attn<<<M * 8, 64, 0, stream>>>(p);
    k_ssm<<<NB * 32 + DB * 32, 64, 0, stream>>>(p);
    k_gemm<<<dim3(512 / 64, M / 64), 256, 0, stream>>>(AF_plain{p.g, 512}, p.in[22], 512, 512, EF_glu{p});
    k_merge<<<(M + 3) / 4, 256, 0, stream>>>(p);
    k_gemm<<<dim3(D / 64, M / 64), 256, 0, stream>>>(AF_plain{p.merged, D}, p.in[26], D, D, EF_res1{p});
    k_rowrms<<<(M + 3) / 4, 256, 0, stream>>>(p, 1);
    k_gemm<<<dim3(FF / 64, M / 64), 256, 0, stream>>>(AF_norm2{p}, p.in[28], D, FF, EF_gate{p});
    k_gemm<<<dim3(FF / 64, M / 64), 256, 0, stream>>>(AF_norm2{p}, p.in[29], D, FF, EF_up{p});
    k_gemm<<<dim3(D / 64, M / 64), 256, 0, stream>>>(AF_plain{p.act, FF}, p.in[30], FF, D, EF_res2{p});
}
```

```cpp
#include <hip/hip_runtime.h>
#include <cstdio>
#include <cstdint>
#include <cmath>

#define LAS __attribute__((address_space(3)))
#define GAS __attribute__((address_space(1)))
typedef unsigned short bf16_t;
typedef short bf16x8 __attribute__((ext_vector_type(8)));
typedef short s16x4 __attribute__((ext_vector_type(4)));
typedef float f32x4 __attribute__((ext_vector_type(4)));
typedef float f32x2 __attribute__((ext_vector_type(2)));
typedef float f32x16 __attribute__((ext_vector_type(16)));
typedef unsigned u32x4 __attribute__((ext_vector_type(4)));
typedef unsigned u32x2 __attribute__((ext_vector_type(2)));
typedef __bf16 bf16x2_t __attribute__((ext_vector_type(2)));

constexpr int D = 1024, NB = 16, SEQ = 4096, DBT = 8, DS = 32, PAST = 1024;
constexpr int MP = NB * SEQ, MS = DBT * DS, M = MP + MS;
constexpr int NIN = 1280, FF = 2816, NGU = 2 * FF, NMOD = 6 * D;
constexpr int XS_LD = 1152;
constexpr float EPS = 1e-6f;
constexpr float QSCALE = 0.125f * 1.4426950408889634f;
constexpr size_t O_Y = 0, O_YS = (size_t)MP * D, O_KP = O_YS + (size_t)MS * D, O_VP = O_KP + 262144, O_HP = O_VP + 262144,
                 O_KS = O_HP + 65536, O_VS = O_KS + 32768, O_HS = O_VS + 32768;
constexpr size_t MiB = 1u << 20;
constexpr size_t WS_CTL = 0, CTL_ZERO_BYTES = 1 * MiB;
constexpr size_t WS_MOD = 1 * MiB, WS_BIAS1 = 2 * MiB, WS_BIAS2 = 2 * MiB + 128 * 1024, WS_R1 = 3 * MiB, WS_ROPE = 4 * MiB, WS_SSQ = 5 * MiB, WS_SSQ2 = 8 * MiB,
                 WS_KMAT = 13 * MiB, WS_LAM = 15 * MiB, WS_US = 15 * MiB + 64 * 1024,
                 WS_WIN = 16 * MiB, WS_WGLU = 19 * MiB, WS_WOUT = 20 * MiB, WS_WGU = 22 * MiB, WS_WD = 33 * MiB, WS_BTS = 39 * MiB, WS_BTY = 48 * MiB,
                 WS_A2 = 128 * MiB, WS_XB = 257 * MiB, WS_Q = 386 * MiB, WS_KB = 451 * MiB, WS_VB = 468 * MiB, WS_XS = 485 * MiB, WS_DS = 557 * MiB,
                 WS_GB = 589 * MiB, WS_MG = 654 * MiB, WS_ACT = 257 * MiB, WS_END = 783 * MiB;
constexpr int CW_TMO = 0, CW_BAR = 4096;

__device__ __forceinline__ unsigned cvtpk(float lo, float hi) { f32x2 v = {lo, hi}; bf16x2_t b = __builtin_convertvector(v, bf16x2_t); return __builtin_bit_cast(unsigned, b); }
__device__ __forceinline__ float bf2f(unsigned short h) { return __uint_as_float((unsigned)h << 16); }
__device__ __forceinline__ float bflo(unsigned w) { return __uint_as_float(w << 16); }
__device__ __forceinline__ float bfhi(unsigned w) { return __uint_as_float(w & 0xffff0000u); }
__device__ __forceinline__ int modrow_of(int m) { return m < MP ? (m >> 12) : NB + ((m - MP) >> 5); }
__device__ __forceinline__ int pos_of(int m) { return m < MP ? (m & (SEQ - 1)) : PAST + ((m - MP) & (DS - 1)); }
__device__ __forceinline__ float silu_f(float v) { return v / (1.f + __expf(-v)); }
__device__ __forceinline__ float sigm_f(float v) { return 1.f / (1.f + __expf(-v)); }
__device__ __forceinline__ float gelu_tanh(float y) { const float u = 0.7978845608028654f * (y + 0.044715f * y * y * y); const float e = __expf(2.f * u); return y * (1.f - 1.f / (e + 1.f)); }
__device__ __forceinline__ float wave_sum(float v) {
#pragma unroll
    for (int o = 1; o < 64; o <<= 1) v += __shfl_xor(v, o);
    return v;
}
#define LDS_WAIT() asm volatile("s_waitcnt lgkmcnt(0)" ::: "memory")
#define VM_WAIT() asm volatile("s_waitcnt vmcnt(0)" ::: "memory")

namespace pg8 {
constexpr int BM = 256, BK = 64, HALF = 128, HTB = HALF * BK * 2, STAGE_BYTES = 8 * HTB, NXCD = 8, WGM = 8;
__host__ __device__ __forceinline__ int lds_byte(int r, int c) { const int st = (r >> 4) * 2 + (c >> 5), rr = r & 15, cc = c & 31, ob = rr * 64 + cc * 2; return st * 1024 + (ob ^ (((ob >> 9) & 1) << 5)); }
__host__ __device__ __forceinline__ void stage_rc(int b, int& R, int& C) { const int st = b / 1024, sb = b % 1024, swz = sb ^ (((sb >> 9) & 1) << 5); R = (st >> 1) * 16 + swz / 64; C = (st & 1) * 32 + (swz % 64) / 2; }

struct Unit { size_t aoff, boff; int pm, pn, nt, aux; };
struct Gemm { const bf16_t* A; const bf16_t* Bt; int lda, ldb; int bhalf; };

struct StaticOrder {
    int nM, nN, nwg, G, c, nt; size_t ta, tb;
    __device__ void init(int M_, int N_, int K_, int lda, int ldb, int G_, int c_) { nM = M_ / BM; nN = N_ / BM; nwg = nM * nN; G = G_; c = c_; nt = K_ / BK; ta = (size_t)BM * lda * 2; tb = (size_t)BM * ldb * 2; }
    __device__ bool next(int i, Unit& u) const {
        const long L = (long)i * G + c; if (L >= nwg) return false;
        int wgid = (int)L; { const int q = nwg / NXCD, r = nwg % NXCD, xcd = wgid % NXCD, off = wgid / NXCD; wgid = (xcd < r ? xcd * (q + 1) : r * (q + 1) + (xcd - r) * q) + off; }
        const int nig = WGM * nN, gid = wgid / nig, fm = gid * WGM, gsz = (nM - fm) < WGM ? (nM - fm) : WGM;
        u.pm = fm + ((wgid % nig) % gsz); u.pn = (wgid % nig) / gsz; u.aoff = (size_t)u.pm * ta; u.boff = (size_t)u.pn * tb; u.nt = nt; u.aux = 0; return true;
    }
};

template <class Epi, class Sched>
__device__ __forceinline__ void gemm_phase(LAS unsigned char* lds, const Gemm g, const Sched& S, const Epi& E) {
    const int tid = threadIdx.x, wid = __builtin_amdgcn_readfirstlane(tid >> 6), lane = tid & 63, wr = wid >> 2, wc = wid & 3, fr = lane & 15, fq = lane >> 4;
    unsigned voffA[2], voffB[2];
#pragma unroll
    for (int i = 0; i < 2; ++i) { int R, C; stage_rc(tid * 16 + i * 8192, R, C); voffA[i] = (unsigned)(R * g.lda + C) * 2u; voffB[i] = (unsigned)(R * g.ldb + C) * 2u; }
    const size_t kstep = (size_t)(BK * 2);
    const size_t hstepA = (size_t)HALF * g.lda * 2, hstepB = g.bhalf ? (size_t)HALF * g.ldb * 2 : 0;
    const unsigned ldsw = (unsigned)wid * 1024u;
    const int aoff = lds_byte(wr * 64 + fr, fq * 8), boff = lds_byte(wc * 32 + fr, fq * 8);
#define PG8_SA(b, h) (((b) * 2 + (h)) * HTB)
#define PG8_SB(b, h) ((4 + (b) * 2 + (h)) * HTB)
#define PG8_STAGE(bufoff, gbase, voff) do { _Pragma("unroll") for (int _i = 0; _i < 2; ++_i) \
        __builtin_amdgcn_global_load_lds((const unsigned*)((const char*)(gbase) + (voff)[_i]), (LAS unsigned*)(lds + (bufoff) + ldsw + _i * 8192), 16, 0, 0); } while (0)
#define PG8_LDA(dst, b, h) do { _Pragma("unroll") for (int m = 0; m < 4; ++m) _Pragma("unroll") for (int k = 0; k < 2; ++k) dst[m][k] = *(const LAS bf16x8*)(lds + PG8_SA(b, h) + aoff + m * 2048 + k * 1024); } while (0)
#define PG8_LDB(dst, b, h) do { _Pragma("unroll") for (int n = 0; n < 2; ++n) _Pragma("unroll") for (int k = 0; k < 2; ++k) dst[n][k] = *(const LAS bf16x8*)(lds + PG8_SB(b, h) + boff + n * 2048 + k * 1024); } while (0)
#define PG8_MMA(ai, bj, At, Bt) do { __builtin_amdgcn_s_setprio(1); _Pragma("unroll") for (int m = 0; m < 4; ++m) _Pragma("unroll") for (int n = 0; n < 2; ++n) _Pragma("unroll") for (int k = 0; k < 2; ++k) \
        acc[ai][bj][m][n] = __builtin_amdgcn_mfma_f32_16x16x32_bf16(Bt[n][k], At[m][k], acc[ai][bj][m][n], 0, 0, 0); __builtin_amdgcn_s_setprio(0); } while (0)
#define PG8_WAIT_V(n) asm volatile("s_waitcnt vmcnt(" #n ")" ::: "memory")
#define PG8_WAIT_L(n) asm volatile("s_waitcnt lgkmcnt(" #n ")" ::: "memory")
#define PG8_BAR __builtin_amdgcn_s_barrier()
#define PG8_SCHED __builtin_amdgcn_sched_barrier(0)
    Unit cur, nxt; int ui = 0;
    if (!S.next(0, cur)) return;
    f32x4 acc[2][2][4][2];
#pragma unroll
    for (int a = 0; a < 2; ++a)
#pragma unroll
        for (int b = 0; b < 2; ++b)
#pragma unroll
            for (int m = 0; m < 4; ++m)
#pragma unroll
                for (int n = 0; n < 2; ++n) acc[a][b][m][n] = (f32x4){0.f, 0.f, 0.f, 0.f};
    bf16x8 At[4][2], B0[2][2], B1[2][2];
    const char* cA = (const char*)g.A + cur.aoff; const char* cB = (const char*)g.Bt + cur.boff;
    PG8_STAGE(PG8_SB(0, 0), cB, voffB); PG8_STAGE(PG8_SB(0, 1), cB + hstepB, voffB); PG8_STAGE(PG8_SA(0, 0), cA, voffA); PG8_STAGE(PG8_SA(0, 1), cA + hstepA, voffA);
    if (wr == 1) PG8_BAR;
    PG8_WAIT_V(2); PG8_BAR;
    PG8_STAGE(PG8_SB(1, 0), cB + kstep, voffB); PG8_STAGE(PG8_SA(1, 0), cA + kstep, voffA); PG8_STAGE(PG8_SB(1, 1), cB + hstepB + kstep, voffB);
    PG8_WAIT_V(6); PG8_BAR;
    for (;;) {
        const bool has_next = S.next(ui + 1, nxt);
        const char* nA = has_next ? (const char*)g.A + nxt.aoff : cA; const char* nB = has_next ? (const char*)g.Bt + nxt.boff : cB;
        const int nt = cur.nt;
        for (int t = 0; t < nt; t += 2) {
            const bool last = (t == nt - 2);
            const char* a1 = cA + (size_t)(t + 1) * kstep;
            const char* a2 = last ? nA : cA + (size_t)(t + 2) * kstep; const char* b2 = last ? nB : cB + (size_t)(t + 2) * kstep;
            const char* a3 = a2 + kstep; const char* b3 = b2 + kstep;
            if constexpr (Epi::HAS_MID) { if (t == Epi::MID_T) E.mid(acc, cur, wr, wc, fr, fq); }
            PG8_LDB(B0, 0, 0); PG8_LDB(B1, 0, 1); PG8_SCHED; PG8_LDA(At, 0, 0); PG8_STAGE(PG8_SA(1, 1), a1 + hstepA, voffA);
            PG8_WAIT_V(8); PG8_WAIT_L(0); PG8_BAR; PG8_MMA(0, 0, At, B0); PG8_MMA(0, 1, At, B1); PG8_BAR; PG8_SCHED;
            PG8_LDA(At, 0, 1); PG8_STAGE(PG8_SB(0, 0), b2, voffB); PG8_STAGE(PG8_SB(0, 1), b2 + hstepB, voffB); PG8_STAGE(PG8_SA(0, 0), a2, voffA);
            PG8_WAIT_V(8); PG8_WAIT_L(0); PG8_BAR; PG8_MMA(1, 0, At, B0); PG8_MMA(1, 1, At, B1); PG8_BAR; PG8_SCHED;
            PG8_LDB(B0, 1, 0); PG8_LDB(B1, 1, 1); PG8_SCHED; PG8_LDA(At, 1, 0); PG8_STAGE(PG8_SA(0, 1), a2 + hstepA, voffA);
            PG8_WAIT_V(8); PG8_WAIT_L(0); PG8_BAR; PG8_MMA(0, 0, At, B0); PG8_MMA(0, 1, At, B1); PG8_BAR; PG8_SCHED;
            PG8_LDA(At, 1, 1); PG8_STAGE(PG8_SB(1, 0), b3, voffB); PG8_STAGE(PG8_SB(1, 1), b3 + hstepB, voffB); PG8_STAGE(PG8_SA(1, 0), a3, voffA);
            PG8_WAIT_V(8); PG8_WAIT_L(0); PG8_BAR; PG8_MMA(1, 0, At, B0); PG8_MMA(1, 1, At, B1); PG8_BAR; PG8_SCHED;
        }
        if (wr == 0) PG8_BAR;
        E(acc, cur, wr, wc, fr, fq);
        if (!has_next) break;
#pragma unroll
        for (int a = 0; a < 2; ++a)
#pragma unroll
            for (int b = 0; b < 2; ++b)
#pragma unroll
                for (int m = 0; m < 4; ++m)
#pragma unroll
                    for (int n = 0; n < 2; ++n) acc[a][b][m][n] = (f32x4){0.f, 0.f, 0.f, 0.f};
        cur = nxt; cA = nA; cB = nB; ++ui;
        if (wr == 1) PG8_BAR;
    }
    PG8_WAIT_V(0);
    PG8_BAR;
#undef PG8_SA
#undef PG8_SB
#undef PG8_STAGE
#undef PG8_LDA
#undef PG8_LDB
#undef PG8_MMA
#undef PG8_WAIT_V
#undef PG8_WAIT_L
#undef PG8_BAR
#undef PG8_SCHED
}
}

#define XB_TMO      128
#define XB_XCNT(j)  (256  + 64 * (j))
#define XB_XSUB(j)  (1280 + 64 * (j))
#define XB_XGEN(j)  (2304 + 64 * (j))
#define XB_TOP      3328
#define XB_TOPGEN   3392
#define XCD_BAR_WORDS 3456
#define XB_SPIN_CAP (1u << 18)
__device__ __forceinline__ unsigned xb_ld(unsigned* p)              { return __hip_atomic_load(p, __ATOMIC_RELAXED, __HIP_MEMORY_SCOPE_AGENT); }
__device__ __forceinline__ unsigned xb_add(unsigned* p, unsigned v) { return __hip_atomic_fetch_add(p, v, __ATOMIC_RELAXED, __HIP_MEMORY_SCOPE_AGENT); }
__device__ __forceinline__ unsigned xb_xcc_id() { return (unsigned)__builtin_amdgcn_s_getreg((3 << 11) | 20) & 0xFu; }
#define XB_SPIN(cond, bar) do { unsigned _sp = 0; while (cond) { __builtin_amdgcn_s_sleep(1); \
    if ((++_sp & 255u) == 0u) { if (xb_ld(&(bar)[XB_TMO])) break; if (_sp > XB_SPIN_CAP) { atomicAdd(&(bar)[XB_TMO], 1u); break; } } } } while (0)
struct XcdBarrier { unsigned* bar; unsigned x; volatile LAS unsigned* st; };
__device__ __forceinline__ XcdBarrier xcd_barrier_post(unsigned* bar, volatile LAS unsigned* st) {
    XcdBarrier b; b.bar = bar; b.x = xb_xcc_id(); b.st = st;
    if (threadIdx.x == 0) (void)xb_add(&bar[XB_XCNT(b.x)], 1u);
    return b;
}
__device__ __forceinline__ void xcd_barrier_complete(unsigned* bar, unsigned x, unsigned& nloc, unsigned& nx) {
    const unsigned G = gridDim.x * gridDim.y * gridDim.z;
    unsigned sum, cnt, mine, sp = 0u;
    for (;;) {
        sum = 0u; cnt = 0u; mine = 0u;
#pragma unroll
        for (unsigned j = 0; j < 16; ++j) { const unsigned c = xb_ld(&bar[XB_XCNT(j)]); sum += c; cnt += (c > 0u) ? 1u : 0u; mine = (j == x) ? c : mine; }
        if (sum == G) break;
        __builtin_amdgcn_s_sleep(1);
        if ((++sp & 255u) == 0u) { if (xb_ld(&bar[XB_TMO])) break; if (sp > XB_SPIN_CAP) { atomicAdd(&bar[XB_TMO], 1u); break; } }
    }
    nloc = mine > 0u ? mine : 1u; nx = cnt > 0u ? cnt : 1u;
}
__device__ __forceinline__ void xcd_barrier(const XcdBarrier& b) {
    asm volatile("s_waitcnt vmcnt(0)" ::: "memory");
    __syncthreads();
    if (threadIdx.x == 0) {
        unsigned* bar = b.bar;
        __builtin_amdgcn_s_waitcnt(0);
        unsigned nloc = b.st[0], nx = b.st[1];
        if (nloc == 0u) { xcd_barrier_complete(bar, b.x, nloc, nx); b.st[0] = nloc; b.st[1] = nx; }
        const unsigned old = xb_add(&bar[XB_XSUB(b.x)], 1u);
        const unsigned gen = old / nloc;
        if (old + 1u == (gen + 1u) * nloc) {
            __builtin_amdgcn_fence(__ATOMIC_RELEASE, "agent");
            asm volatile("s_waitcnt vmcnt(0)" ::: "memory");
            const unsigned og = xb_add(&bar[XB_TOP], 1u);
            const unsigned tg = og / nx;
            if (og + 1u == (tg + 1u) * nx) xb_add(&bar[XB_TOPGEN], 1u);
            else XB_SPIN(xb_ld(&bar[XB_TOPGEN]) == tg, bar);
            __builtin_amdgcn_fence(__ATOMIC_ACQUIRE, "agent");
            xb_add(&bar[XB_XGEN(b.x)], 1u);
            asm volatile("s_waitcnt vmcnt(0)" ::: "memory");
        } else {
            XB_SPIN(xb_ld(&bar[XB_XGEN(b.x)]) == gen, bar);
            __builtin_amdgcn_fence(__ATOMIC_ACQUIRE, "agent");
            asm volatile("s_waitcnt vmcnt(0)" ::: "memory");
        }
    }
    __syncthreads();
}

constexpr int RING_BYTES = 131072, LDSCTL_OFF = RING_BYTES, LDS_BYTES = 147456;
struct Args { const float* in[31]; float* out; unsigned char* ws; };
constexpr int PARAM_OFF = LDSCTL_OFF + 256;
struct Fr { LAS unsigned char* lds; int tid, lane, wave, vcu, G; };
__device__ __forceinline__ unsigned long long ldparam(const Fr& F, int i) { const LAS unsigned* p = (const LAS unsigned*)(F.lds + PARAM_OFF) + 2 * i;
    const unsigned lo = __builtin_amdgcn_readfirstlane(p[0]), hi = __builtin_amdgcn_readfirstlane(p[1]); return ((unsigned long long)hi << 32) | lo; }
__device__ __forceinline__ const float* inp(const Fr& F, int i) { return (const float*)(const GAS float*)ldparam(F, i); }
__device__ __forceinline__ float* outp(const Fr& F) { return (float*)(GAS float*)ldparam(F, 31); }
template <class T> __device__ __forceinline__ T* wsp(const Fr& F, size_t off) { return (T*)(GAS T*)(ldparam(F, 32) + off); }

__device__ __forceinline__ int in_srccol(int n) {
    const int pn = n >> 8, c = n & 255, bj = c >> 7, wc = (c >> 5) & 3, i = c & 31;
    if (pn < 2) return 64 * (4 * pn + wc) + 32 * bj + i;
    if (pn == 2) return (wc < 2 ? 512 + 64 * wc : 640 + 64 * (wc - 2)) + 32 * bj + i;
    return 768 + 256 * (pn - 3) + c;
}
__device__ __forceinline__ int gu_ff(int n) { return 128 * (n >> 8) + (n & 127); }

__device__ __forceinline__ void tr_item(const float* W, int ldw, int k0, int scol0, bf16_t* WT, int drow0, int ldt, int dk0, LAS float* scr, int lane) {
#pragma unroll 8
    for (int i = 0; i < 32; ++i) { const int kk = 2 * i + (lane >> 5); scr[kk * 33 + (lane & 31)] = W[(size_t)(k0 + kk) * ldw + scol0 + (lane & 31)]; }
    LDS_WAIT(); asm volatile("" ::: "memory");
    const int c = lane & 7;
#pragma unroll
    for (int j = 0; j < 4; ++j) { const int n = (lane >> 3) + 8 * j; const LAS float* s = scr + (8 * c) * 33 + n;
        u32x4 o; o.x = cvtpk(s[0 * 33], s[1 * 33]); o.y = cvtpk(s[2 * 33], s[3 * 33]); o.z = cvtpk(s[4 * 33], s[5 * 33]); o.w = cvtpk(s[6 * 33], s[7 * 33]);
        *(u32x4*)(WT + (size_t)(drow0 + n) * ldt + dk0 + 8 * c) = o; }
    LDS_WAIT(); asm volatile("" ::: "memory");
}
__device__ __forceinline__ void p0a(Fr& F) {
    if (F.vcu < 96) {
        const int col = 64 * F.vcu + F.lane; const float* W = inp(F, 7);
        float acc[24];
#pragma unroll
        for (int r = 0; r < 24; ++r) acc[r] = 0.f;
        for (int kc = 0; kc < 2; ++kc) {
            const int k0 = 128 * F.wave + 64 * kc;
            float sc[24];
#pragma unroll
            for (int r = 0; r < 24; ++r) { const float* cv = r < NB ? inp(F, 5) + (size_t)r * D : inp(F, 6) + (size_t)(r - NB) * D; sc[r] = silu_f(cv[k0 + F.lane]); }
#pragma unroll 4
            for (int kk = 0; kk < 64; ++kk) { const float wv = W[(size_t)(k0 + kk) * NMOD + col];
#pragma unroll
                for (int r = 0; r < 24; ++r) acc[r] += __int_as_float(__builtin_amdgcn_readlane(__float_as_int(sc[r]), kk)) * wv; }
        }
        LAS float* red = (LAS float*)F.lds;
#pragma unroll
        for (int r = 0; r < 24; ++r) red[(F.wave * 24 + r) * 64 + F.lane] = acc[r];
        LDS_WAIT(); __syncthreads();
        for (int o = F.tid; o < 24 * 64; o += 512) { const int r = o >> 6, cc = o & 63; float s = 0.f;
#pragma unroll
            for (int w = 0; w < 8; ++w) s += red[(w * 24 + r) * 64 + cc];
            wsp<float>(F, WS_MOD)[r * NMOD + 64 * F.vcu + cc] = s + inp(F, 8)[64 * F.vcu + cc]; }
        LDS_WAIT(); __syncthreads();
    }
    LAS float* scr = (LAS float*)(F.lds + F.wave * 16384);
    const int gw = F.vcu * 8 + F.wave, NGW = F.G * 8;
    constexpr int I_IN = 16 * 40, I_GLU = 8 * 16, I_OUT = 16 * 32, I_GU = 16 * 176, I_D = 44 * 32, I_TR = I_IN + I_GLU + I_OUT + I_GU + I_D, I_SSM = 32 * 65;
    for (int it = gw; it < I_TR + I_SSM; it += NGW) {
        int r = it;
        if (r < I_IN) { const int kb = r / 40, nb = r % 40; tr_item(inp(F, 10), NIN, 64 * kb, in_srccol(32 * nb), wsp<bf16_t>(F, WS_WIN), 32 * nb, D, 64 * kb, scr, F.lane); continue; } r -= I_IN;
        if (r < I_GLU) { const int kb = r / 16, nb = r % 16; tr_item(inp(F, 22), 512, 64 * kb, 32 * nb, wsp<bf16_t>(F, WS_WGLU), 32 * nb, 512, 64 * kb, scr, F.lane); continue; } r -= I_GLU;
        if (r < I_OUT) { const int kb = r / 32, nb = r % 32; tr_item(inp(F, 26), D, 64 * kb, 32 * nb, wsp<bf16_t>(F, WS_WOUT), 32 * nb, D, (64 * kb + 512) & 1023, scr, F.lane); continue; } r -= I_OUT;
        if (r < I_GU) { const int kb = r / 176, nb = r % 176, n0 = 32 * nb; const int bj = (n0 >> 7) & 1; tr_item(bj ? inp(F, 29) : inp(F, 28), FF, 64 * kb, gu_ff(n0), wsp<bf16_t>(F, WS_WGU), n0, D, 64 * kb, scr, F.lane); continue; } r -= I_GU;
        if (r < I_D) { const int kb = r / 32, nb = r % 32; tr_item(inp(F, 30), D, 64 * kb, 32 * nb, wsp<bf16_t>(F, WS_WD), 32 * nb, FF, 64 * kb, scr, F.lane); continue; } r -= I_D;
        {
            const int g = r / 65, tau = r % 65, p = F.lane;
            const double are = inp(F, 14)[g * 64 + p], aim = inp(F, 15)[g * 64 + p], dt = exp((double)inp(F, 16)[g]);
            const double e1 = exp(are * dt), l1r = e1 * cos(aim * dt), l1i = e1 * sin(aim * dt);
            const double et = exp(are * dt * tau), wr_ = et * cos(aim * dt * tau), wi_ = et * sin(aim * dt * tau);
            const double nr = l1r - 1.0, ni = l1i, den = are * are + aim * aim, fr_ = (nr * are + ni * aim) / den, fi_ = (ni * are - nr * aim) / den;
            if (tau == 64) { f32x2* L = wsp<f32x2>(F, WS_LAM); L[g * 64 + p] = (f32x2){(float)wr_, (float)wi_}; continue; }
            const float wrf = (float)wr_, wif = (float)wi_;
            float er[16], ei[16];
#pragma unroll
            for (int h = 0; h < 16; ++h) { const double br = inp(F, 17)[(g * 64 + p) * 16 + h], bi = inp(F, 18)[(g * 64 + p) * 16 + h];
                const double bbr = fr_ * br - fi_ * bi, bbi = fr_ * bi + fi_ * br; er[h] = (float)(wr_ * bbr - wi_ * bbi); ei[h] = (float)(wr_ * bbi + wi_ * bbr); }
            { bf16_t* S = wsp<bf16_t>(F, WS_BTS) + (size_t)g * 128 * 1024; const int s = 63 - tau;
              u32x4 a0, a1, b0, b1;
              a0.x = cvtpk(er[0], er[1]); a0.y = cvtpk(er[2], er[3]); a0.z = cvtpk(er[4], er[5]); a0.w = cvtpk(er[6], er[7]);
              a1.x = cvtpk(er[8], er[9]); a1.y = cvtpk(er[10], er[11]); a1.z = cvtpk(er[12], er[13]); a1.w = cvtpk(er[14], er[15]);
              b0.x = cvtpk(ei[0], ei[1]); b0.y = cvtpk(ei[2], ei[3]); b0.z = cvtpk(ei[4], ei[5]); b0.w = cvtpk(ei[6], ei[7]);
              b1.x = cvtpk(ei[8], ei[9]); b1.y = cvtpk(ei[10], ei[11]); b1.z = cvtpk(ei[12], ei[13]); b1.w = cvtpk(ei[14], ei[15]);
              *(u32x4*)(S + (size_t)p * 1024 + s * 16) = a0; *(u32x4*)(S + (size_t)p * 1024 + s * 16 + 8) = a1;
              *(u32x4*)(S + (size_t)(64 + p) * 1024 + s * 16) = b0; *(u32x4*)(S + (size_t)(64 + p) * 1024 + s * 16 + 8) = b1; }
            if (tau >= 1) { bf16_t* Y = wsp<bf16_t>(F, WS_BTY) + (size_t)g * 1024 * XS_LD; const int t = tau - 1;
#pragma unroll
                for (int ho = 0; ho < 16; ++ho) { const float cr = inp(F, 19)[(g * 16 + ho) * 64 + p], ci = inp(F, 20)[(g * 16 + ho) * 64 + p];
                    const float kr = cr * wrf - ci * wif, ki = -(cr * wif + ci * wrf);
                    Y[(size_t)(t * 16 + ho) * XS_LD + p] = (bf16_t)(cvtpk(kr, 0.f) & 0xffffu); Y[(size_t)(t * 16 + ho) * XS_LD + 64 + p] = (bf16_t)(cvtpk(ki, 0.f) & 0xffffu); } }
            LAS float* Es = scr;
#pragma unroll
            for (int h = 0; h < 16; ++h) { Es[p * 32 + h] = er[h]; Es[p * 32 + 16 + h] = ei[h]; }
            LDS_WAIT(); asm volatile("" ::: "memory");
            { const int ho = F.lane >> 2, h0 = 4 * (F.lane & 3); f32x4 a = {0.f, 0.f, 0.f, 0.f};
              const float* Cr = inp(F, 19) + (g * 16 + ho) * 64; const float* Ci = inp(F, 20) + (g * 16 + ho) * 64;
              for (int q = 0; q < 64; ++q) { const float cr = Cr[q], ci = Ci[q]; const f32x4 e_r = *(const LAS f32x4*)(Es + q * 32 + h0), e_i = *(const LAS f32x4*)(Es + q * 32 + 16 + h0); a += cr * e_r - ci * e_i; }
              if (tau == 0) {
#pragma unroll
                  for (int j = 0; j < 4; ++j) if (h0 + j == ho) a[j] += inp(F, 21)[g * 16 + ho]; }
              *(f32x4*)(wsp<float>(F, WS_KMAT) + ((size_t)(g * 64 + tau) * 16 + ho) * 16 + h0) = a; }
            LDS_WAIT(); asm volatile("" ::: "memory");
        }
    }
    for (int i = gw * 64 + F.lane; i < SEQ * 32; i += NGW * 64) { const int pos = i >> 5, d = i & 31; const double ang = (double)pos * pow(10000.0, -(double)d / 32.0);
        wsp<f32x2>(F, WS_ROPE)[i] = (f32x2){(float)cos(ang), (float)sin(ang)}; }
}

__device__ __forceinline__ void p0b(Fr& F) {
    const int gw = F.vcu * 8 + F.wave, NGW = F.G * 8;
    const float* mod = wsp<float>(F, WS_MOD);
    constexpr int I_B1 = NIN / 64, I_B2 = NGU / 64, I_T = 32 * 1024;
    for (int it = gw; it < I_B1 + I_B2 + I_T + M; it += NGW) {
        int r = it;
        if (r < I_B1 + I_B2) {
            const bool two = r >= I_B1; const int n = 64 * (two ? r - I_B1 : r) + F.lane;
            const float* W; int ldw, sc; int moff;
            if (!two) { W = inp(F, 10); ldw = NIN; sc = in_srccol(n); moff = 0; } else { W = ((n >> 7) & 1) ? inp(F, 29) : inp(F, 28); ldw = FF; sc = gu_ff(n); moff = 3 * D; }
            float acc[24];
#pragma unroll
            for (int q = 0; q < 24; ++q) acc[q] = 0.f;
            for (int k = 0; k < D; ++k) { const float wv = W[(size_t)k * ldw + sc];
#pragma unroll
                for (int q = 0; q < 24; ++q) acc[q] += mod[q * NMOD + moff + k] * wv; }
            float* B = two ? wsp<float>(F, WS_BIAS2) : wsp<float>(F, WS_BIAS1); const int ldb = two ? NGU : NIN;
#pragma unroll
            for (int q = 0; q < 24; ++q) B[q * ldb + n] = acc[q];
            continue;
        }
        r -= I_B1 + I_B2;
        if (r < I_T) {
            const int g = r >> 10, t = (r >> 4) & 63, ho = r & 15; const int ncol = 256 * ((t >> 4) + 1);
            bf16_t* Y = wsp<bf16_t>(F, WS_BTY) + ((size_t)g * 1024 + (r & 1023)) * XS_LD + 128; const float* KM = wsp<float>(F, WS_KMAT) + (size_t)g * 64 * 256;
            for (int c0 = 8 * F.lane; c0 < ncol; c0 += 512) { const int s = c0 >> 4, h0 = c0 & 15; u32x4 o = {0u, 0u, 0u, 0u};
                if (s <= t) { const float* kp = KM + ((size_t)(t - s) * 16 + ho) * 16 + h0; const f32x4 a = *(const f32x4*)kp, b = *(const f32x4*)(kp + 4);
                    o.x = cvtpk(a[0], a[1]); o.y = cvtpk(a[2], a[3]); o.z = cvtpk(b[0], b[1]); o.w = cvtpk(b[2], b[3]); }
                *(u32x4*)(Y + c0) = o; }
            continue;
        }
        r -= I_T;
        {
            const int m = r, mr = modrow_of(m);
            const float* xr = m < MP ? inp(F, 0) + (size_t)m * D : inp(F, 1) + (size_t)(m - MP) * D;
            const float* sc1 = mod + (size_t)mr * NMOD + D; const float* g1 = inp(F, 9);
            f32x4 v[4]; float s = 0.f;
#pragma unroll
            for (int j = 0; j < 4; ++j) { v[j] = *(const f32x4*)(xr + 256 * j + 4 * F.lane); s += (v[j].x * v[j].x + v[j].y * v[j].y) + (v[j].z * v[j].z + v[j].w * v[j].w); }
            s = wave_sum(s);
            if (F.lane == 0) wsp<float>(F, WS_R1)[m] = rsqrtf(s * (1.f / D) + EPS);
            bf16_t* o = wsp<bf16_t>(F, WS_XB) + (size_t)m * D;
#pragma unroll
            for (int j = 0; j < 4; ++j) { const int k = 256 * j + 4 * F.lane; const f32x4 gg = *(const f32x4*)(g1 + k), ss = *(const f32x4*)(sc1 + k);
                const f32x4 w = v[j] * gg * (1.f + ss); u32x2 pk; pk.x = cvtpk(w[0], w[1]); pk.y = cvtpk(w[2], w[3]); *(u32x2*)(o + k) = pk; }
        }
    }
}

struct EpiIn {
    static constexpr bool HAS_MID = false; static constexpr int MID_T = -1;
    Fr F;
    __device__ __forceinline__ void mid(f32x4 (&)[2][2][4][2], const pg8::Unit&, int, int, int, int) const {}
    __device__ __forceinline__ void operator()(const f32x4 (&acc)[2][2][4][2], const pg8::Unit& u, int wr, int wc, int fr, int fq) const {
        const float* r1 = wsp<float>(F, WS_R1); const float* bias1 = wsp<float>(F, WS_BIAS1); const f32x2* rope = wsp<f32x2>(F, WS_ROPE); const float* qg = inp(F, 11); const float* kg = inp(F, 12);
        bf16_t* Q = wsp<bf16_t>(F, WS_Q); bf16_t* Kb = wsp<bf16_t>(F, WS_KB); bf16_t* Vb = wsp<bf16_t>(F, WS_VB); bf16_t* XS = wsp<bf16_t>(F, WS_XS); float* us = wsp<float>(F, WS_US); float* out = outp(F);
        const int pn = u.pn;
#pragma unroll
        for (int ai = 0; ai < 2; ++ai)
#pragma unroll
            for (int m = 0; m < 4; ++m) {
                const int row = u.pm * 256 + ai * 128 + wr * 64 + m * 16 + fr;
                const int mr = modrow_of(row); const float rs = r1[row];
                const float* bp = bias1 + (size_t)mr * NIN + pn * 256 + wc * 32 + 4 * fq;
                f32x4 v[2][2];
#pragma unroll
                for (int bj = 0; bj < 2; ++bj)
#pragma unroll
                    for (int n = 0; n < 2; ++n) v[bj][n] = acc[ai][bj][m][n] * rs + *(const f32x4*)(bp + bj * 128 + n * 16);
                if (pn >= 3) {
                    if (row < MP) { const int bc = row >> 6, s = row & 63;
#pragma unroll
                        for (int bj = 0; bj < 2; ++bj)
#pragma unroll
                            for (int n = 0; n < 2; ++n) { const int g = 16 * (pn - 3) + 8 * bj + 2 * wc + n; u32x2 pk; pk.x = cvtpk(v[bj][n][0], v[bj][n][1]); pk.y = cvtpk(v[bj][n][2], v[bj][n][3]);
                                *(u32x2*)(XS + ((size_t)g * 1024 + bc) * XS_LD + 128 + s * 16 + 4 * fq) = pk; } }
                    else {
#pragma unroll
                        for (int bj = 0; bj < 2; ++bj)
#pragma unroll
                            for (int n = 0; n < 2; ++n) *(f32x4*)(us + (size_t)(row - MP) * 512 + 256 * (pn - 3) + 128 * bj + 32 * wc + 16 * n + 4 * fq) = v[bj][n]; }
                } else if (pn == 2 && wc >= 2) {
                    const int kv = wc - 2;
#pragma unroll
                    for (int bj = 0; bj < 2; ++bj)
#pragma unroll
                        for (int n = 0; n < 2; ++n) { const int d0 = 32 * bj + 16 * n + 4 * fq; u32x2 pk; pk.x = cvtpk(v[bj][n][0], v[bj][n][1]); pk.y = cvtpk(v[bj][n][2], v[bj][n][3]);
                            *(u32x2*)(Vb + (size_t)row * 128 + kv * 64 + d0) = pk;
                            if (row >= MP) *(f32x4*)(out + O_VS + ((size_t)(row - MP) * 2 + kv) * 64 + d0) = v[bj][n];
                            else if ((row & (SEQ - 1)) >= SEQ - 128) *(f32x4*)(out + O_VP + (((size_t)(row >> 12) * 128 + ((row & (SEQ - 1)) - (SEQ - 128))) * 2 + kv) * 64 + d0) = v[bj][n]; }
                } else {
                    float ss = 0.f;
#pragma unroll
                    for (int bj = 0; bj < 2; ++bj)
#pragma unroll
                        for (int n = 0; n < 2; ++n) ss += (v[bj][n][0] * v[bj][n][0] + v[bj][n][1] * v[bj][n][1]) + (v[bj][n][2] * v[bj][n][2] + v[bj][n][3] * v[bj][n][3]);
                    ss += __shfl_xor(ss, 16); ss += __shfl_xor(ss, 32);
                    const float rn = rsqrtf(ss * (1.f / 64.f) + EPS);
                    const float* gn = pn < 2 ? qg : kg; const int pos = pos_of(row);
                    f32x4 o[2][2];
#pragma unroll
                    for (int n = 0; n < 2; ++n) { const int i0 = 16 * n + 4 * fq;
                        const f32x4 g0 = *(const f32x4*)(gn + i0), g1 = *(const f32x4*)(gn + 32 + i0);
                        const f32x4 x1 = v[0][n] * rn * g0, x2 = v[1][n] * rn * g1;
                        const f32x4 cs0 = *(const f32x4*)(rope + (size_t)pos * 32 + i0), cs1 = *(const f32x4*)(rope + (size_t)pos * 32 + i0 + 2);
                        const f32x4 cv = {cs0[0], cs0[2], cs1[0], cs1[2]}, sv = {cs0[1], cs0[3], cs1[1], cs1[3]};
                        o[0][n] = x1 * cv - x2 * sv; o[1][n] = x2 * cv + x1 * sv; }
                    if (pn < 2) { const int head = 4 * pn + wc;
#pragma unroll
                        for (int bj = 0; bj < 2; ++bj)
#pragma unroll
                            for (int n = 0; n < 2; ++n) { const f32x4 q = o[bj][n] * QSCALE; u32x2 pk; pk.x = cvtpk(q[0], q[1]); pk.y = cvtpk(q[2], q[3]);
                                *(u32x2*)(Q + (size_t)row * 512 + head * 64 + 32 * bj + 16 * n + 4 * fq) = pk; }
                    } else { const int kv = wc;
#pragma unroll
                        for (int bj = 0; bj < 2; ++bj)
#pragma unroll
                            for (int n = 0; n < 2; ++n) { const int d0 = 32 * bj + 16 * n + 4 * fq; u32x2 pk; pk.x = cvtpk(o[bj][n][0], o[bj][n][1]); pk.y = cvtpk(o[bj][n][2], o[bj][n][3]);
                                *(u32x2*)(Kb + (size_t)row * 128 + kv * 64 + d0) = pk;
                                if (row >= MP) *(f32x4*)(out + O_KS + ((size_t)(row - MP) * 2 + kv) * 64 + d0) = o[bj][n];
                                else if ((row & (SEQ - 1)) >= SEQ - 128) *(f32x4*)(out + O_KP + (((size_t)(row >> 12) * 128 + ((row & (SEQ - 1)) - (SEQ - 128))) * 2 + kv) * 64 + d0) = o[bj][n]; }
                    }
                }
            }
    }
};
struct EpiState {
    static constexpr bool HAS_MID = false; static constexpr int MID_T = -1;
    Fr F;
    __device__ __forceinline__ void mid(f32x4 (&)[2][2][4][2], const pg8::Unit&, int, int, int, int) const {}
    __device__ __forceinline__ void operator()(const f32x4 (&acc)[2][2][4][2], const pg8::Unit& u, int wr, int wc, int fr, int fq) const {
        float* base = wsp<float>(F, WS_DS) + (size_t)u.aux * 1024 * 128;
#pragma unroll
        for (int ai = 0; ai < 2; ++ai)
#pragma unroll
            for (int m = 0; m < 4; ++m) { const int bc = u.pm * 256 + ai * 128 + wr * 64 + m * 16 + fr;
#pragma unroll
                for (int n = 0; n < 2; ++n) *(f32x4*)(base + (size_t)bc * 128 + 32 * wc + 16 * n + 4 * fq) = acc[ai][0][m][n]; }
    }
};
struct EpiY {
    static constexpr bool HAS_MID = false; static constexpr int MID_T = -1;
    Fr F;
    __device__ __forceinline__ void mid(f32x4 (&)[2][2][4][2], const pg8::Unit&, int, int, int, int) const {}
    __device__ __forceinline__ void operator()(const f32x4 (&acc)[2][2][4][2], const pg8::Unit& u, int wr, int wc, int fr, int fq) const {
        bf16_t* Gb = wsp<bf16_t>(F, WS_GB); const int g = u.aux;
#pragma unroll
        for (int ai = 0; ai < 2; ++ai)
#pragma unroll
            for (int m = 0; m < 4; ++m) { const int bc = u.pm * 256 + ai * 128 + wr * 64 + m * 16 + fr;
#pragma unroll
                for (int bj = 0; bj < 2; ++bj)
#pragma unroll
                    for (int n = 0; n < 2; ++n) { const int t = 16 * u.pn + 8 * bj + 2 * wc + n; const f32x4 y = acc[ai][bj][m][n];
                        u32x2 pk; pk.x = cvtpk(gelu_tanh(y[0]), gelu_tanh(y[1])); pk.y = cvtpk(gelu_tanh(y[2]), gelu_tanh(y[3]));
                        *(u32x2*)(Gb + ((size_t)bc * 64 + t) * 512 + 16 * g + 4 * fq) = pk; } }
    }
};
struct EpiGlu {
    static constexpr bool HAS_MID = false; static constexpr int MID_T = -1;
    Fr F;
    __device__ __forceinline__ void mid(f32x4 (&)[2][2][4][2], const pg8::Unit&, int, int, int, int) const {}
    __device__ __forceinline__ void operator()(const f32x4 (&acc)[2][2][4][2], const pg8::Unit& u, int wr, int wc, int fr, int fq) const {
        const bf16_t* Gb = wsp<bf16_t>(F, WS_GB); const float* gb = inp(F, 23); const float* gain = inp(F, 25); bf16_t* MG = wsp<bf16_t>(F, WS_MG); float* ssq = wsp<float>(F, WS_SSQ);
        const int c0 = u.pn * 256 + wc * 32 + 4 * fq;
#pragma unroll
        for (int ai = 0; ai < 2; ++ai)
#pragma unroll
            for (int m = 0; m < 4; ++m) { const int row = u.pm * 256 + ai * 128 + wr * 64 + m * 16 + fr; float ss = 0.f;
#pragma unroll
                for (int bj = 0; bj < 2; ++bj)
#pragma unroll
                    for (int n = 0; n < 2; ++n) { const int c = c0 + bj * 128 + n * 16; const u32x2 gw = *(const u32x2*)(Gb + (size_t)row * 512 + c);
                        const f32x4 gv = {bflo(gw.x), bfhi(gw.x), bflo(gw.y), bfhi(gw.y)}; const f32x4 z = acc[ai][bj][m][n] + *(const f32x4*)(gb + c);
                        f32x4 so; so[0] = gv[0] * sigm_f(z[0]); so[1] = gv[1] * sigm_f(z[1]); so[2] = gv[2] * sigm_f(z[2]); so[3] = gv[3] * sigm_f(z[3]);
                        ss += (so[0] * so[0] + so[1] * so[1]) + (so[2] * so[2] + so[3] * so[3]);
                        const f32x4 w = so * *(const f32x4*)(gain + c); u32x2 pk; pk.x = cvtpk(w[0], w[1]); pk.y = cvtpk(w[2], w[3]); *(u32x2*)(MG + (size_t)row * D + c) = pk; }
                ss += __shfl_xor(ss, 16); ss += __shfl_xor(ss, 32);
                if (fq == 0) ssq[(size_t)row * 8 + u.pn * 4 + wc] = ss; }
    }
};
struct EpiOut {
    static constexpr bool HAS_MID = true; static constexpr int MID_T = 8;
    Fr F;
    __device__ __forceinline__ void mid(f32x4 (&acc)[2][2][4][2], const pg8::Unit& u, int wr, int wc, int fr, int fq) const {
        const float* ssq = wsp<float>(F, WS_SSQ);
#pragma unroll
        for (int ai = 0; ai < 2; ++ai)
#pragma unroll
            for (int m = 0; m < 4; ++m) { const int row = u.pm * 256 + ai * 128 + wr * 64 + m * 16 + fr; const f32x4 a = *(const f32x4*)(ssq + (size_t)row * 8), b = *(const f32x4*)(ssq + (size_t)row * 8 + 4);
                const float rs = rsqrtf((((a[0] + a[1]) + (a[2] + a[3])) + ((b[0] + b[1]) + (b[2] + b[3]))) * (1.f / 512.f) + EPS);
#pragma unroll
                for (int bj = 0; bj < 2; ++bj)
#pragma unroll
                    for (int n = 0; n < 2; ++n) acc[ai][bj][m][n] *= rs; }
    }
    __device__ __forceinline__ void operator()(const f32x4 (&acc)[2][2][4][2], const pg8::Unit& u, int wr, int wc, int fr, int fq) const {
        const float* xp = inp(F, 0); const float* xs = inp(F, 1); const float* mod = wsp<float>(F, WS_MOD); const float* ln2 = inp(F, 27); float* out = outp(F); bf16_t* A2 = wsp<bf16_t>(F, WS_A2); float* ssq2 = wsp<float>(F, WS_SSQ2);
        const int c0 = u.pn * 256 + wc * 32 + 4 * fq;
#pragma unroll
        for (int ai = 0; ai < 2; ++ai)
#pragma unroll
            for (int m = 0; m < 4; ++m) { const int row = u.pm * 256 + ai * 128 + wr * 64 + m * 16 + fr; const int mr = modrow_of(row);
                const float* xr = row < MP ? xp + (size_t)row * D : xs + (size_t)(row - MP) * D; const float* md = mod + (size_t)mr * NMOD; float ss = 0.f;
#pragma unroll
                for (int bj = 0; bj < 2; ++bj)
#pragma unroll
                    for (int n = 0; n < 2; ++n) { const int c = c0 + bj * 128 + n * 16;
                        const f32x4 x1 = *(const f32x4*)(xr + c) + *(const f32x4*)(md + 2 * D + c) * acc[ai][bj][m][n];
                        *(f32x4*)(out + (size_t)row * D + c) = x1;
                        ss += (x1[0] * x1[0] + x1[1] * x1[1]) + (x1[2] * x1[2] + x1[3] * x1[3]);
                        const f32x4 w = x1 * *(const f32x4*)(ln2 + c) * (1.f + *(const f32x4*)(md + 4 * D + c)); u32x2 pk; pk.x = cvtpk(w[0], w[1]); pk.y = cvtpk(w[2], w[3]); *(u32x2*)(A2 + (size_t)row * D + c) = pk; asm volatile("" ::: "memory"); }
                ss += __shfl_xor(ss, 16); ss += __shfl_xor(ss, 32);
                if (fq == 0) ssq2[(size_t)row * 16 + u.pn * 4 + wc] = ss; }
    }
};
struct EpiUp {
    static constexpr bool HAS_MID = false; static constexpr int MID_T = -1;
    Fr F;
    __device__ __forceinline__ void mid(f32x4 (&)[2][2][4][2], const pg8::Unit&, int, int, int, int) const {}
    __device__ __forceinline__ void operator()(const f32x4 (&acc)[2][2][4][2], const pg8::Unit& u, int wr, int wc, int fr, int fq) const {
        const float* ssq2 = wsp<float>(F, WS_SSQ2); const float* bias2 = wsp<float>(F, WS_BIAS2); bf16_t* ACT = wsp<bf16_t>(F, WS_ACT);
#pragma unroll
        for (int ai = 0; ai < 2; ++ai)
#pragma unroll
            for (int m = 0; m < 4; ++m) { const int row = u.pm * 256 + ai * 128 + wr * 64 + m * 16 + fr; const int mr = modrow_of(row);
                const float* sp = ssq2 + (size_t)row * 16; const f32x4 a = *(const f32x4*)sp, b = *(const f32x4*)(sp + 4), c = *(const f32x4*)(sp + 8), d = *(const f32x4*)(sp + 12);
                const float r2 = rsqrtf(((((a[0] + a[1]) + (a[2] + a[3])) + ((b[0] + b[1]) + (b[2] + b[3]))) + (((c[0] + c[1]) + (c[2] + c[3])) + ((d[0] + d[1]) + (d[2] + d[3])))) * (1.f / D) + EPS);
                const float* bp = bias2 + (size_t)mr * NGU + u.pn * 256 + wc * 32 + 4 * fq;
#pragma unroll
                for (int n = 0; n < 2; ++n) { const f32x4 gt = acc[ai][0][m][n] * r2 + *(const f32x4*)(bp + n * 16), up = acc[ai][1][m][n] * r2 + *(const f32x4*)(bp + 128 + n * 16);
                    u32x2 pk; pk.x = cvtpk(silu_f(gt[0]) * up[0], silu_f(gt[1]) * up[1]); pk.y = cvtpk(silu_f(gt[2]) * up[2], silu_f(gt[3]) * up[3]);
                    *(u32x2*)(ACT + (size_t)row * FF + u.pn * 128 + wc * 32 + n * 16 + 4 * fq) = pk; } }
    }
};
struct EpiDown {
    static constexpr bool HAS_MID = false; static constexpr int MID_T = -1;
    Fr F;
    __device__ __forceinline__ void mid(f32x4 (&)[2][2][4][2], const pg8::Unit&, int, int, int, int) const {}
    __device__ __forceinline__ void operator()(const f32x4 (&acc)[2][2][4][2], const pg8::Unit& u, int wr, int wc, int fr, int fq) const {
        const float* mod = wsp<float>(F, WS_MOD); float* out = outp(F);
        const int c0 = u.pn * 256 + wc * 32 + 4 * fq;
#pragma unroll
        for (int ai = 0; ai < 2; ++ai)
#pragma unroll
            for (int m = 0; m < 4; ++m) { const int row = u.pm * 256 + ai * 128 + wr * 64 + m * 16 + fr; const float* md = mod + (size_t)modrow_of(row) * NMOD + 5 * D;
#pragma unroll
                for (int bj = 0; bj < 2; ++bj)
#pragma unroll
                    for (int n = 0; n < 2; ++n) { const int c = c0 + bj * 128 + n * 16; float* op = out + (size_t)row * D + c; *(f32x4*)op = *(const f32x4*)op + *(const f32x4*)(md + c) * acc[ai][bj][m][n]; } }
    }
};
struct StateOrder {
    int c;
    __device__ bool next(int i, pg8::Unit& u) const { if (i > 0) return false; const int g = c >> 3, pm = (c >> 1) & 3, kh = c & 1;
        u.pm = pm; u.pn = 0; u.nt = 8; u.aux = kh * 32 + g; u.aoff = (((size_t)g * 1024 + pm * 256) * XS_LD + 128 + kh * 512) * 2; u.boff = ((size_t)g * 128 * 1024 + kh * 512) * 2; return true; }
};
struct YOrder {
    int c;
    __device__ bool next(int i, pg8::Unit& u) const { if (i > 1) return false; const int g = c >> 3, pm = (c >> 1) & 3, w = c & 1; const int pn = (i == 0) ? (w ? 2 : 3) : (w ? 1 : 0);
        u.pm = pm; u.pn = pn; u.nt = 2 + 4 * (pn + 1); u.aux = g; u.aoff = ((size_t)g * 1024 + pm * 256) * XS_LD * 2; u.boff = ((size_t)g * 1024 + pn * 256) * XS_LD * 2; return true; }
};

constexpr int AK_C = 192 * 16 + 16, AK_H = 8 * AK_C, AV_D = 192 * 64 + 64, AV_H = 2 * AV_D, A_V0 = 2 * AK_H, A_SS = A_V0 + 2 * AV_H;
__device__ __forceinline__ s16x4 vtr(const LAS unsigned char* p) { typedef short v4i16_t __attribute__((ext_vector_type(4))); return __builtin_bit_cast(s16x4, __builtin_amdgcn_ds_read_tr16_b64_v4i16((LAS v4i16_t*)p)); }
__device__ __forceinline__ float swap_max(float v) { auto rr = __builtin_amdgcn_permlane32_swap(__float_as_uint(v), __float_as_uint(v), false, false); return fmaxf(__uint_as_float(rr[0]), __uint_as_float(rr[1])); }
__device__ __forceinline__ float swap_add(float v) { auto rr = __builtin_amdgcn_permlane32_swap(__float_as_uint(v), __float_as_uint(v), false, false); return __uint_as_float(rr[0]) + __uint_as_float(rr[1]); }
__device__ __forceinline__ void attn_unit(Fr& F, int unit) {
    const int lane = F.lane, w = F.wave, r32 = lane & 31, hi = lane >> 5, kvh = w >> 2;
    const bf16_t* Kb = wsp<bf16_t>(F, WS_KB); const bf16_t* Vb = wsp<bf16_t>(F, WS_VB); const bf16_t* Q = wsp<bf16_t>(F, WS_Q); bf16_t* MG = wsp<bf16_t>(F, WS_MG);
    const bool samp = unit >= 1024;
    int nkeys, row0, krow0, sb = 0;
    if (!samp) { const int b = unit >> 6, c = unit & 63, nc = c < 2 ? c : 2; nkeys = 64 * (nc + 1); row0 = b * SEQ + 64 * c; krow0 = b * SEQ + 64 * (c - nc); }
    else { sb = unit - 1024; nkeys = 160; row0 = MP + 32 * sb; krow0 = 0; }
    for (int idx = F.tid; idx < nkeys * 16; idx += 512) {
        const int key = idx >> 4, j = idx & 15; u32x4 kq, vq;
        if (samp && key < 128) { const float* kp = inp(F, 2) + ((size_t)sb * 128 + key) * 128 + j * 8; const float* vp = inp(F, 3) + ((size_t)sb * 128 + key) * 128 + j * 8;
            const f32x4 a = *(const f32x4*)kp, b = *(const f32x4*)(kp + 4), c = *(const f32x4*)vp, d = *(const f32x4*)(vp + 4);
            kq.x = cvtpk(a[0], a[1]); kq.y = cvtpk(a[2], a[3]); kq.z = cvtpk(b[0], b[1]); kq.w = cvtpk(b[2], b[3]);
            vq.x = cvtpk(c[0], c[1]); vq.y = cvtpk(c[2], c[3]); vq.z = cvtpk(d[0], d[1]); vq.w = cvtpk(d[2], d[3]); }
        else { const size_t r = samp ? (size_t)(MP + 32 * sb + key - 128) : (size_t)(krow0 + key); kq = *(const u32x4*)(Kb + r * 128 + j * 8); vq = *(const u32x4*)(Vb + r * 128 + j * 8); }
        *(LAS u32x4*)(F.lds + (j >> 3) * AK_H + (j & 7) * AK_C + key * 16) = kq;
        *(LAS u32x4*)(F.lds + A_V0 + (j >> 3) * AV_H + ((j & 7) >> 2) * AV_D + key * 64 + (j & 3) * 16) = vq;
    }
    LDS_WAIT(); __syncthreads();
    const int nkb = nkeys >> 5, npass = samp ? 1 : 2;
    const float sinkL = inp(F, 13)[w] * 1.4426950408889634f;
    const LAS unsigned char* kbase = F.lds + kvh * AK_H + hi * AK_C + r32 * 16;
    const LAS unsigned char* vbase = F.lds + A_V0 + kvh * AV_H + (4 * hi + ((lane & 15) >> 2)) * 64 + ((lane >> 4) & 1) * 32 + (lane & 3) * 8;
    LAS float* ssl = (LAS float*)(F.lds + A_SS);
    f32x16 O[2][2];
#pragma unroll
    for (int pass = 0; pass < 2; ++pass) {
        if (pass < npass) {
            const int qrow = row0 + 32 * pass + r32;
            bf16x8 qf[4];
#pragma unroll
            for (int s = 0; s < 4; ++s) qf[s] = *(const bf16x8*)(Q + (size_t)qrow * 512 + w * 64 + 16 * s + 8 * hi);
            f32x16 P[6];
#pragma unroll
            for (int kb = 0; kb < 6; ++kb) {
                if (kb < nkb) {
                    f32x16 a = {};
#pragma unroll
                    for (int s = 0; s < 4; ++s) { const bf16x8 kf = *(const LAS bf16x8*)(kbase + (2 * s) * AK_C + kb * 512); a = __builtin_amdgcn_mfma_f32_32x32x16_bf16(kf, qf[s], a, 0, 0, 0); }
                    P[kb] = a;
                } else {
#pragma unroll
                    for (int r = 0; r < 16; ++r) P[kb][r] = -INFINITY;
                }
            }
            float mx = sinkL;
#pragma unroll
            for (int kb = 0; kb < 6; ++kb)
#pragma unroll
                for (int r = 0; r < 16; ++r) mx = fmaxf(mx, P[kb][r]);
            mx = swap_max(mx);
            float l = 0.f;
#pragma unroll
            for (int kb = 0; kb < 6; ++kb)
#pragma unroll
                for (int r = 0; r < 16; ++r) { const float e = __builtin_amdgcn_exp2f(P[kb][r] - mx); P[kb][r] = e; l += e; }
            l = swap_add(l) + __builtin_amdgcn_exp2f(sinkL - mx);
            f32x16 o0 = {}, o1 = {};
#pragma unroll
            for (int kb = 0; kb < 6; ++kb) {
                if (kb < nkb) {
#pragma unroll
                    for (int s2 = 0; s2 < 2; ++s2) {
                        u32x4 pw; pw.x = cvtpk(P[kb][8 * s2 + 0], P[kb][8 * s2 + 1]); pw.y = cvtpk(P[kb][8 * s2 + 2], P[kb][8 * s2 + 3]); pw.z = cvtpk(P[kb][8 * s2 + 4], P[kb][8 * s2 + 5]); pw.w = cvtpk(P[kb][8 * s2 + 6], P[kb][8 * s2 + 7]);
                        const bf16x8 pb = __builtin_bit_cast(bf16x8, pw);
                        const LAS unsigned char* vp = vbase + (32 * kb + 16 * s2) * 64;
                        const s16x4 a0l = vtr(vp), a0h = vtr(vp + 512), a1l = vtr(vp + AV_D), a1h = vtr(vp + AV_D + 512);
                        const bf16x8 va0 = {a0l[0], a0l[1], a0l[2], a0l[3], a0h[0], a0h[1], a0h[2], a0h[3]}, va1 = {a1l[0], a1l[1], a1l[2], a1l[3], a1h[0], a1h[1], a1h[2], a1h[3]};
                        o0 = __builtin_amdgcn_mfma_f32_32x32x16_bf16(va0, pb, o0, 0, 0, 0);
                        o1 = __builtin_amdgcn_mfma_f32_32x32x16_bf16(va1, pb, o1, 0, 0, 0);
                    }
                }
            }
            const float inv = 1.f / l; float ss = 0.f;
#pragma unroll
            for (int r = 0; r < 16; ++r) { o0[r] *= inv; o1[r] *= inv; ss += o0[r] * o0[r] + o1[r] * o1[r]; }
            ss = swap_add(ss);
            if (hi == 0) ssl[(pass * 32 + r32) * 8 + w] = ss;
            O[pass][0] = o0; O[pass][1] = o1;
        }
    }
    LDS_WAIT(); __syncthreads();
    const float* gain = inp(F, 24) + w * 64;
#pragma unroll
    for (int pass = 0; pass < 2; ++pass) {
        if (pass < npass) {
            const f32x4 s0 = *(const LAS f32x4*)(ssl + (pass * 32 + r32) * 8), s1 = *(const LAS f32x4*)(ssl + (pass * 32 + r32) * 8 + 4);
            const float ra = rsqrtf((((s0[0] + s0[1]) + (s0[2] + s0[3])) + ((s1[0] + s1[1]) + (s1[2] + s1[3]))) * (1.f / 512.f) + EPS);
            bf16_t* op = MG + (size_t)(row0 + 32 * pass + r32) * D + 512 + w * 64;
#pragma unroll
            for (int db = 0; db < 2; ++db)
#pragma unroll
                for (int r4 = 0; r4 < 4; ++r4) { const int d0 = 32 * db + 8 * r4 + 4 * hi; const f32x4 gn = *(const f32x4*)(gain + d0);
                    const f32x16& o = O[pass][db]; u32x2 pk; pk.x = cvtpk(o[4 * r4 + 0] * ra * gn[0], o[4 * r4 + 1] * ra * gn[1]); pk.y = cvtpk(o[4 * r4 + 2] * ra * gn[2], o[4 * r4 + 3] * ra * gn[3]);
                    *(u32x2*)(op + d0) = pk; }
        }
    }
    __syncthreads();
}

__device__ __forceinline__ void p3(Fr& F) {
    const int gw = F.vcu * 8 + F.wave, NGW = F.G * 8, p = F.lane;
    for (int it = gw; it < 512 + 256; it += NGW) {
        if (it < 512) {
            const int b = it >> 5, g = it & 31; const f32x2 L = wsp<f32x2>(F, WS_LAM)[g * 64 + p];
            const float* d0 = wsp<float>(F, WS_DS) + ((size_t)g * 1024 + b * 64) * 128; const float* d1 = d0 + (size_t)32 * 1024 * 128;
            bf16_t* X = wsp<bf16_t>(F, WS_XS) + ((size_t)g * 1024 + b * 64) * XS_LD;
            float hr = 0.f, hi_ = 0.f;
#pragma unroll 8
            for (int c = 0; c < 64; ++c) {
                const float ar = d0[c * 128 + p] + d1[c * 128 + p], ai = d0[c * 128 + 64 + p] + d1[c * 128 + 64 + p];
                X[(size_t)c * XS_LD + p] = (bf16_t)(cvtpk(hr, 0.f) & 0xffffu); X[(size_t)c * XS_LD + 64 + p] = (bf16_t)(cvtpk(hi_, 0.f) & 0xffffu);
                const float nr = L.x * hr - L.y * hi_ + ar, ni = L.x * hi_ + L.y * hr + ai; hr = nr; hi_ = ni;
            }
            *(f32x2*)(outp(F) + O_HP + ((size_t)(b * 32 + g) * 64 + p) * 2) = (f32x2){hr, hi_};
        } else {
            const int sb = (it - 512) >> 5, g = (it - 512) & 31;
            const double are = inp(F, 14)[g * 64 + p], aim = inp(F, 15)[g * 64 + p], dt = exp((double)inp(F, 16)[g]);
            const double e1 = exp(are * dt), l1r = e1 * cos(aim * dt), l1i = e1 * sin(aim * dt);
            const double nr = l1r - 1.0, ni = l1i, den = are * are + aim * aim, fr_ = (nr * are + ni * aim) / den, fi_ = (ni * are - nr * aim) / den;
            float bbr[16], bbi[16];
#pragma unroll
            for (int h = 0; h < 16; ++h) { const double br = inp(F, 17)[(g * 64 + p) * 16 + h], bi = inp(F, 18)[(g * 64 + p) * 16 + h]; bbr[h] = (float)(fr_ * br - fi_ * bi); bbi[h] = (float)(fr_ * bi + fi_ * br); }
            const float lr = (float)l1r, li = (float)l1i;
            float hr = inp(F, 4)[((sb * 32 + g) * 64 + p) * 2], hi_ = inp(F, 4)[((sb * 32 + g) * 64 + p) * 2 + 1];
            LAS float* hs = (LAS float*)(F.lds + F.wave * 16384);
            const float* us = wsp<float>(F, WS_US) + (size_t)sb * 32 * 512 + g * 16;
            for (int t = 0; t < 32; ++t) {
                const f32x4 u0 = *(const f32x4*)(us + t * 512), u1 = *(const f32x4*)(us + t * 512 + 4), u2 = *(const f32x4*)(us + t * 512 + 8), u3 = *(const f32x4*)(us + t * 512 + 12);
                const float uu[16] = {u0[0], u0[1], u0[2], u0[3], u1[0], u1[1], u1[2], u1[3], u2[0], u2[1], u2[2], u2[3], u3[0], u3[1], u3[2], u3[3]};
                float sr = 0.f, si = 0.f;
#pragma unroll
                for (int h = 0; h < 16; ++h) { sr += bbr[h] * uu[h]; si += bbi[h] * uu[h]; }
                const float n_r = lr * hr - li * hi_ + sr, n_i = lr * hi_ + li * hr + si; hr = n_r; hi_ = n_i;
                hs[t * 128 + p] = hr; hs[t * 128 + 64 + p] = hi_;
            }
            *(f32x2*)(outp(F) + O_HS + ((size_t)(sb * 32 + g) * 64 + p) * 2) = (f32x2){hr, hi_};
            LDS_WAIT(); asm volatile("" ::: "memory");
            const int ho = p & 15; const float* Cr = inp(F, 19) + (g * 16 + ho) * 64; const float* Ci = inp(F, 20) + (g * 16 + ho) * 64; const float dsk = inp(F, 21)[g * 16 + ho];
            float y[8];
#pragma unroll
            for (int j = 0; j < 8; ++j) y[j] = 0.f;
            for (int q = 0; q < 64; ++q) { const float cr = Cr[q], ci = Ci[q];
#pragma unroll
                for (int j = 0; j < 8; ++j) { const int t = (p >> 4) + 4 * j; y[j] += cr * hs[t * 128 + q] - ci * hs[t * 128 + 64 + q]; } }
            bf16_t* Gb = wsp<bf16_t>(F, WS_GB);
#pragma unroll
            for (int j = 0; j < 8; ++j) { const int t = (p >> 4) + 4 * j; const float yy = y[j] + dsk * us[t * 512 + ho]; Gb[((size_t)MP + sb * 32 + t) * 512 + g * 16 + ho] = (bf16_t)(cvtpk(gelu_tanh(yy), 0.f) & 0xffffu); }
            LDS_WAIT(); asm volatile("" ::: "memory");
        }
    }
}

__global__ void __launch_bounds__(512, 2) mega_fwd(Args args) {
    extern __shared__ __attribute__((aligned(16))) unsigned char lds_raw[];
    Fr F; F.lds = (LAS unsigned char*)lds_raw; F.tid = threadIdx.x; F.lane = F.tid & 63; F.wave = __builtin_amdgcn_readfirstlane(F.tid >> 6);
    F.G = gridDim.x; { const int bx = blockIdx.x; F.vcu = (F.G % 8 == 0) ? (bx % 8) * (F.G / 8) + bx / 8 : bx; }
    volatile LAS unsigned* MISC = (volatile LAS unsigned*)(F.lds + LDSCTL_OFF);
    for (int u = F.tid; u < (LDS_BYTES - LDSCTL_OFF) / 4; u += 512) ((LAS unsigned*)(F.lds + LDSCTL_OFF))[u] = 0u;
    __syncthreads();
    { const unsigned long long* ka = (const unsigned long long*)__builtin_amdgcn_kernarg_segment_ptr(); if (F.tid < 33) ((LAS unsigned long long*)(F.lds + PARAM_OFF))[F.tid] = ka[F.tid]; }
    LDS_WAIT(); __syncthreads();
    unsigned* ctl = wsp<unsigned>(F, WS_CTL);
    XcdBarrier bar = xcd_barrier_post(ctl + CW_BAR, MISC + 8);
    const int bx = (int)blockIdx.x;

    p0a(F);
    xcd_barrier(bar);
    p0b(F);
    xcd_barrier(bar);
    {
        pg8::Gemm g{wsp<bf16_t>(F, WS_XB), wsp<bf16_t>(F, WS_WIN), D, D, 1}; pg8::StaticOrder S; S.init(M, NIN, D, D, D, F.G, bx);
        EpiIn E{F};
        pg8::gemm_phase<EpiIn, pg8::StaticOrder>(F.lds, g, S, E);
    }
    xcd_barrier(bar);
    {
        for (int u = F.vcu; u < 1024 + DBT; u += F.G) attn_unit(F, u);
        pg8::Gemm g{wsp<bf16_t>(F, WS_XS), wsp<bf16_t>(F, WS_BTS), XS_LD, 1024, 0}; StateOrder S{F.vcu}; EpiState E{F};
        pg8::gemm_phase<EpiState, StateOrder>(F.lds, g, S, E);
    }
    xcd_barrier(bar);
    p3(F);
    xcd_barrier(bar);
    {
        pg8::Gemm g{wsp<bf16_t>(F, WS_XS), wsp<bf16_t>(F, WS_BTY), XS_LD, XS_LD, 1}; YOrder S{F.vcu}; EpiY E{F};
        pg8::gemm_phase<EpiY, YOrder>(F.lds, g, S, E);
    }
    xcd_barrier(bar);
    {
        pg8::Gemm g{wsp<bf16_t>(F, WS_GB), wsp<bf16_t>(F, WS_WGLU), 512, 512, 1}; pg8::StaticOrder S; S.init(M, 512, 512, 512, 512, F.G, bx);
        EpiGlu E{F};
        pg8::gemm_phase<EpiGlu, pg8::StaticOrder>(F.lds, g, S, E);
    }
    xcd_barrier(bar);
    {
        pg8::Gemm g{wsp<bf16_t>(F, WS_MG), wsp<bf16_t>(F, WS_WOUT), D, D, 1}; pg8::StaticOrder S; S.init(M, D, D, D, D, F.G, bx);
        EpiOut E{F};
        pg8::gemm_phase<EpiOut, pg8::StaticOrder>(F.lds, g, S, E);
    }
    xcd_barrier(bar);
    {
        pg8::Gemm g{wsp<bf16_t>(F, WS_A2), wsp<bf16_t>(F, WS_WGU), D, D, 1}; pg8::StaticOrder S; S.init(M, NGU, D, D, D, F.G, bx);
        EpiUp E{F};
        pg8::gemm_phase<EpiUp, pg8::StaticOrder>(F.lds, g, S, E);
    }
    xcd_barrier(bar);
    {
        pg8::Gemm g{wsp<bf16_t>(F, WS_ACT), wsp<bf16_t>(F, WS_WD), FF, FF, 1}; pg8::StaticOrder S; S.init(M, D, FF, FF, FF, F.G, bx);
        EpiDown E{F};
        pg8::gemm_phase<EpiDown, pg8::StaticOrder>(F.lds, g, S, E);
    }
}

extern "C" void kernel_launch(void* const* d_in, const int* in_sizes, int n_in, void* d_out, int out_size, void* d_ws, size_t ws_size, hipStream_t stream) {
    static int ready = 0;
    if (ready == 0) {
        ready = -1;
        if (n_in != 31 || ws_size < WS_END) { fprintf(stderr, "kernel_launch: unexpected n_in %d / ws %zu\n", n_in, ws_size); return; }
        int dev = 0, cus = 0;
        if (hipGetDevice(&dev) != hipSuccess || hipDeviceGetAttribute(&cus, hipDeviceAttributeMultiprocessorCount, dev) != hipSuccess) return;
        if (hipFuncSetAttribute((const void*)mega_fwd, hipFuncAttributeMaxDynamicSharedMemorySize, LDS_BYTES) != hipSuccess) { fprintf(stderr, "kernel_launch: hipFuncSetAttribute failed\n"); return; }
        if (cus != 256) fprintf(stderr, "kernel_launch: %d CUs (built for 256)\n", cus);
        (void)hipGetLastError();
        ready = 1;
    }
    if (ready < 0) return;
    (void)hipMemsetAsync((char*)d_ws + WS_CTL, 0, CTL_ZERO_BYTES, stream);
    Args a{};
    for (int i = 0; i < 31; ++i) a.in[i] = (const float*)d_in[i];
    a.out = (float*)d_out; a.ws = (unsigned char*)d_ws;
    hipLaunchKernelGGL(mega_fwd, dim3(256), dim3(512), LDS_BYTES, stream, a);
}
```

```cpp
#include <hip/hip_runtime.h>
#include <cstdio>
#include <cstdint>
#include <cmath>

#define LAS __attribute__((address_space(3)))
#define GAS __attribute__((address_space(1)))
typedef unsigned short bf16_t;
typedef short bf16x8 __attribute__((ext_vector_type(8)));
typedef short s16x4 __attribute__((ext_vector_type(4)));
typedef float f32x4 __attribute__((ext_vector_type(4)));
typedef float f32x2 __attribute__((ext_vector_type(2)));
typedef float f32x16 __attribute__((ext_vector_type(16)));
typedef unsigned u32x4 __attribute__((ext_vector_type(4)));
typedef unsigned u32x2 __attribute__((ext_vector_type(2)));
typedef __bf16 bf16x2_t __attribute__((ext_vector_type(2)));

constexpr int D = 1024, NB = 16, SEQ = 4096, DBT = 8, DS = 32, PAST = 1024;
constexpr int MP = NB * SEQ, MS = DBT * DS, M = MP + MS;
constexpr int NIN = 1280, FF = 2816, NGU = 2 * FF, NMOD = 6 * D;
constexpr int XS_LD = 1152;
constexpr float EPS = 1e-6f;
constexpr float QSCALE = 0.125f * 1.4426950408889634f;
constexpr size_t O_Y = 0, O_YS = (size_t)MP * D, O_KP = O_YS + (size_t)MS * D, O_VP = O_KP + 262144, O_HP = O_VP + 262144,
                 O_KS = O_HP + 65536, O_VS = O_KS + 32768, O_HS = O_VS + 32768;
constexpr size_t MiB = 1u << 20;
constexpr size_t WS_CTL = 0, CTL_ZERO_BYTES = 64 * 1024;
constexpr size_t WS_MOD = 1 * MiB, WS_BIAS1 = 2 * MiB, WS_BIAS2 = 2 * MiB + 128 * 1024, WS_R1 = 3 * MiB, WS_ROPE = 4 * MiB, WS_SSQ = 5 * MiB, WS_SSQ2 = 8 * MiB,
                 WS_KMAT = 13 * MiB, WS_LAM = 15 * MiB, WS_SH2B = 15 * MiB + 32 * 1024, WS_US = 15 * MiB + 128 * 1024, WS_SSQA = 913 * MiB, WS_KC = 916 * MiB, WS_VC = 917 * MiB,
                 WS_WIN = 16 * MiB, WS_WGLU = 19 * MiB, WS_WOUT = 20 * MiB, WS_WGU = 22 * MiB, WS_WD = 33 * MiB, WS_BTS = 39 * MiB, WS_BTY = 48 * MiB,
                 WS_A2 = 128 * MiB, WS_XB = 257 * MiB, WS_Q = 386 * MiB, WS_KB = 451 * MiB, WS_VB = 468 * MiB, WS_XS = 485 * MiB, WS_DS = 557 * MiB,
                 WS_GB = 589 * MiB, WS_MG = 654 * MiB, WS_ACT = 257 * MiB, WS_X1B = 784 * MiB, WS_END = 918 * MiB;
constexpr int CW_TMO = 0, CW_BAR = 4096, CW_Q = 8192;

__device__ __forceinline__ unsigned cvtpk(float lo, float hi) { f32x2 v = {lo, hi}; bf16x2_t b = __builtin_convertvector(v, bf16x2_t); return __builtin_bit_cast(unsigned, b); }
__device__ __forceinline__ u32x4 pack8(const f32x4& a, const f32x4& b) { u32x4 o; o.x = cvtpk(a[0], a[1]); o.y = cvtpk(a[2], a[3]); o.z = cvtpk(b[0], b[1]); o.w = cvtpk(b[2], b[3]); return o; }
__device__ __forceinline__ float bf2f(unsigned short h) { return __uint_as_float((unsigned)h << 16); }
__device__ __forceinline__ float bflo(unsigned w) { return __uint_as_float(w << 16); }
__device__ __forceinline__ float bfhi(unsigned w) { return __uint_as_float(w & 0xffff0000u); }
__device__ __forceinline__ int modrow_of(int m) { return m < MP ? (m >> 12) : NB + ((m - MP) >> 5); }
__device__ __forceinline__ int pos_of(int m) { return m < MP ? (m & (SEQ - 1)) : PAST + ((m - MP) & (DS - 1)); }
__device__ __forceinline__ float silu_f(float v) { return v * __builtin_amdgcn_rcpf(1.f + __builtin_amdgcn_exp2f(-1.4426950408889634f * v)); }
__device__ __forceinline__ float sigm_f(float v) { return __builtin_amdgcn_rcpf(1.f + __builtin_amdgcn_exp2f(-1.4426950408889634f * v)); }
__device__ __forceinline__ float gelu_tanh(float y) { const float u = 0.7978845608028654f * (y + 0.044715f * y * y * y); const float e = __builtin_amdgcn_exp2f(2.8853900817779268f * u); return y * (1.f - __builtin_amdgcn_rcpf(e + 1.f)); }
__device__ __forceinline__ float wave_sum(float v) {
#pragma unroll
    for (int o = 1; o < 64; o <<= 1) v += __shfl_xor(v, o);
    return v;
}
__device__ __forceinline__ int wq_next(unsigned* ctr) { unsigned v = 0; if ((threadIdx.x & 63) == 0) v = __hip_atomic_fetch_add(ctr, 1u, __ATOMIC_RELAXED, __HIP_MEMORY_SCOPE_AGENT); return (int)__builtin_amdgcn_readfirstlane(v); }
#define LDS_WAIT() asm volatile("s_waitcnt lgkmcnt(0)" ::: "memory")
#define VM_WAIT() asm volatile("s_waitcnt vmcnt(0)" ::: "memory")

namespace pg8 {
constexpr int BM = 256, BK = 64, HALF = 128, HTB = HALF * BK * 2, STAGE_BYTES = 8 * HTB, NXCD = 8, WGM = 8;
__host__ __device__ __forceinline__ int lds_byte(int r, int c) { const int st = (r >> 4) * 2 + (c >> 5), rr = r & 15, cc = c & 31, ob = rr * 64 + cc * 2; return st * 1024 + (ob ^ (((ob >> 9) & 1) << 5)); }
__host__ __device__ __forceinline__ int perm32(int rho) { const int n = rho >> 4, i = rho & 15; return 8 * (i >> 2) + 4 * n + (i & 3); }
__host__ __device__ __forceinline__ void stage_rc(int b, int& R, int& C) { const int st = b / 1024, sb = b % 1024, swz = sb ^ (((sb >> 9) & 1) << 5); R = (st >> 1) * 16 + swz / 64; C = (st & 1) * 32 + (swz % 64) / 2; }

struct Unit { size_t aoff, boff; int pm, pn, nt, aux; };
struct Gemm { const bf16_t* A; const bf16_t* Bt; int lda, ldb; int bhalf; size_t kstepA = 128, hstepA = 0; };

struct StaticOrder {
    int nM, nN, nwg, G, c, nt, rev = 0; size_t ta, tb;
    __device__ void init(int M_, int N_, int K_, int lda, int ldb, int G_, int c_) { nM = M_ / BM; nN = N_ / BM; nwg = nM * nN; G = G_; c = c_; nt = K_ / BK; ta = (size_t)BM * lda * 2; tb = (size_t)BM * ldb * 2; }
    __device__ bool next(int i, Unit& u) const {
        const long L = (long)i * G + c; if (L >= nwg) return false;
        int wgid = (int)L; { const int q = nwg / NXCD, r = nwg % NXCD, xcd = wgid % NXCD, off = wgid / NXCD; wgid = (xcd < r ? xcd * (q + 1) : r * (q + 1) + (xcd - r) * q) + off; }
        const int nig = WGM * nN, gid = wgid / nig, fm = gid * WGM, gsz = (nM - fm) < WGM ? (nM - fm) : WGM;
        u.pm = fm + ((wgid % nig) % gsz); if (rev) u.pm = nM - 1 - u.pm; u.pn = (wgid % nig) / gsz; u.aoff = (size_t)u.pm * ta; u.boff = (size_t)u.pn * tb; u.nt = nt; u.aux = 0; return true;
    }
};

template <class Epi, class Sched>
__device__ __forceinline__ void gemm_phase(LAS unsigned char* lds, const Gemm g, const Sched& S, const Epi& E) {
    int tid_ = threadIdx.x; asm volatile("" : "+v"(tid_));
    const int tid = tid_, wid = __builtin_amdgcn_readfirstlane(tid >> 6), lane = tid & 63, wr = wid >> 2, wc = wid & 3, fr = lane & 15, fq = lane >> 4;
    unsigned voffA[2], voffB[2];
#pragma unroll
    for (int i = 0; i < 2; ++i) { int R, C; stage_rc(tid * 16 + i * 8192, R, C); const int Rb = (R & ~31) + perm32(R & 31); voffA[i] = (unsigned)(R * g.lda + C) * 2u; voffB[i] = (unsigned)(Rb * g.ldb + C) * 2u; }
    const size_t kstep = (size_t)(BK * 2), kstepA = g.kstepA;
    const size_t hstepA = g.hstepA ? g.hstepA : (size_t)HALF * g.lda * 2, hstepB = g.bhalf ? (size_t)HALF * g.ldb * 2 : 0;
    const unsigned ldsw = (unsigned)wid * 1024u;
    const int aoff = lds_byte(wr * 64 + fr, fq * 8), boff = lds_byte(wc * 32 + fr, fq * 8);
#define PG8_SA(b, h) (((b) * 2 + (h)) * HTB)
#define PG8_SB(b, h) ((4 + (b) * 2 + (h)) * HTB)
#define PG8_STAGE(bufoff, gbase, voff) do { _Pragma("unroll") for (int _i = 0; _i < 2; ++_i) \
        __builtin_amdgcn_global_load_lds((const unsigned*)((const char*)(gbase) + (voff)[_i]), (LAS unsigned*)(lds + (bufoff) + ldsw + _i * 8192), 16, 0, 0); } while (0)
#define PG8_LDA(dst, b, h) do { _Pragma("unroll") for (int m = 0; m < 4; ++m) _Pragma("unroll") for (int k = 0; k < 2; ++k) dst[m][k] = *(const LAS bf16x8*)(lds + PG8_SA(b, h) + aoff + m * 2048 + k * 1024); } while (0)
#define PG8_LDB(dst, b, h) do { _Pragma("unroll") for (int n = 0; n < 2; ++n) _Pragma("unroll") for (int k = 0; k < 2; ++k) dst[n][k] = *(const LAS bf16x8*)(lds + PG8_SB(b, h) + boff + n * 2048 + k * 1024); } while (0)
#define PG8_MMA(ai, bj, At, Bt) do { __builtin_amdgcn_s_setprio(1); _Pragma("unroll") for (int m = 0; m < 4; ++m) _Pragma("unroll") for (int n = 0; n < 2; ++n) _Pragma("unroll") for (int k = 0; k < 2; ++k) \
        acc[ai][bj][m][n] = __builtin_amdgcn_mfma_f32_16x16x32_bf16(Bt[n][k], At[m][k], acc[ai][bj][m][n], 0, 0, 0); __builtin_amdgcn_s_setprio(0); } while (0)
#define PG8_WAIT_V(n) asm volatile("s_waitcnt vmcnt(" #n ")" ::: "memory")
#define PG8_WAIT_L(n) asm volatile("s_waitcnt lgkmcnt(" #n ")" ::: "memory")
#define PG8_BAR __builtin_amdgcn_s_barrier()
#define PG8_SCHED __builtin_amdgcn_sched_barrier(0)
    Unit cur, nxt; int ui = 0;
    if (!S.next(0, cur)) return;
    f32x4 acc[2][2][4][2];
#pragma unroll
    for (int a = 0; a < 2; ++a)
#pragma unroll
        for (int b = 0; b < 2; ++b)
#pragma unroll
            for (int m = 0; m < 4; ++m)
#pragma unroll
                for (int n = 0; n < 2; ++n) acc[a][b][m][n] = (f32x4){0.f, 0.f, 0.f, 0.f};
    bf16x8 At[4][2], B0[2][2], B1[2][2];
    const char* cA = (const char*)g.A + cur.aoff; const char* cB = (const char*)g.Bt + cur.boff;
    PG8_STAGE(PG8_SB(0, 0), cB, voffB); PG8_STAGE(PG8_SB(0, 1), cB + hstepB, voffB); PG8_STAGE(PG8_SA(0, 0), cA, voffA); PG8_STAGE(PG8_SA(0, 1), cA + hstepA, voffA);
    if (wr == 1) PG8_BAR;
    PG8_WAIT_V(2); PG8_BAR;
    PG8_STAGE(PG8_SB(1, 0), cB + kstep, voffB); PG8_STAGE(PG8_SA(1, 0), cA + kstepA, voffA); PG8_STAGE(PG8_SB(1, 1), cB + hstepB + kstep, voffB);
    PG8_WAIT_V(6); PG8_BAR;
    for (;;) {
        const bool has_next = S.next(ui + 1, nxt);
        const char* nA = has_next ? (const char*)g.A + nxt.aoff : cA; const char* nB = has_next ? (const char*)g.Bt + nxt.boff : cB;
        const int nt = cur.nt;
        for (int t = 0; t < nt; t += 2) {
            const bool last = (t == nt - 2);
            const char* a1 = cA + (size_t)(t + 1) * kstepA;
            const char* a2 = last ? nA : cA + (size_t)(t + 2) * kstepA; const char* b2 = last ? nB : cB + (size_t)(t + 2) * kstep;
            const char* a3 = a2 + kstepA; const char* b3 = b2 + kstep;
            if constexpr (Epi::HAS_MID) { if (t == Epi::MID_T) { int fr_ = fr, fq_ = fq; asm volatile("" : "+v"(fr_), "+v"(fq_)); E.mid(acc, cur, wr, wc, fr_, fq_); } }
            PG8_LDB(B0, 0, 0); PG8_LDB(B1, 0, 1); PG8_SCHED; PG8_LDA(At, 0, 0); PG8_STAGE(PG8_SA(1, 1), a1 + hstepA, voffA);
            PG8_WAIT_V(8); PG8_WAIT_L(0); PG8_BAR; PG8_MMA(0, 0, At, B0); PG8_MMA(0, 1, At, B1); PG8_BAR; PG8_SCHED;
            PG8_LDA(At, 0, 1); PG8_STAGE(PG8_SB(0, 0), b2, voffB); PG8_STAGE(PG8_SB(0, 1), b2 + hstepB, voffB); PG8_STAGE(PG8_SA(0, 0), a2, voffA);
            PG8_WAIT_V(8); PG8_WAIT_L(0); PG8_BAR; PG8_MMA(1, 0, At, B0); PG8_MMA(1, 1, At, B1); PG8_BAR; PG8_SCHED;
            PG8_LDB(B0, 1, 0); PG8_LDB(B1, 1, 1); PG8_SCHED; PG8_LDA(At, 1, 0); PG8_STAGE(PG8_SA(0, 1), a2 + hstepA, voffA);
            PG8_WAIT_V(8); PG8_WAIT_L(0); PG8_BAR; PG8_MMA(0, 0, At, B0); PG8_MMA(0, 1, At, B1); PG8_BAR; PG8_SCHED;
            PG8_LDA(At, 1, 1); PG8_STAGE(PG8_SB(1, 0), b3, voffB); PG8_STAGE(PG8_SB(1, 1), b3 + hstepB, voffB); PG8_STAGE(PG8_SA(1, 0), a3, voffA);
            PG8_WAIT_V(8); PG8_WAIT_L(0); PG8_BAR; PG8_MMA(1, 0, At, B0); PG8_MMA(1, 1, At, B1); PG8_BAR; PG8_SCHED;
        }
        if (wr == 0) PG8_BAR;
        { int fr_ = fr, fq_ = fq; asm volatile("" : "+v"(fr_), "+v"(fq_)); E(acc, cur, wr, wc, fr_, fq_);
#ifdef PROBE_EPI2
          if constexpr (Epi::EPI2) { asm volatile("" : "+v"(fr_), "+v"(fq_) :: "memory"); E(acc, cur, wr, wc, fr_, fq_); }
#endif
        }
        if (!has_next) break;
#pragma unroll
        for (int a = 0; a < 2; ++a)
#pragma unroll
            for (int b = 0; b < 2; ++b)
#pragma unroll
                for (int m = 0; m < 4; ++m)
#pragma unroll
                    for (int n = 0; n < 2; ++n) acc[a][b][m][n] = (f32x4){0.f, 0.f, 0.f, 0.f};
        cur = nxt; cA = nA; cB = nB; ++ui;
        if (wr == 1) PG8_BAR;
    }
    PG8_WAIT_V(0);
    PG8_BAR;
#undef PG8_SA
#undef PG8_SB
#undef PG8_STAGE
#undef PG8_LDA
#undef PG8_LDB
#undef PG8_MMA
#undef PG8_WAIT_V
#undef PG8_WAIT_L
#undef PG8_BAR
#undef PG8_SCHED
}
}

#define XB_TMO      128
#define XB_XCNT(j)  (256  + 64 * (j))
#define XB_XSUB(j)  (1280 + 64 * (j))
#define XB_XGEN(j)  (2304 + 64 * (j))
#define XB_TOP      3328
#define XB_TOPGEN   3392
#define XCD_BAR_WORDS 3456
#define XB_SPIN_CAP (1u << 18)
__device__ __forceinline__ unsigned xb_ld(unsigned* p)              { return __hip_atomic_load(p, __ATOMIC_RELAXED, __HIP_MEMORY_SCOPE_AGENT); }
__device__ __forceinline__ unsigned xb_add(unsigned* p, unsigned v) { return __hip_atomic_fetch_add(p, v, __ATOMIC_RELAXED, __HIP_MEMORY_SCOPE_AGENT); }
__device__ __forceinline__ unsigned xb_xcc_id() { return (unsigned)__builtin_amdgcn_s_getreg((3 << 11) | 20) & 0xFu; }
#define XB_SPIN(cond, bar) do { unsigned _sp = 0; while (cond) { __builtin_amdgcn_s_sleep(1); \
    if ((++_sp & 255u) == 0u) { if (xb_ld(&(bar)[XB_TMO])) break; if (_sp > XB_SPIN_CAP) { atomicAdd(&(bar)[XB_TMO], 1u); break; } } } } while (0)
struct XcdBarrier { unsigned* bar; unsigned x; volatile LAS unsigned* st; };
__device__ __forceinline__ XcdBarrier xcd_barrier_post(unsigned* bar, volatile LAS unsigned* st) {
    XcdBarrier b; b.bar = bar; b.x = xb_xcc_id(); b.st = st;
    if (threadIdx.x == 0) (void)xb_add(&bar[XB_XCNT(b.x)], 1u);
    return b;
}
__device__ __forceinline__ void xcd_barrier_complete(unsigned* bar, unsigned x, unsigned& nloc, unsigned& nx) {
    const unsigned G = gridDim.x * gridDim.y * gridDim.z;
    unsigned sum, cnt, mine, sp = 0u;
    for (;;) {
        sum = 0u; cnt = 0u; mine = 0u;
#pragma unroll
        for (unsigned j = 0; j < 16; ++j) { const unsigned c = xb_ld(&bar[XB_XCNT(j)]); sum += c; cnt += (c > 0u) ? 1u : 0u; mine = (j == x) ? c : mine; }
        if (sum == G) break;
        __builtin_amdgcn_s_sleep(1);
        if ((++sp & 255u) == 0u) { if (xb_ld(&bar[XB_TMO])) break; if (sp > XB_SPIN_CAP) { atomicAdd(&bar[XB_TMO], 1u); break; } }
    }
    nloc = mine > 0u ? mine : 1u; nx = cnt > 0u ? cnt : 1u;
}
__device__ __forceinline__ void xcd_barrier(const XcdBarrier& b) {
    asm volatile("s_waitcnt vmcnt(0)" ::: "memory");
    __syncthreads();
    if (threadIdx.x == 0) {
        unsigned* bar = b.bar;
        __builtin_amdgcn_s_waitcnt(0);
        unsigned nloc = b.st[0], nx = b.st[1];
        if (nloc == 0u) { xcd_barrier_complete(bar, b.x, nloc, nx); b.st[0] = nloc; b.st[1] = nx; }
        const unsigned old = xb_add(&bar[XB_XSUB(b.x)], 1u);
        const unsigned gen = old / nloc;
        if (old + 1u == (gen + 1u) * nloc) {
            __builtin_amdgcn_fence(__ATOMIC_RELEASE, "agent");
            asm volatile("s_waitcnt vmcnt(0)" ::: "memory");
            const unsigned og = xb_add(&bar[XB_TOP], 1u);
            const unsigned tg = og / nx;
            if (og + 1u == (tg + 1u) * nx) xb_add(&bar[XB_TOPGEN], 1u);
            else XB_SPIN(xb_ld(&bar[XB_TOPGEN]) == tg, bar);
            __builtin_amdgcn_fence(__ATOMIC_ACQUIRE, "agent");
            xb_add(&bar[XB_XGEN(b.x)], 1u);
            asm volatile("s_waitcnt vmcnt(0)" ::: "memory");
        } else {
            XB_SPIN(xb_ld(&bar[XB_XGEN(b.x)]) == gen, bar);
            __builtin_amdgcn_fence(__ATOMIC_ACQUIRE, "agent");
            asm volatile("s_waitcnt vmcnt(0)" ::: "memory");
        }
    }
    __syncthreads();
}

constexpr int RING_BYTES = 131072, LDSCTL_OFF = RING_BYTES, LDS_BYTES = 147456;
struct Args { const float* in[31]; float* out; unsigned char* ws; };
constexpr int PARAM_OFF = LDSCTL_OFF + 256;
struct Fr { LAS unsigned char* lds; int tid, lane, wave, vcu, G; };
__device__ __forceinline__ unsigned long long ldparam(const Fr& F, int i) { const LAS unsigned* p = (const LAS unsigned*)(F.lds + PARAM_OFF) + 2 * i;
    const unsigned lo = __builtin_amdgcn_readfirstlane(p[0]), hi = __builtin_amdgcn_readfirstlane(p[1]); return ((unsigned long long)hi << 32) | lo; }
__device__ __forceinline__ const float* inp(const Fr& F, int i) { return (const float*)(const GAS float*)ldparam(F, i); }
__device__ __forceinline__ float* outp(const Fr& F) { return (float*)(GAS float*)ldparam(F, 31); }
template <class T> __device__ __forceinline__ T* wsp(const Fr& F, size_t off) { return (T*)(GAS T*)(ldparam(F, 32) + off); }

__device__ __forceinline__ int in_srccol(int n) {
    const int pn = n >> 8, c = n & 255, bj = c >> 7, wc = (c >> 5) & 3, i = c & 31;
    if (pn < 2) return 64 * (4 * pn + wc) + 32 * bj + i;
    if (pn == 2) return (wc < 2 ? 512 + 64 * wc : 640 + 64 * (wc - 2)) + 32 * bj + i;
    return 768 + 256 * (pn - 3) + c;
}
__device__ __forceinline__ int gu_ff(int n) { return 128 * (n >> 8) + (n & 127); }

__device__ __forceinline__ void tr_item(const float* W, int ldw, int k0, int scol0, bf16_t* WT, int drow0, int ldt, int dk0, LAS float* scr, int lane) {
#pragma unroll 8
    for (int i = 0; i < 32; ++i) { const int kk = 2 * i + (lane >> 5); scr[kk * 33 + (lane & 31)] = W[(size_t)(k0 + kk) * ldw + scol0 + (lane & 31)]; }
    LDS_WAIT(); asm volatile("" ::: "memory");
    const int c = lane & 7;
#pragma unroll
    for (int j = 0; j < 4; ++j) { const int n = (lane >> 3) + 8 * j; const LAS float* s = scr + (8 * c) * 33 + n;
        u32x4 o; o.x = cvtpk(s[0 * 33], s[1 * 33]); o.y = cvtpk(s[2 * 33], s[3 * 33]); o.z = cvtpk(s[4 * 33], s[5 * 33]); o.w = cvtpk(s[6 * 33], s[7 * 33]);
        *(u32x4*)(WT + (size_t)(drow0 + n) * ldt + dk0 + 8 * c) = o; }
    LDS_WAIT(); asm volatile("" ::: "memory");
}
template <int MODE> __device__ __forceinline__ void gemv24(Fr& F, int item) {
    const int cl = F.lane & 31, kh = F.lane >> 5, n = 32 * item + cl; const float* W; int ldw, sc;
    if (MODE == 0) { W = inp(F, 7); ldw = NMOD; sc = n; } else if (MODE == 1) { W = inp(F, 10); ldw = NIN; sc = in_srccol(n); } else { W = ((item >> 2) & 1) ? inp(F, 29) : inp(F, 28); ldw = FF; sc = gu_ff(n); }
    const float* mod = wsp<float>(F, WS_MOD);
    float acc[24];
#pragma unroll
    for (int r = 0; r < 24; ++r) acc[r] = 0.f;
    LAS float* svl = (LAS float*)(F.lds + 32768) + F.wave * (128 * 24);
    const int k0 = 128 * F.wave;
    {
        const float* rp; size_t rstride;
        if (MODE == 0) { rp = inp(F, 5) + k0 + F.lane; rstride = D; } else { rp = mod + (MODE == 2 ? 3 * D : 0) + k0 + F.lane; rstride = NMOD; }
        const float* rp2 = inp(F, 6) + k0 + F.lane;
#pragma unroll
        for (int h = 0; h < 2; ++h) { float v[24];
#pragma unroll 24
            for (int r = 0; r < 24; ++r) v[r] = (MODE == 0 && r >= NB) ? rp2[(size_t)(r - NB) * D + 64 * h] : rp[(size_t)r * rstride + 64 * h];
#pragma unroll
            for (int r = 0; r < 24; ++r) svl[(F.lane + 64 * h) * 24 + r] = MODE == 0 ? silu_f(v[r]) : v[r]; }
        LDS_WAIT(); asm volatile("" ::: "memory"); }
    {
        float wv[64];
#pragma unroll
        for (int q = 0; q < 64; ++q) wv[q] = W[(size_t)(k0 + 2 * q + kh) * ldw + sc];
#pragma unroll
        for (int q = 0; q < 64; ++q) {
#pragma unroll
            for (int i = 0; i < 6; ++i) { const f32x4 sv4 = *(const LAS f32x4*)(svl + (2 * q + kh) * 24 + 4 * i);
#pragma unroll
                for (int j = 0; j < 4; ++j) acc[4 * i + j] += sv4[j] * wv[q]; } }
    }
    LDS_WAIT(); asm volatile("" ::: "memory");
#pragma unroll
    for (int r = 0; r < 24; ++r) acc[r] += __shfl_xor(acc[r], 32);
    LAS float* red = (LAS float*)F.lds;
    if (kh == 0) {
#pragma unroll
        for (int r = 0; r < 24; ++r) red[(F.wave * 24 + r) * 32 + cl] = acc[r]; }
    LDS_WAIT(); __syncthreads();
    for (int o = F.tid; o < 24 * 32; o += 512) { const int r = o >> 5, cc = o & 31; float t = 0.f;
#pragma unroll
        for (int w = 0; w < 8; ++w) t += red[(w * 24 + r) * 32 + cc];
        if (MODE == 0) wsp<float>(F, WS_MOD)[r * NMOD + 32 * item + cc] = t + inp(F, 8)[32 * item + cc];
        else if (MODE == 1) wsp<float>(F, WS_BIAS1)[r * NIN + 32 * item + cc] = t;
        else wsp<float>(F, WS_BIAS2)[r * NGU + 32 * item + cc] = t; }
    LDS_WAIT(); __syncthreads();
}
__device__ __forceinline__ void p0_item(Fr& F, int it) {
    LAS float* scr = (LAS float*)(F.lds + F.wave * 16384);
    constexpr int I_IN = 16 * 40, I_GLU = 8 * 16, I_OUT = 16 * 32, I_GU = 16 * 176, I_D = 44 * 32, I_TR = I_IN + I_GLU + I_OUT + I_GU + I_D, I_SSM = 32 * 65;
        int r = it < I_SSM ? it + I_TR : it - I_SSM;
        if (r < I_IN) { const int kb = r / 40, nb = r % 40; tr_item(inp(F, 10), NIN, 64 * kb, in_srccol(32 * nb), wsp<bf16_t>(F, WS_WIN), 32 * nb, D, 64 * kb, scr, F.lane); return; } r -= I_IN;
        if (r < I_GLU) { const int kb = r / 16, nb = r % 16; tr_item(inp(F, 22), 512, 64 * kb, 32 * nb, wsp<bf16_t>(F, WS_WGLU), 32 * nb, 512, 64 * kb, scr, F.lane); return; } r -= I_GLU;
        if (r < I_OUT) { const int kb = r / 32, nb = r % 32; tr_item(inp(F, 26), D, 64 * kb, 32 * nb, wsp<bf16_t>(F, WS_WOUT), 32 * nb, D, (64 * kb + 512) & 1023, scr, F.lane); return; } r -= I_OUT;
        if (r < I_GU) { const int kb = r / 176, nb = r % 176, n0 = 32 * nb; const int bj = (n0 >> 7) & 1; tr_item(bj ? inp(F, 29) : inp(F, 28), FF, 64 * kb, gu_ff(n0), wsp<bf16_t>(F, WS_WGU), n0, D, 64 * kb, scr, F.lane); return; } r -= I_GU;
        if (r < I_D) { const int kb = r / 32, nb = r % 32; tr_item(inp(F, 30), D, 64 * kb, 32 * nb, wsp<bf16_t>(F, WS_WD), 32 * nb, FF, 64 * kb, scr, F.lane); return; } r -= I_D;
        {
            const int g = r / 65, tau = r % 65, p = F.lane;
            const float are = inp(F, 14)[g * 64 + p], aim = inp(F, 15)[g * 64 + p], dt = __expf(inp(F, 16)[g]);
            const float x1 = are * dt, y1 = aim * dt, ex1 = expm1f(x1), sh = sinf(0.5f * y1), cy = cosf(y1), sy = sinf(y1);
            const float nr = ex1 * cy - 2.f * sh * sh, ni = (ex1 + 1.f) * sy, den = are * are + aim * aim, fr_ = (nr * are + ni * aim) / den, fi_ = (ni * are - nr * aim) / den;
            const float et = __expf(x1 * (float)tau), rev = __builtin_amdgcn_fractf(y1 * (float)tau * 0.15915494309189535f);
            const float wrf = et * __builtin_amdgcn_cosf(rev), wif = et * __builtin_amdgcn_sinf(rev);
            if (tau == 64) { f32x2* L = wsp<f32x2>(F, WS_LAM); L[g * 64 + p] = (f32x2){wrf, wif}; return; }
            float er[16], ei[16];
#pragma unroll
            for (int h = 0; h < 16; ++h) { const float br = inp(F, 17)[(g * 64 + p) * 16 + h], bi = inp(F, 18)[(g * 64 + p) * 16 + h];
                const float bbr = fr_ * br - fi_ * bi, bbi = fr_ * bi + fi_ * br; er[h] = wrf * bbr - wif * bbi; ei[h] = wrf * bbi + wif * bbr; }
            { bf16_t* S = wsp<bf16_t>(F, WS_BTS) + (size_t)g * 128 * 1024; const int s = 63 - tau;
              u32x4 a0, a1, b0, b1;
              a0.x = cvtpk(er[0], er[1]); a0.y = cvtpk(er[2], er[3]); a0.z = cvtpk(er[4], er[5]); a0.w = cvtpk(er[6], er[7]);
              a1.x = cvtpk(er[8], er[9]); a1.y = cvtpk(er[10], er[11]); a1.z = cvtpk(er[12], er[13]); a1.w = cvtpk(er[14], er[15]);
              b0.x = cvtpk(ei[0], ei[1]); b0.y = cvtpk(ei[2], ei[3]); b0.z = cvtpk(ei[4], ei[5]); b0.w = cvtpk(ei[6], ei[7]);
              b1.x = cvtpk(ei[8], ei[9]); b1.y = cvtpk(ei[10], ei[11]); b1.z = cvtpk(ei[12], ei[13]); b1.w = cvtpk(ei[14], ei[15]);
              *(u32x4*)(S + (size_t)p * 1024 + s * 16) = a0; *(u32x4*)(S + (size_t)p * 1024 + s * 16 + 8) = a1;
              *(u32x4*)(S + (size_t)(64 + p) * 1024 + s * 16) = b0; *(u32x4*)(S + (size_t)(64 + p) * 1024 + s * 16 + 8) = b1; }
            if (tau >= 1) { bf16_t* Y = wsp<bf16_t>(F, WS_BTY) + (size_t)g * 1024 * XS_LD; const int t = tau - 1;
#pragma unroll
                for (int ho = 0; ho < 16; ++ho) { const float cr = inp(F, 19)[(g * 16 + ho) * 64 + p], ci = inp(F, 20)[(g * 16 + ho) * 64 + p];
                    const float kr = cr * wrf - ci * wif, ki = -(cr * wif + ci * wrf);
                    Y[(size_t)(t * 16 + ho) * XS_LD + p] = (bf16_t)(cvtpk(kr, 0.f) & 0xffffu); Y[(size_t)(t * 16 + ho) * XS_LD + 64 + p] = (bf16_t)(cvtpk(ki, 0.f) & 0xffffu); } }
            LAS float* Es = scr;
#pragma unroll
            for (int h = 0; h < 16; ++h) { Es[p * 32 + h] = er[h]; Es[p * 32 + 16 + h] = ei[h]; }
            LDS_WAIT(); asm volatile("" ::: "memory");
            { const int ho = F.lane >> 2, h0 = 4 * (F.lane & 3); f32x4 a = {0.f, 0.f, 0.f, 0.f};
              const float* Cr = inp(F, 19) + (g * 16 + ho) * 64; const float* Ci = inp(F, 20) + (g * 16 + ho) * 64;
#pragma unroll 16
              for (int q = 0; q < 64; ++q) { const float cr = Cr[q], ci = Ci[q]; const f32x4 e_r = *(const LAS f32x4*)(Es + q * 32 + h0), e_i = *(const LAS f32x4*)(Es + q * 32 + 16 + h0); a += cr * e_r - ci * e_i; }
              if (tau == 0) {
#pragma unroll
                  for (int j = 0; j < 4; ++j) if (h0 + j == ho) a[j] += inp(F, 21)[g * 16 + ho]; }
              *(f32x4*)(wsp<float>(F, WS_KMAT) + ((size_t)(g * 64 + tau) * 16 + ho) * 16 + h0) = a; }
            LDS_WAIT(); asm volatile("" ::: "memory");
        }
}
constexpr int P0_NITEMS = 16 * 40 + 8 * 16 + 16 * 32 + 16 * 176 + 44 * 32 + 32 * 65, P0_STATIC_A = 64 * 8;
__device__ __forceinline__ void p0a(Fr& F) {
    if (F.vcu < 192) { gemv24<0>(F, F.vcu);
#ifdef PROBE_GEMV2
        gemv24<0>(F, F.vcu); gemv24<0>(F, F.vcu);
#endif
    } else p0_item(F, (F.vcu - 192) * 8 + F.wave);
}
__device__ __forceinline__ void toeplitz_rows16(Fr& F, int r0) {
    const int g = r0 >> 10, t = (r0 >> 4) & 63; const int ncol = 256 * ((t >> 4) + 1);
    bf16_t* Y = wsp<bf16_t>(F, WS_BTY) + ((size_t)g * 1024 + (r0 & 1023)) * XS_LD + 128; const float* KM = wsp<float>(F, WS_KMAT) + (size_t)g * 64 * 256;
    for (int c0 = 8 * F.lane; c0 < ncol; c0 += 512) { const int s = c0 >> 4, h0 = c0 & 15; const bool nz = s <= t; const float* kp = KM + (size_t)(nz ? t - s : 0) * 256 + h0;
#pragma unroll
        for (int hb = 0; hb < 16; hb += 4) { f32x4 a[4], b[4];
#pragma unroll
            for (int q = 0; q < 4; ++q) { a[q] = *(const f32x4*)(kp + (hb + q) * 16); b[q] = *(const f32x4*)(kp + (hb + q) * 16 + 4); }
#pragma unroll
            for (int q = 0; q < 4; ++q) { u32x4 o = {0u, 0u, 0u, 0u}; if (nz) o = pack8(a[q], b[q]); *(u32x4*)(Y + (size_t)(hb + q) * XS_LD + c0) = o; } }
    }
}
__device__ __forceinline__ void p0_rows16(Fr& F, int ch) {
    const float* g1 = inp(F, 9); const float* modp = wsp<float>(F, WS_MOD); float* r1p = wsp<float>(F, WS_R1); bf16_t* xb = wsp<bf16_t>(F, WS_XB); const float* xpp = inp(F, 0); const float* xsp = inp(F, 1);
    for (int it = 16 * ch; it < 16 * ch + 16; it += 2) {
        const int m0 = it, m1 = it + 1; const bool two = true;
        const float* xr0 = m0 < MP ? xpp + (size_t)m0 * D : xsp + (size_t)(m0 - MP) * D;
        const int m1c = two ? m1 : m0; const float* xr1 = m1c < MP ? xpp + (size_t)m1c * D : xsp + (size_t)(m1c - MP) * D;
        f32x4 v0[4], v1[4]; float s0 = 0.f, s1 = 0.f;
#pragma unroll
        for (int j = 0; j < 4; ++j) { v0[j] = *(const f32x4*)(xr0 + 256 * j + 4 * F.lane); v1[j] = *(const f32x4*)(xr1 + 256 * j + 4 * F.lane); }
#pragma unroll
        for (int j = 0; j < 4; ++j) { s0 += (v0[j].x * v0[j].x + v0[j].y * v0[j].y) + (v0[j].z * v0[j].z + v0[j].w * v0[j].w); s1 += (v1[j].x * v1[j].x + v1[j].y * v1[j].y) + (v1[j].z * v1[j].z + v1[j].w * v1[j].w); }
        s0 = wave_sum(s0); s1 = wave_sum(s1);
        if (F.lane == 0) { r1p[m0] = rsqrtf(s0 * (1.f / D) + EPS); if (two) r1p[m1] = rsqrtf(s1 * (1.f / D) + EPS); }
        const float* sc0 = modp + (size_t)modrow_of(m0) * NMOD + D; const float* sc1 = modp + (size_t)modrow_of(m1c) * NMOD + D;
#pragma unroll
        for (int j = 0; j < 4; ++j) { const int k = 256 * j + 4 * F.lane; const f32x4 gg = *(const f32x4*)(g1 + k);
            const f32x4 w0 = v0[j] * gg * (1.f + *(const f32x4*)(sc0 + k)); u32x2 p0; p0.x = cvtpk(w0[0], w0[1]); p0.y = cvtpk(w0[2], w0[3]); *(u32x2*)(xb + (size_t)m0 * D + k) = p0;
            if (two) { const f32x4 w1 = v1[j] * gg * (1.f + *(const f32x4*)(sc1 + k)); u32x2 p1; p1.x = cvtpk(w1[0], w1[1]); p1.y = cvtpk(w1[2], w1[3]); *(u32x2*)(xb + (size_t)m1 * D + k) = p1; } }
    }
}
__device__ __forceinline__ void p0b(Fr& F) {
    const int gw = F.vcu * 8 + F.wave, NGW = F.G * 8;
    if (F.vcu < NIN / 32) gemv24<1>(F, F.vcu);
    else if (F.vcu == F.G - 2) {
        const float* ck = inp(F, 2); const float* cv = inp(F, 3); bf16_t* kc = wsp<bf16_t>(F, WS_KC); bf16_t* vc = wsp<bf16_t>(F, WS_VC);
        for (int i = F.tid; i < DBT * 128 * 128 / 4; i += 512) { const f32x4 a = *(const f32x4*)(ck + 4 * i), b = *(const f32x4*)(cv + 4 * i); u32x2 p; p.x = cvtpk(a[0], a[1]); p.y = cvtpk(a[2], a[3]); *(u32x2*)(kc + 4 * i) = p; p.x = cvtpk(b[0], b[1]); p.y = cvtpk(b[2], b[3]); *(u32x2*)(vc + 4 * i) = p; } }
    else if (F.vcu == F.G - 1) {
        const float* md = wsp<float>(F, WS_MOD); bf16_t* o = wsp<bf16_t>(F, WS_SH2B);
        for (int i = F.tid; i < 32 * D; i += 512) { const int r = i >> 10, k = i & 1023; o[i] = r < 24 ? (bf16_t)(cvtpk(md[(size_t)r * NMOD + 3 * D + k], 0.f) & 0xffffu) : (bf16_t)0; } }
    unsigned* q0 = wsp<unsigned>(F, WS_CTL) + CW_Q; unsigned* q1 = q0 + 64;
    int ch = gw, ib = P0_STATIC_A + 2 * gw; bool rows_left = true, items_left = true;
    while (rows_left || items_left) {
        if (rows_left) { if (ch < M / 16) { p0_rows16(F, ch);
#ifdef PROBE_ROWS2
            asm volatile("" ::: "memory"); p0_rows16(F, ch);
#endif
            ch = NGW + wq_next(q1); } else rows_left = false; }
        if (items_left) { if (ib < P0_NITEMS) { p0_item(F, ib); if (ib + 1 < P0_NITEMS) p0_item(F, ib + 1);
#ifdef PROBE_ITEMS2
            asm volatile("" ::: "memory"); p0_item(F, ib); if (ib + 1 < P0_NITEMS) p0_item(F, ib + 1);
#endif
 ib = P0_STATIC_A + 2 * NGW + 2 * wq_next(q0); } else items_left = false; }
    }
}

#define RG_ROW(u, rg) ((u).pm * 256 + ((rg) >> 2) * 128 + wr * 64 + ((rg) & 3) * 16 + fr)
constexpr int R2TAB_OFF = LDSCTL_OFF + 6144;
constexpr int TAB_OFF = LDSCTL_OFF + 2048;
template <int NP> __device__ __forceinline__ LAS float* row_factor_table(const Fr& F, const float* part, const pg8::Unit& u, int wr, int wc, float inv_div) {
    LAS float* tab = (LAS float*)(F.lds + TAB_OFF) + (wr * 4 + wc) * 128; const int lane = F.lane;
    f32x4 p0[NP / 4], p1[NP / 4];
    const int r0 = u.pm * 256 + wr * 64 + lane, r1 = r0 + 128;
#pragma unroll
    for (int i = 0; i < NP / 4; ++i) { p0[i] = *(const f32x4*)(part + (size_t)r0 * NP + 4 * i); p1[i] = *(const f32x4*)(part + (size_t)r1 * NP + 4 * i); }
    float s0 = 0.f, s1 = 0.f;
#pragma unroll
    for (int i = 0; i < NP / 4; ++i) { s0 += (p0[i][0] + p0[i][1]) + (p0[i][2] + p0[i][3]); s1 += (p1[i][0] + p1[i][1]) + (p1[i][2] + p1[i][3]); }
    tab[lane] = rsqrtf(s0 * inv_div + EPS); tab[64 + lane] = rsqrtf(s1 * inv_div + EPS);
    LDS_WAIT(); asm volatile("" ::: "memory");
    return tab;
}

struct EpiIn {
    static constexpr bool EPI2 = false;
    static constexpr bool HAS_MID = false; static constexpr int MID_T = -1;
    Fr F;
    __device__ __forceinline__ void mid(f32x4 (&)[2][2][4][2], const pg8::Unit&, int, int, int, int) const {}
    template <bool UNI, int KIND> __device__ __forceinline__ void run(const f32x4 (&acc)[2][2][4][2], const pg8::Unit& u, int wr, int wc, int fr, int fq) const {
        const int pn = u.pn;
        const float* r1p = wsp<float>(F, WS_R1); float r1c = r1p[RG_ROW(u, 0)], r1n = 0.f;
        f32x4 ub[2][2], gn[2][2];
        if (UNI) { const float* bp = wsp<float>(F, WS_BIAS1) + (size_t)modrow_of(u.pm * 256) * NIN + pn * 256 + wc * 32 + 8 * fq;
#pragma unroll
            for (int bj = 0; bj < 2; ++bj) { ub[bj][0] = *(const f32x4*)(bp + bj * 128); ub[bj][1] = *(const f32x4*)(bp + bj * 128 + 4); } }
        if (KIND == 0) { const float* g = (pn < 2 ? inp(F, 11) : inp(F, 12)) + 8 * fq;
#pragma unroll
            for (int bj = 0; bj < 2; ++bj) { gn[bj][0] = *(const f32x4*)(g + 32 * bj); gn[bj][1] = *(const f32x4*)(g + 32 * bj + 4); }
        }
        bf16_t* Q = wsp<bf16_t>(F, WS_Q); bf16_t* Kb = wsp<bf16_t>(F, WS_KB); bf16_t* Vb = wsp<bf16_t>(F, WS_VB); bf16_t* XS = wsp<bf16_t>(F, WS_XS); float* us = wsp<float>(F, WS_US); float* out = outp(F);
#pragma unroll
        for (int rg = 0; rg < 8; ++rg) {
            const int ai = rg >> 2, m = rg & 3, row = RG_ROW(u, rg);
            if (rg < 7) r1n = r1p[RG_ROW(u, rg + 1)];
            const float* bpr = wsp<float>(F, WS_BIAS1) + (size_t)modrow_of(row) * NIN + pn * 256 + wc * 32 + 8 * fq;
#define VIN(bj, n) (acc[ai][bj][m][n] * r1c + (UNI ? ub[bj][n] : *(const f32x4*)(bpr + (bj) * 128 + 4 * (n))))
            if (KIND == 2) {
                if (row < MP) { const int bc = row >> 6, s = row & 63;
#pragma unroll
                    for (int bj = 0; bj < 2; ++bj) { const int g = 16 * (pn - 3) + 8 * bj + 2 * wc + (fq >> 1);
                        *(u32x4*)(XS + ((size_t)g * 1024 + bc) * XS_LD + 128 + s * 16 + 8 * (fq & 1)) = pack8(VIN(bj, 0), VIN(bj, 1)); } }
                else {
#pragma unroll
                    for (int bj = 0; bj < 2; ++bj) { float* p = us + (size_t)(row - MP) * 512 + 256 * (pn - 3) + 128 * bj + 32 * wc + 8 * fq; *(f32x4*)p = VIN(bj, 0); *(f32x4*)(p + 4) = VIN(bj, 1); } }
            } else if (KIND == 1) {
                const int kv = wc - 2;
#pragma unroll
                for (int bj = 0; bj < 2; ++bj) { const int d0 = 32 * bj + 8 * fq; const f32x4 v0 = VIN(bj, 0), v1 = VIN(bj, 1); *(u32x4*)(Vb + (size_t)row * 128 + kv * 64 + d0) = pack8(v0, v1);
                    float* op = nullptr;
                    if (row >= MP) op = out + O_VS + ((size_t)(row - MP) * 2 + kv) * 64 + d0;
                    else if ((row & (SEQ - 1)) >= SEQ - 128) op = out + O_VP + (((size_t)(row >> 12) * 128 + ((row & (SEQ - 1)) - (SEQ - 128))) * 2 + kv) * 64 + d0;
                    if (op) { *(f32x4*)op = v0; *(f32x4*)(op + 4) = v1; } }
            } else {
                float ss = 0.f;
#pragma unroll
                for (int bj = 0; bj < 2; ++bj)
#pragma unroll
                    for (int n = 0; n < 2; ++n) { const f32x4 t = VIN(bj, n); ss += (t[0] * t[0] + t[1] * t[1]) + (t[2] * t[2] + t[3] * t[3]); }
                ss += __shfl_xor(ss, 16); ss += __shfl_xor(ss, 32);
                const float rn = rsqrtf(ss * (1.f / 64.f) + EPS); const float posf = (float)pos_of(row);
                f32x4 o[2][2];
#pragma unroll
                for (int n = 0; n < 2; ++n) { const f32x4 x1 = VIN(0, n) * rn * gn[0][n], x2 = VIN(1, n) * rn * gn[1][n]; f32x4 cv, sv;
#pragma unroll
                    for (int j = 0; j < 4; ++j) { const float ivr = __builtin_amdgcn_exp2f(-(float)(8 * fq + 4 * n + j) * (13.287712379549449f / 32.f)) * 0.15915494309189535f;
                        const float fr_ = __builtin_amdgcn_fractf(posf * ivr); cv[j] = __builtin_amdgcn_cosf(fr_); sv[j] = __builtin_amdgcn_sinf(fr_); }
                    o[0][n] = x1 * cv - x2 * sv; o[1][n] = x2 * cv + x1 * sv; }
                if (pn < 2) { const int head = 4 * pn + wc;
#pragma unroll
                    for (int bj = 0; bj < 2; ++bj) *(u32x4*)(Q + (size_t)row * 512 + head * 64 + 32 * bj + 8 * fq) = pack8(o[bj][0] * QSCALE, o[bj][1] * QSCALE);
                } else { const int kv = wc;
#pragma unroll
                    for (int bj = 0; bj < 2; ++bj) { const int d0 = 32 * bj + 8 * fq; *(u32x4*)(Kb + (size_t)row * 128 + kv * 64 + d0) = pack8(o[bj][0], o[bj][1]);
                        float* op = nullptr;
                        if (row >= MP) op = out + O_KS + ((size_t)(row - MP) * 2 + kv) * 64 + d0;
                        else if ((row & (SEQ - 1)) >= SEQ - 128) op = out + O_KP + (((size_t)(row >> 12) * 128 + ((row & (SEQ - 1)) - (SEQ - 128))) * 2 + kv) * 64 + d0;
                        if (op) { *(f32x4*)op = o[bj][0]; *(f32x4*)(op + 4) = o[bj][1]; } }
                }
            }
#undef VIN
            r1c = r1n;
            asm volatile("" ::: "memory");
        }
    }
    __device__ __forceinline__ void operator()(const f32x4 (&acc)[2][2][4][2], const pg8::Unit& u, int wr, int wc, int fr, int fq) const {
        const int kind = u.pn >= 3 ? 2 : (u.pn == 2 && wc >= 2) ? 1 : 0;
        if (kind == 2) run<true, 2>(acc, u, wr, wc, fr, fq); else if (kind == 1) run<true, 1>(acc, u, wr, wc, fr, fq); else run<true, 0>(acc, u, wr, wc, fr, fq);
    }
};
struct EpiState {
    static constexpr bool EPI2 = false;
    static constexpr bool HAS_MID = false; static constexpr int MID_T = -1;
    Fr F;
    __device__ __forceinline__ void mid(f32x4 (&)[2][2][4][2], const pg8::Unit&, int, int, int, int) const {}
    __device__ __forceinline__ void operator()(const f32x4 (&acc)[2][2][4][2], const pg8::Unit& u, int wr, int wc, int fr, int fq) const {
        float* base = wsp<float>(F, WS_DS) + (size_t)u.aux * 1024 * 128;
#pragma unroll
        for (int rg = 0; rg < 8; ++rg) { const int bc = RG_ROW(u, rg); float* p = base + (size_t)bc * 128 + 32 * wc + 8 * fq; *(f32x4*)p = acc[rg >> 2][0][rg & 3][0]; *(f32x4*)(p + 4) = acc[rg >> 2][0][rg & 3][1]; }
    }
};
struct EpiY {
    static constexpr bool EPI2 = false;
    static constexpr bool HAS_MID = false; static constexpr int MID_T = -1;
    Fr F;
    __device__ __forceinline__ void mid(f32x4 (&)[2][2][4][2], const pg8::Unit&, int, int, int, int) const {}
    __device__ __forceinline__ void operator()(const f32x4 (&acc)[2][2][4][2], const pg8::Unit& u, int wr, int wc, int fr, int fq) const {
        bf16_t* Gb = wsp<bf16_t>(F, WS_GB); const int g = u.aux;
#pragma unroll
        for (int rg = 0; rg < 8; ++rg) { const int bc = RG_ROW(u, rg);
#pragma unroll
            for (int bj = 0; bj < 2; ++bj) { const int t = 16 * u.pn + 8 * bj + 2 * wc + (fq >> 1); f32x4 a = acc[rg >> 2][bj][rg & 3][0], b = acc[rg >> 2][bj][rg & 3][1];
#pragma unroll
                for (int j = 0; j < 4; ++j) { a[j] = gelu_tanh(a[j]); b[j] = gelu_tanh(b[j]); }
                *(u32x4*)(Gb + ((size_t)bc * 64 + t) * 512 + 16 * g + 8 * (fq & 1)) = pack8(a, b); } }
    }
};
struct EpiGlu {
    static constexpr bool EPI2 = false;
    static constexpr bool HAS_MID = false; static constexpr int MID_T = -1;
    Fr F;
    __device__ __forceinline__ void mid(f32x4 (&)[2][2][4][2], const pg8::Unit&, int, int, int, int) const {}
    __device__ __forceinline__ void operator()(const f32x4 (&acc)[2][2][4][2], const pg8::Unit& u, int wr, int wc, int fr, int fq) const {
        const bf16_t* Gb = wsp<bf16_t>(F, WS_GB); bf16_t* MG = wsp<bf16_t>(F, WS_MG); float* ssq = wsp<float>(F, WS_SSQ);
        const int c0 = u.pn * 256 + wc * 32 + 8 * fq;
        f32x4 gbv[2][2], gnv[2][2];
#pragma unroll
        for (int bj = 0; bj < 2; ++bj) { const float* a = inp(F, 23) + c0 + bj * 128; const float* b = inp(F, 25) + c0 + bj * 128; gbv[bj][0] = *(const f32x4*)a; gbv[bj][1] = *(const f32x4*)(a + 4); gnv[bj][0] = *(const f32x4*)b; gnv[bj][1] = *(const f32x4*)(b + 4); }
        u32x4 cur[2], nxt[2];
#pragma unroll
        for (int bj = 0; bj < 2; ++bj) cur[bj] = *(const u32x4*)(Gb + (size_t)RG_ROW(u, 0) * 512 + c0 + bj * 128);
#pragma unroll
        for (int rg = 0; rg < 8; ++rg) {
            if (rg < 7) {
#pragma unroll
                for (int bj = 0; bj < 2; ++bj) nxt[bj] = *(const u32x4*)(Gb + (size_t)RG_ROW(u, rg + 1) * 512 + c0 + bj * 128); }
            const int row = RG_ROW(u, rg); float ss = 0.f;
#pragma unroll
            for (int bj = 0; bj < 2; ++bj) { const u32x4 gw = cur[bj];
                const f32x4 g0 = {bflo(gw.x), bfhi(gw.x), bflo(gw.y), bfhi(gw.y)}, g1 = {bflo(gw.z), bfhi(gw.z), bflo(gw.w), bfhi(gw.w)};
                const f32x4 z0 = acc[rg >> 2][bj][rg & 3][0] + gbv[bj][0], z1 = acc[rg >> 2][bj][rg & 3][1] + gbv[bj][1]; f32x4 s0, s1;
#pragma unroll
                for (int j = 0; j < 4; ++j) { s0[j] = g0[j] * sigm_f(z0[j]); s1[j] = g1[j] * sigm_f(z1[j]); ss += s0[j] * s0[j] + s1[j] * s1[j]; }
                *(u32x4*)(MG + (size_t)row * D + c0 + bj * 128) = pack8(s0 * gnv[bj][0], s1 * gnv[bj][1]); }
            ss += __shfl_xor(ss, 16); ss += __shfl_xor(ss, 32);
            if (fq == 0) ssq[(size_t)row * 8 + u.pn * 4 + wc] = ss;
            if (rg < 7) { cur[0] = nxt[0]; cur[1] = nxt[1]; }
            asm volatile("" ::: "memory");
        }
    }
};
struct EpiOut {
    static constexpr bool EPI2 = false;
    static constexpr bool HAS_MID = true; static constexpr int MID_T = 8;
    Fr F;
    int pm_min;
    __device__ __forceinline__ void mid(f32x4 (&acc)[2][2][4][2], const pg8::Unit& u, int wr, int wc, int fr, int fq) const {
        const LAS float* tab = (const LAS float*)(F.lds + R2TAB_OFF) + ((u.pm - pm_min) >> 3) * 512 + wr * 64;
#pragma unroll
        for (int rg = 0; rg < 8; ++rg) { const float rs = tab[(rg >> 2) * 128 + (rg & 3) * 16 + fr];
#pragma unroll
            for (int bj = 0; bj < 2; ++bj)
#pragma unroll
                for (int n = 0; n < 2; ++n) acc[rg >> 2][bj][rg & 3][n] *= rs; }
    }
    template <bool UNI> __device__ __forceinline__ void run(const f32x4 (&acc)[2][2][4][2], const pg8::Unit& u, int wr, int wc, int fr, int fq) const {
        bf16_t* X1 = wsp<bf16_t>(F, WS_X1B); bf16_t* A2 = wsp<bf16_t>(F, WS_A2); const float* xp = inp(F, 0); const float* xs = inp(F, 1); const float* modp = wsp<float>(F, WS_MOD); const float* l2p = inp(F, 27);
        float ssv[8], rav[8]; const LAS float* tab2 = (const LAS float*)(F.lds + R2TAB_OFF) + ((u.pm - pm_min) >> 3) * 512 + 256 + wr * 64;
#pragma unroll
        for (int rg = 0; rg < 8; ++rg) { ssv[rg] = 0.f; rav[rg] = tab2[(rg >> 2) * 128 + (rg & 3) * 16 + fr]; }
#pragma unroll
        for (int bj = 0; bj < 2; ++bj) {
            const int c0 = u.pn * 256 + bj * 128 + wc * 32 + 8 * fq;
            f32x4 ug1[2], uw2[2];
            if (UNI) { const float* md = modp + (size_t)modrow_of(u.pm * 256) * NMOD + c0;
#pragma unroll
                for (int n = 0; n < 2; ++n) { ug1[n] = *(const f32x4*)(md + 2 * D + 4 * n); uw2[n] = *(const f32x4*)(l2p + c0 + 4 * n) * (1.f + *(const f32x4*)(md + 4 * D + 4 * n)); } }
            f32x4 cx[2], nx[2];
            { const int row = RG_ROW(u, 0); const float* xr = (row < MP ? xp + (size_t)row * D : xs + (size_t)(row - MP) * D) + c0; cx[0] = *(const f32x4*)xr; cx[1] = *(const f32x4*)(xr + 4); }
#pragma unroll
            for (int rg = 0; rg < 8; ++rg) {
                if (rg < 7) { const int row = RG_ROW(u, rg + 1); const float* xr = (row < MP ? xp + (size_t)row * D : xs + (size_t)(row - MP) * D) + c0; nx[0] = *(const f32x4*)xr; nx[1] = *(const f32x4*)(xr + 4); }
                const int row = RG_ROW(u, rg); const float* md = modp + (size_t)modrow_of(row) * NMOD + c0;
                f32x4 x1[2], w2[2];
#pragma unroll
                for (int n = 0; n < 2; ++n) { const f32x4 g1 = UNI ? ug1[n] : *(const f32x4*)(md + 2 * D + 4 * n);
                    w2[n] = UNI ? uw2[n] : *(const f32x4*)(l2p + c0 + 4 * n) * (1.f + *(const f32x4*)(md + 4 * D + 4 * n));
                    x1[n] = cx[n] + g1 * (acc[rg >> 2][bj][rg & 3][n] * rav[rg]);
                    ssv[rg] += (x1[n][0] * x1[n][0] + x1[n][1] * x1[n][1]) + (x1[n][2] * x1[n][2] + x1[n][3] * x1[n][3]); }
                asm volatile("" : "+v"(ssv[rg]));
                *(u32x4*)(X1 + (size_t)row * D + c0) = pack8(x1[0], x1[1]);
                *(u32x4*)(A2 + (size_t)row * D + c0) = pack8(x1[0] * w2[0], x1[1] * w2[1]);
                if (rg < 7) { cx[0] = nx[0]; cx[1] = nx[1]; }
                asm volatile("" ::: "memory");
            }
        }
        float* ssq2 = wsp<float>(F, WS_SSQ2);
#pragma unroll
        for (int rg = 0; rg < 8; ++rg) { float ss = ssv[rg]; ss += __shfl_xor(ss, 16); ss += __shfl_xor(ss, 32); if (fq == 0) ssq2[(size_t)RG_ROW(u, rg) * 16 + u.pn * 4 + wc] = ss; }
    }
    __device__ __forceinline__ void run_slow(const f32x4 (&acc)[2][2][4][2], const pg8::Unit& u, int wr, int wc, int fr, int fq) const {
        bf16_t* X1 = wsp<bf16_t>(F, WS_X1B); bf16_t* A2 = wsp<bf16_t>(F, WS_A2); const float* xs = inp(F, 1); const float* modp = wsp<float>(F, WS_MOD); const float* l2p = inp(F, 27); float* ssq2 = wsp<float>(F, WS_SSQ2);
#pragma unroll
        for (int rg = 0; rg < 8; ++rg) { const int row = RG_ROW(u, rg); float ss = 0.f; const float* md = modp + (size_t)modrow_of(row) * NMOD;
#pragma unroll
            for (int bj = 0; bj < 2; ++bj)
#pragma unroll
                for (int n = 0; n < 2; ++n) { const int c = u.pn * 256 + bj * 128 + wc * 32 + 8 * fq + 4 * n;
                    const f32x4 x1 = *(const f32x4*)(xs + (size_t)(row - MP) * D + c) + *(const f32x4*)(md + 2 * D + c) * acc[rg >> 2][bj][rg & 3][n];
                    ss += (x1[0] * x1[0] + x1[1] * x1[1]) + (x1[2] * x1[2] + x1[3] * x1[3]);
                    { u32x2 xk; xk.x = cvtpk(x1[0], x1[1]); xk.y = cvtpk(x1[2], x1[3]); *(u32x2*)(X1 + (size_t)row * D + c) = xk; }
                    const f32x4 w = x1 * *(const f32x4*)(l2p + c) * (1.f + *(const f32x4*)(md + 4 * D + c)); u32x2 pk; pk.x = cvtpk(w[0], w[1]); pk.y = cvtpk(w[2], w[3]); *(u32x2*)(A2 + (size_t)row * D + c) = pk;
                    asm volatile("" : "+v"(ss) :: "memory"); }
            ss += __shfl_xor(ss, 16); ss += __shfl_xor(ss, 32);
            if (fq == 0) ssq2[(size_t)row * 16 + u.pn * 4 + wc] = ss; }
    }
    __device__ __forceinline__ void operator()(const f32x4 (&acc)[2][2][4][2], const pg8::Unit& u, int wr, int wc, int fr, int fq) const {
        run<true>(acc, u, wr, wc, fr, fq);
    }
};
struct EpiUp {
    static constexpr bool EPI2 = false;
    static constexpr bool HAS_MID = false; static constexpr int MID_T = -1;
    Fr F;
    __device__ __forceinline__ void mid(f32x4 (&)[2][2][4][2], const pg8::Unit&, int, int, int, int) const {}
    int pm_min;
    template <bool UNI> __device__ __forceinline__ void run(const f32x4 (&acc)[2][2][4][2], const pg8::Unit& u, int wr, int wc, int fr, int fq) const {
        bf16_t* ACT = wsp<bf16_t>(F, WS_ACT); const float* bias2 = wsp<float>(F, WS_BIAS2);
        const LAS float* tab = (const LAS float*)(F.lds + R2TAB_OFF) + ((u.pm - pm_min) >> 3) * 256 + wr * 64;
        const int cb = u.pn * 256 + wc * 32 + 8 * fq;
        f32x4 ub[2][2];
        if (UNI) { const float* bp = bias2 + (size_t)modrow_of(u.pm * 256) * NGU + cb;
#pragma unroll
            for (int bj = 0; bj < 2; ++bj) { ub[bj][0] = *(const f32x4*)(bp + bj * 128); ub[bj][1] = *(const f32x4*)(bp + bj * 128 + 4); } }
#pragma unroll
        for (int rg = 0; rg < 8; ++rg) { const int row = RG_ROW(u, rg); const float r2 = tab[(rg >> 2) * 128 + (rg & 3) * 16 + fr];
            f32x4 b[2][2];
            if (UNI) { b[0][0] = ub[0][0]; b[0][1] = ub[0][1]; b[1][0] = ub[1][0]; b[1][1] = ub[1][1]; }
            else { const float* bp = bias2 + (size_t)modrow_of(row) * NGU + cb;
#pragma unroll
                for (int bj = 0; bj < 2; ++bj) { b[bj][0] = *(const f32x4*)(bp + bj * 128); b[bj][1] = *(const f32x4*)(bp + bj * 128 + 4); } }
            f32x4 o[2];
#pragma unroll
            for (int n = 0; n < 2; ++n) { const f32x4 gt = acc[rg >> 2][0][rg & 3][n] * r2 + b[0][n], up = acc[rg >> 2][1][rg & 3][n] * r2 + b[1][n];
#pragma unroll
                for (int j = 0; j < 4; ++j) o[n][j] = silu_f(gt[j]) * up[j]; }
            { const int ff = u.pn * 128 + wc * 32 + 8 * fq;
              *(u32x4*)(ACT + ((size_t)(u.pm * (FF / 64) + (ff >> 6)) * 256 + (row & 255)) * 64 + (ff & 63)) = pack8(o[0], o[1]); } }
    }
    __device__ __forceinline__ void operator()(const f32x4 (&acc)[2][2][4][2], const pg8::Unit& u, int wr, int wc, int fr, int fq) const {
        run<true>(acc, u, wr, wc, fr, fq);
    }
};
struct EpiDown {
    static constexpr bool EPI2 = false;
    static constexpr bool HAS_MID = false; static constexpr int MID_T = -1;
    Fr F;
    __device__ __forceinline__ void mid(f32x4 (&)[2][2][4][2], const pg8::Unit&, int, int, int, int) const {}
    template <bool UNI> __device__ __forceinline__ void run(const f32x4 (&acc)[2][2][4][2], const pg8::Unit& u, int wr, int wc, int fr, int fq) const {
        float* out = outp(F); const bf16_t* X1 = wsp<bf16_t>(F, WS_X1B); const float* modp = wsp<float>(F, WS_MOD) + 5 * D;
#pragma unroll
        for (int bj = 0; bj < 2; ++bj) {
            const int c0 = u.pn * 256 + bj * 128 + wc * 32 + 8 * fq;
            f32x4 ug[2];
            if (UNI) { const float* md = modp + (size_t)modrow_of(u.pm * 256) * NMOD + c0; ug[0] = *(const f32x4*)md; ug[1] = *(const f32x4*)(md + 4); }
            u32x4 cx, nx;
            cx = *(const u32x4*)(X1 + (size_t)RG_ROW(u, 0) * D + c0);
#pragma unroll
            for (int rg = 0; rg < 8; ++rg) {
                if (rg < 7) nx = *(const u32x4*)(X1 + (size_t)RG_ROW(u, rg + 1) * D + c0);
                const int row = RG_ROW(u, rg); const float* md = modp + (size_t)modrow_of(row) * NMOD + c0; float* op = out + (size_t)row * D + c0;
                const f32x4 x0 = {bflo(cx.x), bfhi(cx.x), bflo(cx.y), bfhi(cx.y)}, x1 = {bflo(cx.z), bfhi(cx.z), bflo(cx.w), bfhi(cx.w)};
                *(f32x4*)op = x0 + (UNI ? ug[0] : *(const f32x4*)md) * acc[rg >> 2][bj][rg & 3][0];
                *(f32x4*)(op + 4) = x1 + (UNI ? ug[1] : *(const f32x4*)(md + 4)) * acc[rg >> 2][bj][rg & 3][1];
                if (rg < 7) cx = nx;
                asm volatile("" ::: "memory");
            }
        }
    }
    __device__ __forceinline__ void operator()(const f32x4 (&acc)[2][2][4][2], const pg8::Unit& u, int wr, int wc, int fr, int fq) const {
        run<true>(acc, u, wr, wc, fr, fq);
    }
};
struct StateOrder {
    int c;
    __device__ bool next(int i, pg8::Unit& u) const { if (i > 0) return false; const int g = c >> 3, pm = (c >> 1) & 3, kh = c & 1;
        u.pm = pm; u.pn = 0; u.nt = 8; u.aux = kh * 32 + g; u.aoff = (((size_t)g * 1024 + pm * 256) * XS_LD + 128 + kh * 512) * 2; u.boff = ((size_t)g * 128 * 1024 + kh * 512) * 2; return true; }
};
struct YOrder {
    int c;
    __device__ bool next(int i, pg8::Unit& u) const { if (i > 1) return false; const int g = c >> 3, pm = (c >> 1) & 3, w = c & 1; const int pn = (i == 0) ? (w ? 2 : 3) : (w ? 1 : 0);
        u.pm = pm; u.pn = pn; u.nt = 2 + 4 * (pn + 1); u.aux = g; u.aoff = ((size_t)g * 1024 + pm * 256) * XS_LD * 2; u.boff = ((size_t)g * 1024 + pn * 256) * XS_LD * 2; return true; }
};

constexpr int AK_C = 192 * 16 + 16, AK_H = 8 * AK_C, AV_D = 192 * 64 + 64, AV_H = 2 * AV_D, ABUF = AK_H + AV_H;
__device__ __forceinline__ s16x4 vtr(const LAS unsigned char* p) { typedef short v4i16_t __attribute__((ext_vector_type(4))); return __builtin_bit_cast(s16x4, __builtin_amdgcn_ds_read_tr16_b64_v4i16((LAS v4i16_t*)p)); }
__device__ __forceinline__ float swap_max(float v) { auto rr = __builtin_amdgcn_permlane32_swap(__float_as_uint(v), __float_as_uint(v), false, false); return fmaxf(__uint_as_float(rr[0]), __uint_as_float(rr[1])); }
__device__ __forceinline__ float swap_add(float v) { auto rr = __builtin_amdgcn_permlane32_swap(__float_as_uint(v), __float_as_uint(v), false, false); return __uint_as_float(rr[0]) + __uint_as_float(rr[1]); }
struct AUnit { int row0, nkeys, n0, kvh, npass; const bf16_t *kA, *kB, *vA, *vB; };
__device__ __forceinline__ AUnit attn_decode(Fr& F, int unit) {
    AUnit a; const bf16_t* Kb = wsp<bf16_t>(F, WS_KB); const bf16_t* Vb = wsp<bf16_t>(F, WS_VB);
    if (unit < 2048) { const int kvh = unit & 1, bc = unit >> 1, b = bc >> 6, c = bc & 63, nc = c < 2 ? c : 2; const size_t tok0 = (size_t)b * SEQ + 64 * (c - nc);
        a.row0 = b * SEQ + 64 * c; a.nkeys = 64 * (nc + 1); a.n0 = a.nkeys; a.kvh = kvh; a.npass = 2; a.kA = Kb + tok0 * 128 + kvh * 64; a.vA = Vb + tok0 * 128 + kvh * 64; a.kB = a.kA; a.vB = a.vA; }
    else { const int s = unit - 2048, kvh = s & 1, sb = s >> 1; a.row0 = MP + 32 * sb; a.nkeys = 160; a.n0 = 128; a.kvh = kvh; a.npass = 1;
        a.kA = wsp<bf16_t>(F, WS_KC) + (size_t)sb * 128 * 128 + kvh * 64; a.vA = wsp<bf16_t>(F, WS_VC) + (size_t)sb * 128 * 128 + kvh * 64; a.kB = Kb + (size_t)a.row0 * 128 + kvh * 64; a.vB = Vb + (size_t)a.row0 * 128 + kvh * 64; }
    return a;
}
__device__ __forceinline__ void attn_issue(Fr& F, const AUnit& a, LAS unsigned char* buf) {
#pragma unroll
    for (int j = 0; j < 6; ++j) { const int i = F.wave + 8 * j;
        if (i < 24) { const int c8 = i / 3, q = i % 3, k0 = 64 * q;
            if (k0 < a.nkeys) { const bf16_t* src = (k0 < a.n0 ? a.kA + (size_t)(k0 + F.lane) * 128 : a.kB + (size_t)(k0 - a.n0 + F.lane) * 128) + c8 * 8;
                __builtin_amdgcn_global_load_lds((const unsigned*)src, (LAS unsigned*)(buf + c8 * AK_C + q * 1024), 16, 0, 0); } }
        else { const int i2 = i - 24, db = i2 / 12, q = i2 % 12, k0 = 16 * q;
            if (k0 < a.nkeys) { const bf16_t* src = (k0 < a.n0 ? a.vA + (size_t)(k0 + (F.lane >> 2)) * 128 : a.vB + (size_t)(k0 - a.n0 + (F.lane >> 2)) * 128) + db * 32 + (F.lane & 3) * 8;
                __builtin_amdgcn_global_load_lds((const unsigned*)src, (LAS unsigned*)(buf + AK_H + db * AV_D + q * 1024), 16, 0, 0); } }
    }
}
__device__ __forceinline__ void attn_qload(Fr& F, const AUnit& a, bf16x8 (&qf)[4]) {
    const int r32 = F.lane & 31, hi = F.lane >> 5, hq = a.kvh * 4 + (F.wave & 3), pass = F.wave >> 2;
    const bf16_t* qp = wsp<bf16_t>(F, WS_Q) + (size_t)(a.row0 + 32 * (pass < a.npass ? pass : 0) + r32) * 512 + hq * 64 + 8 * hi;
    asm volatile("global_load_dwordx4 %0, %4, off\n\tglobal_load_dwordx4 %1, %4, off offset:32\n\tglobal_load_dwordx4 %2, %4, off offset:64\n\tglobal_load_dwordx4 %3, %4, off offset:96"
                 : "=&v"(qf[0]), "=&v"(qf[1]), "=&v"(qf[2]), "=&v"(qf[3]) : "v"(qp) : "memory");
}
__device__ __forceinline__ void attn_compute(Fr& F, const AUnit& a, const LAS unsigned char* buf, const bf16x8 (&qf)[4], float sinkL) {
    const int lane = F.lane, r32 = lane & 31, hi = lane >> 5, hq = a.kvh * 4 + (F.wave & 3), pass = F.wave >> 2;
    if (pass >= a.npass) return;
    const int qrow = a.row0 + 32 * pass + r32, nkb = a.nkeys >> 5;
    const LAS unsigned char* kbase = buf + hi * AK_C + r32 * 16;
    const LAS unsigned char* vbase = buf + AK_H + (4 * hi + ((lane & 15) >> 2)) * 64 + ((lane >> 4) & 1) * 32 + (lane & 3) * 8;
    f32x16 P[6];
#pragma unroll
    for (int kb = 0; kb < 6; ++kb) {
        if (kb < nkb) { f32x16 acc = {};
#pragma unroll
            for (int s = 0; s < 4; ++s) { const bf16x8 kf = *(const LAS bf16x8*)(kbase + (2 * s) * AK_C + kb * 512); acc = __builtin_amdgcn_mfma_f32_32x32x16_bf16(kf, qf[s], acc, 0, 0, 0); }
            P[kb] = acc;
        } else {
#pragma unroll
            for (int r = 0; r < 16; ++r) P[kb][r] = -INFINITY; }
    }
    float mx = sinkL;
#pragma unroll
    for (int kb = 0; kb < 6; ++kb)
#pragma unroll
        for (int r = 0; r < 16; ++r) mx = fmaxf(mx, P[kb][r]);
    mx = swap_max(mx);
    float l = 0.f;
#pragma unroll
    for (int kb = 0; kb < 6; ++kb)
#pragma unroll
        for (int r = 0; r < 16; ++r) { const float e = __builtin_amdgcn_exp2f(P[kb][r] - mx); P[kb][r] = e; l += e; }
    l = swap_add(l) + __builtin_amdgcn_exp2f(sinkL - mx);
    f32x16 o0 = {}, o1 = {};
#pragma unroll
    for (int kb = 0; kb < 6; ++kb) {
        if (kb < nkb) {
#pragma unroll
            for (int s2 = 0; s2 < 2; ++s2) {
                u32x4 pw; pw.x = cvtpk(P[kb][8 * s2 + 0], P[kb][8 * s2 + 1]); pw.y = cvtpk(P[kb][8 * s2 + 2], P[kb][8 * s2 + 3]); pw.z = cvtpk(P[kb][8 * s2 + 4], P[kb][8 * s2 + 5]); pw.w = cvtpk(P[kb][8 * s2 + 6], P[kb][8 * s2 + 7]);
                const bf16x8 pb = __builtin_bit_cast(bf16x8, pw);
                const LAS unsigned char* vp = vbase + (32 * kb + 16 * s2) * 64;
                const s16x4 a0l = vtr(vp), a0h = vtr(vp + 512), a1l = vtr(vp + AV_D), a1h = vtr(vp + AV_D + 512);
                const bf16x8 va0 = {a0l[0], a0l[1], a0l[2], a0l[3], a0h[0], a0h[1], a0h[2], a0h[3]}, va1 = {a1l[0], a1l[1], a1l[2], a1l[3], a1h[0], a1h[1], a1h[2], a1h[3]};
                o0 = __builtin_amdgcn_mfma_f32_32x32x16_bf16(va0, pb, o0, 0, 0, 0);
                o1 = __builtin_amdgcn_mfma_f32_32x32x16_bf16(va1, pb, o1, 0, 0, 0);
            }
        }
    }
    const float inv = __builtin_amdgcn_rcpf(l); float ss = 0.f;
#pragma unroll
    for (int r = 0; r < 16; ++r) { o0[r] *= inv; o1[r] *= inv; ss += o0[r] * o0[r] + o1[r] * o1[r]; }
    ss = swap_add(ss);
    if (hi == 0) wsp<float>(F, WS_SSQA)[(size_t)qrow * 8 + hq] = ss;
    const float* gain = inp(F, 24) + hq * 64; bf16_t* op = wsp<bf16_t>(F, WS_MG) + (size_t)qrow * D + 512 + hq * 64;
#pragma unroll
    for (int db = 0; db < 2; ++db)
#pragma unroll
        for (int r4 = 0; r4 < 4; ++r4) { const int d0 = 32 * db + 8 * r4 + 4 * hi; const f32x4 gn = *(const f32x4*)(gain + d0);
            const f32x16& o = db ? o1 : o0; u32x2 pk; pk.x = cvtpk(o[4 * r4 + 0] * gn[0], o[4 * r4 + 1] * gn[1]); pk.y = cvtpk(o[4 * r4 + 2] * gn[2], o[4 * r4 + 3] * gn[3]);
            *(u32x2*)(op + d0) = pk; }
}
__device__ __forceinline__ void attn_phase(Fr& F, int first, int stride, int last) {
    if (first >= last) return;
    AUnit cur = attn_decode(F, first); attn_issue(F, cur, F.lds);
    bf16x8 qc[4], qn[4]; attn_qload(F, cur, qc);
    const float sinkL = inp(F, 13)[cur.kvh * 4 + (F.wave & 3)] * 1.4426950408889634f;
    asm volatile("s_waitcnt vmcnt(0)" ::: "memory"); __builtin_amdgcn_sched_barrier(0); __syncthreads();
    int par = 0;
    for (int u = first; u < last; u += stride) {
        const bool has_next = u + stride < last; AUnit nxt = cur;
        if (has_next) { nxt = attn_decode(F, u + stride); attn_issue(F, nxt, F.lds + (par ^ 1) * ABUF); }
        attn_compute(F, cur, F.lds + par * ABUF, qc, sinkL);
        if (has_next) attn_qload(F, nxt, qn);
        asm volatile("s_waitcnt vmcnt(0) lgkmcnt(0)" ::: "memory"); __builtin_amdgcn_sched_barrier(0); __syncthreads();
        if (has_next) {
#pragma unroll
            for (int s = 0; s < 4; ++s) qc[s] = qn[s]; }
        cur = nxt; par ^= 1;
    }
}

__device__ __forceinline__ void scan_item(Fr& F, int b, int g) {
    const int p = F.lane; const f32x2 L = wsp<f32x2>(F, WS_LAM)[g * 64 + p];
    const float* d0 = wsp<float>(F, WS_DS) + ((size_t)g * 1024 + b * 64) * 128; const float* d1 = d0 + (size_t)32 * 1024 * 128;
    bf16_t* X = wsp<bf16_t>(F, WS_XS) + ((size_t)g * 1024 + b * 64) * XS_LD;
    float hr = 0.f, hi_ = 0.f;
#pragma unroll 16
    for (int c = 0; c < 64; ++c) {
        const float ar = d0[c * 128 + p] + d1[c * 128 + p], ai = d0[c * 128 + 64 + p] + d1[c * 128 + 64 + p];
        X[(size_t)c * XS_LD + p] = (bf16_t)(cvtpk(hr, 0.f) & 0xffffu); X[(size_t)c * XS_LD + 64 + p] = (bf16_t)(cvtpk(hi_, 0.f) & 0xffffu);
        const float nr = L.x * hr - L.y * hi_ + ar, ni = L.x * hi_ + L.y * hr + ai; hr = nr; hi_ = ni;
    }
    *(f32x2*)(outp(F) + O_HP + ((size_t)(b * 32 + g) * 64 + p) * 2) = (f32x2){hr, hi_};
}
__device__ __forceinline__ void sample_s5_item(Fr& F, int item, LAS unsigned char* lds) {
    const int p = F.lane, sb = item >> 5, g = item & 31;
    LAS float* hs = (LAS float*)lds; LAS float* ul = (LAS float*)(lds + 16384); LAS float* Cl = (LAS float*)(lds + 18432);
    const float* us = wsp<float>(F, WS_US) + (size_t)sb * 32 * 512 + g * 16;
    { const int t = p >> 1, h0 = 8 * (p & 1); const f32x4 a = *(const f32x4*)(us + t * 512 + h0), b = *(const f32x4*)(us + t * 512 + h0 + 4); *(LAS f32x4*)(ul + t * 16 + h0) = a; *(LAS f32x4*)(ul + t * 16 + h0 + 4) = b;
      const float* cr = inp(F, 19) + g * 1024; const float* ci = inp(F, 20) + g * 1024;
#pragma unroll
      for (int i = 0; i < 4; ++i) { const int e = 4 * (p + 64 * i), ho = e >> 6, q = e & 63; const f32x4 x = *(const f32x4*)(cr + e), y = *(const f32x4*)(ci + e);
#pragma unroll
          for (int j = 0; j < 4; ++j) { Cl[ho * 129 + q + j] = x[j]; Cl[ho * 129 + 64 + q + j] = y[j]; } } }
    const float are = inp(F, 14)[g * 64 + p], aim = inp(F, 15)[g * 64 + p], dt = __expf(inp(F, 16)[g]);
    const float x1 = are * dt, y1 = aim * dt, ex1 = expm1f(x1), sh = sinf(0.5f * y1), cy = cosf(y1), sy = sinf(y1);
    const float nr = ex1 * cy - 2.f * sh * sh, ni = (ex1 + 1.f) * sy, den = are * are + aim * aim, fr_ = (nr * are + ni * aim) / den, fi_ = (ni * are - nr * aim) / den;
    const float lr = (ex1 + 1.f) * cy, li = (ex1 + 1.f) * sy;
    float bbr[16], bbi[16];
#pragma unroll
    for (int h = 0; h < 16; ++h) { const float br = inp(F, 17)[(g * 64 + p) * 16 + h], bi = inp(F, 18)[(g * 64 + p) * 16 + h]; bbr[h] = fr_ * br - fi_ * bi; bbi[h] = fr_ * bi + fi_ * br; }
    float hr = inp(F, 4)[((sb * 32 + g) * 64 + p) * 2], hi_ = inp(F, 4)[((sb * 32 + g) * 64 + p) * 2 + 1];
    LDS_WAIT(); asm volatile("" ::: "memory");
#pragma unroll 4
    for (int t = 0; t < 32; ++t) {
        const f32x4 u0 = *(const LAS f32x4*)(ul + t * 16), u1 = *(const LAS f32x4*)(ul + t * 16 + 4), u2 = *(const LAS f32x4*)(ul + t * 16 + 8), u3 = *(const LAS f32x4*)(ul + t * 16 + 12);
        const float uu[16] = {u0[0], u0[1], u0[2], u0[3], u1[0], u1[1], u1[2], u1[3], u2[0], u2[1], u2[2], u2[3], u3[0], u3[1], u3[2], u3[3]};
        float sr = 0.f, si = 0.f;
#pragma unroll
        for (int h = 0; h < 16; ++h) { sr += bbr[h] * uu[h]; si += bbi[h] * uu[h]; }
        const float n_r = lr * hr - li * hi_ + sr, n_i = lr * hi_ + li * hr + si; hr = n_r; hi_ = n_i;
        hs[t * 128 + p] = hr; hs[t * 128 + 64 + p] = hi_;
    }
    *(f32x2*)(outp(F) + O_HS + ((size_t)(sb * 32 + g) * 64 + p) * 2) = (f32x2){hr, hi_};
    LDS_WAIT(); asm volatile("" ::: "memory");
    const int ho = p & 15; const float dsk = inp(F, 21)[g * 16 + ho];
    float y[8];
#pragma unroll
    for (int j = 0; j < 8; ++j) y[j] = 0.f;
#pragma unroll 8
    for (int q = 0; q < 64; ++q) { const float cr = Cl[ho * 129 + q], ci = Cl[ho * 129 + 64 + q];
#pragma unroll
        for (int j = 0; j < 8; ++j) { const int t = (p >> 4) + 4 * j; y[j] += cr * hs[t * 128 + q] - ci * hs[t * 128 + 64 + q]; } }
    bf16_t* Gb = wsp<bf16_t>(F, WS_GB);
#pragma unroll
    for (int j = 0; j < 8; ++j) { const int t = (p >> 4) + 4 * j; const float yy = y[j] + dsk * ul[t * 16 + ho]; Gb[((size_t)MP + sb * 32 + t) * 512 + g * 16 + ho] = (bf16_t)(cvtpk(gelu_tanh(yy), 0.f) & 0xffffu); }
    LDS_WAIT(); asm volatile("" ::: "memory");
}
__device__ __forceinline__ void p2_side(Fr& F) {
    unsigned* q2 = wsp<unsigned>(F, WS_CTL) + CW_Q + 128;
    if (F.wave == 0) sample_s5_item(F, F.vcu, F.lds);
    for (int it = F.wave ? F.vcu * 7 + F.wave - 1 : F.G * 7 + wq_next(q2); it < 2048; it = F.G * 7 + wq_next(q2)) toeplitz_rows16(F, 16 * it);
}

__device__ __forceinline__ f32x4 mtile(Fr& F, const bf16_t* A, int lda, const bf16_t* B0, const bf16_t* B1, int ldb, int nspw, float first_scale, float second_scale = 1.f) {
    const int r32 = F.lane & 31, h = F.lane >> 5;
    f32x16 c0 = {}, c1 = {};
    const bf16_t* ap = A + (size_t)r32 * lda + 8 * h + (size_t)F.wave * nspw * 16; const bf16_t* b0p = B0 + (size_t)r32 * ldb + 8 * h + (size_t)F.wave * nspw * 16; const bf16_t* b1p = B1 + (size_t)r32 * ldb + 8 * h + (size_t)F.wave * nspw * 16;
    for (int s0 = 0; s0 < nspw; s0 += 8) {
        bf16x8 av[8], b0v[8], b1v[8];
#pragma unroll
        for (int s = 0; s < 8; ++s) if (s0 + s < nspw) { av[s] = *(const bf16x8*)(ap + 16 * (s0 + s)); b0v[s] = *(const bf16x8*)(b0p + 16 * (s0 + s)); b1v[s] = *(const bf16x8*)(b1p + 16 * (s0 + s)); }
        __builtin_amdgcn_sched_barrier(0);
#pragma unroll
        for (int s = 0; s < 8; ++s) if (s0 + s < nspw) { c0 = __builtin_amdgcn_mfma_f32_32x32x16_bf16(av[s], b0v[s], c0, 0, 0, 0); c1 = __builtin_amdgcn_mfma_f32_32x32x16_bf16(av[s], b1v[s], c1, 0, 0, 0); }
        __builtin_amdgcn_sched_barrier(0);
    }
    LAS float* part = (LAS float*)F.lds;
#pragma unroll
    for (int r = 0; r < 16; ++r) { part[((F.wave * 2 + 0) * 16 + r) * 64 + F.lane] = c0[r]; part[((F.wave * 2 + 1) * 16 + r) * 64 + F.lane] = c1[r]; }
    LDS_WAIT(); __syncthreads();
    const int row = F.tid >> 4, cg = F.tid & 15, j = cg >> 3, hi = (row >> 2) & 1, r = (row & 3) + 4 * (row >> 3);
    f32x4 lo = {0.f, 0.f, 0.f, 0.f}, hi4 = {0.f, 0.f, 0.f, 0.f};
#pragma unroll
    for (int w = 0; w < 8; ++w) { const f32x4 p = *(const LAS f32x4*)(part + ((w * 2 + j) * 16 + r) * 64 + 32 * hi + 4 * (cg & 7)); if (w < 4) lo += p; else hi4 += p; }
    LDS_WAIT(); __syncthreads();
    return lo * first_scale + hi4 * second_scale;
}
__device__ __forceinline__ float sum16(float v) { v += __shfl_xor(v, 1); v += __shfl_xor(v, 2); v += __shfl_xor(v, 4); v += __shfl_xor(v, 8); return v; }
__device__ __forceinline__ void samp_inproj(Fr& F) {
    const bf16_t* A = wsp<bf16_t>(F, WS_XB) + (size_t)MP * D; const bf16_t* W = wsp<bf16_t>(F, WS_WIN);
    for (int t = F.vcu; t < 8 * 20; t += F.G) {
        const int rt = t / 20, ht = t % 20; int n0, n1;
        if (ht < 8) { n0 = 256 * (ht >> 2) + 32 * (ht & 3); n1 = n0 + 128; } else if (ht < 12) { n0 = 512 + 32 * (ht - 8); n1 = n0 + 128; } else { n0 = 768 + 64 * (ht - 12); n1 = n0 + 32; }
        const int rl = F.tid >> 4, cg = F.tid & 15, dim = 4 * cg, row = MP + rt * 32 + rl, mr = NB + rt;
        const int nb = (dim < 32 ? n0 : n1) + (dim & 31);
        const float r1v = wsp<float>(F, WS_R1)[row]; const f32x4 bv = *(const f32x4*)(wsp<float>(F, WS_BIAS1) + (size_t)mr * NIN + nb);
        const f32x4 gnv = *(const f32x4*)((ht < 8 ? inp(F, 11) : inp(F, 12)) + dim);
        const f32x4 acc = mtile(F, A + (size_t)rt * 32 * D, D, W + (size_t)n0 * D, W + (size_t)n1 * D, D, 8, 1.f);
        const f32x4 v = acc * r1v + bv;
        if (ht >= 12) { *(f32x4*)(wsp<float>(F, WS_US) + (size_t)(row - MP) * 512 + 64 * (ht - 12) + dim) = v; continue; }
        if (ht >= 10) { const int kv = ht - 10; u32x2 pk; pk.x = cvtpk(v[0], v[1]); pk.y = cvtpk(v[2], v[3]); *(u32x2*)(wsp<bf16_t>(F, WS_VB) + (size_t)row * 128 + kv * 64 + dim) = pk;
            *(f32x4*)(outp(F) + O_VS + ((size_t)(row - MP) * 2 + kv) * 64 + dim) = v; continue; }
        const float ss = sum16((v[0] * v[0] + v[1] * v[1]) + (v[2] * v[2] + v[3] * v[3])); const float rn = rsqrtf(ss * (1.f / 64.f) + EPS);
        const f32x4 y = v * rn * gnv;
        f32x4 o, pr;
#pragma unroll
        for (int e = 0; e < 4; ++e) pr[e] = __shfl_xor(y[e], 8);
        const float posf = (float)(PAST + rl);
#pragma unroll
        for (int e = 0; e < 4; ++e) { const float ivr = __builtin_amdgcn_exp2f(-(float)((dim & 31) + e) * (13.287712379549449f / 32.f)) * 0.15915494309189535f; const float fr_ = __builtin_amdgcn_fractf(posf * ivr);
            const float cs = __builtin_amdgcn_cosf(fr_), sn = __builtin_amdgcn_sinf(fr_); o[e] = dim < 32 ? y[e] * cs - pr[e] * sn : y[e] * cs + pr[e] * sn; }
        if (ht < 8) { const f32x4 q = o * QSCALE; u32x2 pk; pk.x = cvtpk(q[0], q[1]); pk.y = cvtpk(q[2], q[3]); *(u32x2*)(wsp<bf16_t>(F, WS_Q) + (size_t)row * 512 + ht * 64 + dim) = pk; }
        else { const int kv = ht - 8; u32x2 pk; pk.x = cvtpk(o[0], o[1]); pk.y = cvtpk(o[2], o[3]); *(u32x2*)(wsp<bf16_t>(F, WS_KB) + (size_t)row * 128 + kv * 64 + dim) = pk;
            *(f32x4*)(outp(F) + O_KS + ((size_t)(row - MP) * 2 + kv) * 64 + dim) = o; }
    }
}
__device__ __forceinline__ void samp_glu(Fr& F) {
    const bf16_t* A = wsp<bf16_t>(F, WS_GB) + (size_t)MP * 512; const bf16_t* W = wsp<bf16_t>(F, WS_WGLU);
    for (int t = F.vcu; t < 8 * 8; t += F.G) {
        const int rt = t >> 3, ct = t & 7;
        const int rl = F.tid >> 4, col = 64 * ct + 4 * (F.tid & 15), row = MP + rt * 32 + rl;
        const u32x2 gw = *(const u32x2*)(wsp<bf16_t>(F, WS_GB) + (size_t)row * 512 + col); const f32x4 gbv = *(const f32x4*)(inp(F, 23) + col), gainv = *(const f32x4*)(inp(F, 25) + col);
        const f32x4 acc = mtile(F, A + (size_t)rt * 32 * 512, 512, W + (size_t)(64 * ct) * 512, W + (size_t)(64 * ct + 32) * 512, 512, 4, 1.f);
        const f32x4 g = {bflo(gw.x), bfhi(gw.x), bflo(gw.y), bfhi(gw.y)};
        const f32x4 z = acc + gbv; f32x4 so; float ss = 0.f;
#pragma unroll
        for (int e = 0; e < 4; ++e) { so[e] = g[e] * sigm_f(z[e]); ss += so[e] * so[e]; }
        ss = sum16(ss); if ((F.tid & 15) == 0) wsp<float>(F, WS_SSQ)[(size_t)row * 8 + ct] = ss;
        const f32x4 w = so * gainv; u32x2 pk; pk.x = cvtpk(w[0], w[1]); pk.y = cvtpk(w[2], w[3]); *(u32x2*)(wsp<bf16_t>(F, WS_MG) + (size_t)row * D + col) = pk;
    }
}
__device__ __forceinline__ void samp_outproj(Fr& F) {
    const bf16_t* A = wsp<bf16_t>(F, WS_MG) + (size_t)MP * D; const bf16_t* W = wsp<bf16_t>(F, WS_WOUT);
    for (int t = F.vcu; t < 8 * 16; t += F.G) {
        const int rt = t >> 4, ct = t & 15, rl = F.tid >> 4, col = 64 * ct + 4 * (F.tid & 15), row = MP + rt * 32 + rl, mr = NB + rt;
        const float* sp = wsp<float>(F, WS_SSQ) + (size_t)row * 8; const f32x4 a = *(const f32x4*)sp, b = *(const f32x4*)(sp + 4);
        const float rs = rsqrtf((((a[0] + a[1]) + (a[2] + a[3])) + ((b[0] + b[1]) + (b[2] + b[3]))) * (1.f / 512.f) + EPS);
        const float* md = wsp<float>(F, WS_MOD) + (size_t)mr * NMOD;
        const f32x4 xv = *(const f32x4*)(inp(F, 1) + (size_t)(row - MP) * D + col), g1v = *(const f32x4*)(md + 2 * D + col), w2v = *(const f32x4*)(inp(F, 27) + col) * (1.f + *(const f32x4*)(md + 4 * D + col));
        const float* spa = wsp<float>(F, WS_SSQA) + (size_t)row * 8; const f32x4 a2 = *(const f32x4*)spa, b2 = *(const f32x4*)(spa + 4);
        const float ra = rsqrtf((((a2[0] + a2[1]) + (a2[2] + a2[3])) + ((b2[0] + b2[1]) + (b2[2] + b2[3]))) * (1.f / 512.f) + EPS);
        const f32x4 acc = mtile(F, A + (size_t)rt * 32 * D, D, W + (size_t)(64 * ct) * D, W + (size_t)(64 * ct + 32) * D, D, 8, rs, ra);
        const f32x4 x1 = xv + g1v * acc;
        const float ss = sum16((x1[0] * x1[0] + x1[1] * x1[1]) + (x1[2] * x1[2] + x1[3] * x1[3])); if ((F.tid & 15) == 0) wsp<float>(F, WS_SSQ2)[(size_t)row * 16 + ct] = ss;
        u32x2 pk; pk.x = cvtpk(x1[0], x1[1]); pk.y = cvtpk(x1[2], x1[3]); *(u32x2*)(wsp<bf16_t>(F, WS_X1B) + (size_t)row * D + col) = pk;
        const f32x4 w = x1 * w2v; pk.x = cvtpk(w[0], w[1]); pk.y = cvtpk(w[2], w[3]); *(u32x2*)(wsp<bf16_t>(F, WS_A2) + (size_t)row * D + col) = pk;
    }
}
__device__ __forceinline__ void samp_up(Fr& F) {
    const bf16_t* A = wsp<bf16_t>(F, WS_A2) + (size_t)MP * D; const bf16_t* W = wsp<bf16_t>(F, WS_WGU);
    for (int t = F.vcu; t < 8 * 88; t += F.G) {
        const int rt = t / 88, ft = t % 88, ff0 = 32 * ft, n0 = 256 * (ff0 >> 7) + (ff0 & 127), rl = F.tid >> 4, cg = F.tid & 15, row = MP + rt * 32 + rl, mr = NB + rt;
        const f32x4 bv = *(const f32x4*)(wsp<float>(F, WS_BIAS2) + (size_t)mr * NGU + n0 + (cg < 8 ? 0 : 128) + 4 * (cg & 7));
        const float* sp = wsp<float>(F, WS_SSQ2) + (size_t)row * 16; const f32x4 a = *(const f32x4*)sp, b = *(const f32x4*)(sp + 4), c = *(const f32x4*)(sp + 8), d = *(const f32x4*)(sp + 12);
        const float r2 = rsqrtf(((((a[0] + a[1]) + (a[2] + a[3])) + ((b[0] + b[1]) + (b[2] + b[3]))) + (((c[0] + c[1]) + (c[2] + c[3])) + ((d[0] + d[1]) + (d[2] + d[3])))) * (1.f / D) + EPS);
        const f32x4 acc = mtile(F, A + (size_t)rt * 32 * D, D, W + (size_t)n0 * D, W + (size_t)(n0 + 128) * D, D, 8, 1.f);
        const f32x4 v = acc * r2 + bv;
        f32x4 up;
#pragma unroll
        for (int e = 0; e < 4; ++e) up[e] = __shfl_xor(v[e], 8);
        if (cg < 8) { u32x2 pk; pk.x = cvtpk(silu_f(v[0]) * up[0], silu_f(v[1]) * up[1]); pk.y = cvtpk(silu_f(v[2]) * up[2], silu_f(v[3]) * up[3]); *(u32x2*)(wsp<bf16_t>(F, WS_ACT) + (size_t)row * FF + ff0 + 4 * cg) = pk; }
    }
}
__device__ __forceinline__ void samp_down(Fr& F) {
    const bf16_t* A = wsp<bf16_t>(F, WS_ACT) + (size_t)MP * FF; const bf16_t* W = wsp<bf16_t>(F, WS_WD);
    for (int t = F.vcu; t < 8 * 16; t += F.G) {
        const int rt = t >> 4, ct = t & 15, rl = F.tid >> 4, col = 64 * ct + 4 * (F.tid & 15), row = MP + rt * 32 + rl, mr = NB + rt;
        const u32x2 xw = *(const u32x2*)(wsp<bf16_t>(F, WS_X1B) + (size_t)row * D + col); const f32x4 g2v = *(const f32x4*)(wsp<float>(F, WS_MOD) + (size_t)mr * NMOD + 5 * D + col);
        const f32x4 acc = mtile(F, A + (size_t)rt * 32 * FF, FF, W + (size_t)(64 * ct) * FF, W + (size_t)(64 * ct + 32) * FF, FF, 22, 1.f);
        const f32x4 x1 = {bflo(xw.x), bfhi(xw.x), bflo(xw.y), bfhi(xw.y)};
        *(f32x4*)(outp(F) + (size_t)row * D + col) = x1 + g2v * acc;
    }
}

__device__ __forceinline__ void bias2_tiles(Fr& F) {
    const bf16_t* A = wsp<bf16_t>(F, WS_SH2B); const bf16_t* W = wsp<bf16_t>(F, WS_WGU);
    for (int t = F.vcu - 104; t >= 0 && t < NGU / 64; t += F.G) {
        const f32x4 acc = mtile(F, A, D, W + (size_t)(64 * t) * D, W + (size_t)(64 * t + 32) * D, D, 8, 1.f);
        const int r = F.tid >> 4, col = 64 * t + 4 * (F.tid & 15);
        if (r < 24) *(f32x4*)(wsp<float>(F, WS_BIAS2) + (size_t)r * NGU + col) = acc;
    }
}
__device__ __forceinline__ int r2_table_fill(Fr& F, const pg8::StaticOrder& S) {
    pg8::Unit u; int pmin = 1 << 30, pmax = 0;
    for (int i = 0; S.next(i, u); ++i) { pmin = u.pm < pmin ? u.pm : pmin; pmax = u.pm > pmax ? u.pm : pmax; }
    const float* part = wsp<float>(F, WS_SSQ2); LAS float* tab = (LAS float*)(F.lds + R2TAB_OFF);
    for (int j = 0; pmin + 8 * j <= pmax && j < 6; ++j) { const int row = (pmin + 8 * j) * 256 + (F.tid >> 1); const float* p = part + (size_t)row * 16 + 8 * (F.tid & 1);
        const f32x4 a = *(const f32x4*)p, b = *(const f32x4*)(p + 4); float sum = ((a[0] + a[1]) + (a[2] + a[3])) + ((b[0] + b[1]) + (b[2] + b[3])); sum += __shfl_xor(sum, 1);
        if ((F.tid & 1) == 0) tab[j * 256 + (F.tid >> 1)] = rsqrtf(sum * (1.f / D) + EPS); }
    LDS_WAIT(); __syncthreads();
    return pmin;
}
__device__ __forceinline__ int rsra_table_fill(Fr& F, const pg8::StaticOrder& S) {
    pg8::Unit u; int pmin = 1 << 30, pmax = 0;
    for (int i = 0; S.next(i, u); ++i) { pmin = u.pm < pmin ? u.pm : pmin; pmax = u.pm > pmax ? u.pm : pmax; }
    const float* ps = wsp<float>(F, WS_SSQ); const float* pa = wsp<float>(F, WS_SSQA); LAS float* tab = (LAS float*)(F.lds + R2TAB_OFF);
    for (int j = 0; pmin + 8 * j <= pmax && j < 4; ++j) { const int row = (pmin + 8 * j) * 256 + (F.tid >> 1); const float* p = ((F.tid & 1) ? pa : ps) + (size_t)row * 8;
        const f32x4 a = *(const f32x4*)p, b = *(const f32x4*)(p + 4); const float r = rsqrtf((((a[0] + a[1]) + (a[2] + a[3])) + ((b[0] + b[1]) + (b[2] + b[3]))) * (1.f / 512.f) + EPS);
        const float ra = __shfl_xor(r, 1);
        if ((F.tid & 1) == 0) { tab[j * 512 + (F.tid >> 1)] = r * __builtin_amdgcn_rcpf(ra); tab[j * 512 + 256 + (F.tid >> 1)] = ra; } }
    LDS_WAIT(); __syncthreads();
    return pmin;
}
__global__ void __launch_bounds__(512, 2) mega_fwd(Args args) {
    extern __shared__ __attribute__((aligned(16))) unsigned char lds_raw[];
    Fr F; F.lds = (LAS unsigned char*)lds_raw; F.tid = threadIdx.x; F.lane = F.tid & 63; F.wave = __builtin_amdgcn_readfirstlane(F.tid >> 6);
    F.G = gridDim.x; { const int bx = blockIdx.x; F.vcu = (F.G % 8 == 0) ? (bx % 8) * (F.G / 8) + bx / 8 : bx; }
    volatile LAS unsigned* MISC = (volatile LAS unsigned*)(F.lds + LDSCTL_OFF);
    for (int u = F.tid; u < (LDS_BYTES - LDSCTL_OFF) / 4; u += 512) ((LAS unsigned*)(F.lds + LDSCTL_OFF))[u] = 0u;
    __syncthreads();
    { const unsigned long long* ka = (const unsigned long long*)__builtin_amdgcn_kernarg_segment_ptr(); if (F.tid < 33) ((LAS unsigned long long*)(F.lds + PARAM_OFF))[F.tid] = ka[F.tid]; }
    LDS_WAIT(); __syncthreads();
    unsigned* ctl = wsp<unsigned>(F, WS_CTL);
    XcdBarrier bar = xcd_barrier_post(ctl + CW_BAR, MISC + 8);
    const int bx = (int)blockIdx.x;
#ifdef PROBE_LO
    LAS unsigned long long* tsl = (LAS unsigned long long*)(F.lds + LDSCTL_OFF + 1024); int n_st = 0;
#define STAMP() do { if (F.tid == 0) tsl[n_st] = __builtin_amdgcn_s_memrealtime(); ++n_st; } while (0)
#else
#define STAMP() do {} while (0)
#endif
#define REFRESH() do { int t_ = threadIdx.x; asm volatile("" : "+v"(t_)); F.tid = t_; F.lane = t_ & 63; } while (0)
    STAMP();
    REFRESH(); p0a(F);
    xcd_barrier(bar); STAMP();
    REFRESH(); p0b(F);
    xcd_barrier(bar); STAMP();
    {
        REFRESH(); samp_inproj(F);
#ifdef PROBE_SAMP2
        REFRESH(); samp_inproj(F);
#endif
        pg8::Gemm g{wsp<bf16_t>(F, WS_XB), wsp<bf16_t>(F, WS_WIN), D, D, 1}; pg8::StaticOrder S; S.init(MP, NIN, D, D, D, F.G, bx);
        EpiIn E{F};
        pg8::gemm_phase<EpiIn, pg8::StaticOrder>(F.lds, g, S, E);
    }
    xcd_barrier(bar); STAMP();
    {
        REFRESH();
        attn_phase(F, F.vcu, F.G, 2048);
        pg8::Gemm g{wsp<bf16_t>(F, WS_XS), wsp<bf16_t>(F, WS_BTS), XS_LD, 1024, 0}; StateOrder S{F.vcu}; EpiState E{F};
        pg8::gemm_phase<EpiState, StateOrder>(F.lds, g, S, E);
        REFRESH(); if (F.vcu < 2 * DBT) attn_phase(F, 2048 + F.vcu, F.G, 2048 + 2 * DBT);
        bias2_tiles(F); REFRESH();
        p2_side(F);
#ifdef PROBE_SIDE2
        REFRESH(); if (F.vcu < 2 * DBT) attn_phase(F, 2048 + F.vcu, F.G, 2048 + 2 * DBT);
        bias2_tiles(F); REFRESH(); p2_side(F);
#endif
    }
    xcd_barrier(bar); STAMP();
    {
        REFRESH(); if (F.wave < 4) scan_item(F, 4 * ((F.vcu >> 1) & 3) + F.wave, F.vcu >> 3);
        asm volatile("s_waitcnt vmcnt(0)" ::: "memory"); __syncthreads();
        REFRESH(); samp_glu(F);
#ifdef PROBE_SAMP2
        REFRESH(); samp_glu(F);
#endif
        pg8::Gemm g{wsp<bf16_t>(F, WS_XS), wsp<bf16_t>(F, WS_BTY), XS_LD, XS_LD, 1}; YOrder S{F.vcu}; EpiY E{F};
        pg8::gemm_phase<EpiY, YOrder>(F.lds, g, S, E);
    }
    xcd_barrier(bar); STAMP();
    {
        REFRESH(); samp_outproj(F);
#ifdef PROBE_SAMP2
        REFRESH(); samp_outproj(F);
#endif
        pg8::Gemm g{wsp<bf16_t>(F, WS_GB), wsp<bf16_t>(F, WS_WGLU), 512, 512, 1}; pg8::StaticOrder S; S.init(MP, 512, 512, 512, 512, F.G, bx);
        EpiGlu E{F};
        pg8::gemm_phase<EpiGlu, pg8::StaticOrder>(F.lds, g, S, E);
    }
    xcd_barrier(bar); STAMP();
    {
        REFRESH(); samp_up(F);
#ifdef PROBE_SAMP2
        REFRESH(); samp_up(F);
#endif
        pg8::Gemm g{wsp<bf16_t>(F, WS_MG), wsp<bf16_t>(F, WS_WOUT), D, D, 1}; pg8::StaticOrder S; S.init(MP, D, D, D, D, F.G, bx);
        REFRESH(); EpiOut E{F, rsra_table_fill(F, S)};
        pg8::gemm_phase<EpiOut, pg8::StaticOrder>(F.lds, g, S, E);
    }
    xcd_barrier(bar); STAMP();
    {
        REFRESH(); samp_down(F);
#ifdef PROBE_SAMP2
        REFRESH(); samp_down(F);
#endif
        pg8::Gemm g{wsp<bf16_t>(F, WS_A2), wsp<bf16_t>(F, WS_WGU), D, D, 1}; pg8::StaticOrder S; S.init(MP, NGU, D, D, D, F.G, bx);
        REFRESH(); EpiUp E{F, r2_table_fill(F, S)};
        pg8::gemm_phase<EpiUp, pg8::StaticOrder>(F.lds, g, S, E);
    }
    xcd_barrier(bar); STAMP();
    {
        pg8::Gemm g{wsp<bf16_t>(F, WS_ACT), wsp<bf16_t>(F, WS_WD), 64, FF, 1, 32768, 16384}; pg8::StaticOrder S; S.init(MP, D, FF, FF, FF, F.G, bx); S.ta = (size_t)(FF / 64) * 32768;
        EpiDown E{F};
        pg8::gemm_phase<EpiDown, pg8::StaticOrder>(F.lds, g, S, E);
    }
    STAMP();
#ifdef PROBE_LO
    if (bx == 0 && F.tid == 0) { asm volatile("s_waitcnt lgkmcnt(0)" ::: "memory"); const unsigned long long d = (tsl[PROBE_HI] - tsl[PROBE_LO]) * PROBE_SCALE, t0 = __builtin_amdgcn_s_memrealtime();
        while (__builtin_amdgcn_s_memrealtime() - t0 < d) __builtin_amdgcn_s_sleep(8); }
#endif
}

extern "C" void kernel_launch(void* const* d_in, const int* in_sizes, int n_in, void* d_out, int out_size, void* d_ws, size_t ws_size, hipStream_t stream) {
    static int ready = 0;
    if (ready == 0) {
        ready = -1;
        if (n_in != 31 || ws_size < WS_END) { fprintf(stderr, "kernel_launch: unexpected n_in %d / ws %zu\n", n_in, ws_size); return; }
        int dev = 0, cus = 0;
        if (hipGetDevice(&dev) != hipSuccess || hipDeviceGetAttribute(&cus, hipDeviceAttributeMultiprocessorCount, dev) != hipSuccess) return;
        if (hipFuncSetAttribute((const void*)mega_fwd, hipFuncAttributeMaxDynamicSharedMemorySize, LDS_BYTES) != hipSuccess) { fprintf(stderr, "kernel_launch: hipFuncSetAttribute failed\n"); return; }
        if (cus != 256) fprintf(stderr, "kernel_launch: %d CUs (built for 256)\n", cus);
        (void)hipGetLastError();
        ready = 1;
    }
    if (ready < 0) return;
    (void)hipMemsetAsync((char*)d_ws + WS_CTL, 0, CTL_ZERO_BYTES, stream);
    Args a{};
    for (int i = 0; i < 31; ++i) a.in[i] = (const float*)d_in[i];
    a.out = (float*)d_out; a.ws = (unsigned char*)d_ws;
    hipLaunchKernelGGL(mega_fwd, dim3(256), dim3(512), LDS_BYTES, stream, a);
}
```

```cpp
#include <hip/hip_runtime.h>
#include <cstdio>
#include <cstdint>
#include <cmath>

#define LAS __attribute__((address_space(3)))
#define GAS __attribute__((address_space(1)))
typedef unsigned short bf16_t;
typedef short bf16x8 __attribute__((ext_vector_type(8)));
typedef short s16x4 __attribute__((ext_vector_type(4)));
typedef float f32x4 __attribute__((ext_vector_type(4)));
typedef float f32x2 __attribute__((ext_vector_type(2)));
typedef float f32x16 __attribute__((ext_vector_type(16)));
typedef unsigned u32x4 __attribute__((ext_vector_type(4)));
typedef unsigned u32x2 __attribute__((ext_vector_type(2)));
typedef __bf16 bf16x2_t __attribute__((ext_vector_type(2)));

constexpr int D = 1024, NB = 16, SEQ = 4096, DBT = 8, DS = 32, PAST = 1024;
constexpr int MP = NB * SEQ, MS = DBT * DS, M = MP + MS;
constexpr int NIN = 1280, FF = 2816, NGU = 2 * FF, NMOD = 6 * D;
constexpr int XS_LD = 1152;
constexpr float EPS = 1e-6f;
constexpr float QSCALE = 0.125f * 1.4426950408889634f;
constexpr size_t O_Y = 0, O_YS = (size_t)MP * D, O_KP = O_YS + (size_t)MS * D, O_VP = O_KP + 262144, O_HP = O_VP + 262144,
                 O_KS = O_HP + 65536, O_VS = O_KS + 32768, O_HS = O_VS + 32768;
constexpr size_t MiB = 1u << 20;
constexpr size_t WS_CTL = 0, CTL_ZERO_BYTES = 64 * 1024;
constexpr size_t WS_MOD = 1 * MiB, WS_BIAS1 = 2 * MiB, WS_BIAS2 = 2 * MiB + 128 * 1024, WS_R1 = 3 * MiB, WS_ROPE = 4 * MiB, WS_SSQ = 5 * MiB, WS_SSQ2 = 8 * MiB,
                 WS_KMAT = 13 * MiB, WS_LAM = 15 * MiB, WS_SH2B = 15 * MiB + 32 * 1024, WS_US = 15 * MiB + 128 * 1024, WS_SSQA = 913 * MiB, WS_KC = 916 * MiB, WS_VC = 917 * MiB,
                 WS_WIN = 16 * MiB, WS_WGLU = 19 * MiB, WS_WOUT = 20 * MiB, WS_WGU = 22 * MiB, WS_WD = 33 * MiB, WS_BTS = 39 * MiB, WS_BTY = 48 * MiB,
                 WS_A2 = 128 * MiB, WS_XB = 257 * MiB, WS_Q = 386 * MiB, WS_KB = 451 * MiB, WS_VB = 468 * MiB, WS_XS = 485 * MiB, WS_DS = 557 * MiB,
                 WS_GB = 589 * MiB, WS_MG = 654 * MiB, WS_ACT = 257 * MiB, WS_X1B = 784 * MiB, WS_END = 918 * MiB;
constexpr int CW_TMO = 0, CW_BAR = 4096, CW_Q = 8192;

__device__ __forceinline__ unsigned cvtpk(float lo, float hi) { f32x2 v = {lo, hi}; bf16x2_t b = __builtin_convertvector(v, bf16x2_t); return __builtin_bit_cast(unsigned, b); }
__device__ __forceinline__ u32x4 pack8(const f32x4& a, const f32x4& b) { u32x4 o; o.x = cvtpk(a[0], a[1]); o.y = cvtpk(a[2], a[3]); o.z = cvtpk(b[0], b[1]); o.w = cvtpk(b[2], b[3]); return o; }
__device__ __forceinline__ float bf2f(unsigned short h) { return __uint_as_float((unsigned)h << 16); }
__device__ __forceinline__ float bflo(unsigned w) { return __uint_as_float(w << 16); }
__device__ __forceinline__ float bfhi(unsigned w) { return __uint_as_float(w & 0xffff0000u); }
__device__ __forceinline__ int modrow_of(int m) { return m < MP ? (m >> 12) : NB + ((m - MP) >> 5); }
__device__ __forceinline__ int pos_of(int m) { return m < MP ? (m & (SEQ - 1)) : PAST + ((m - MP) & (DS - 1)); }
__device__ __forceinline__ float silu_f(float v) { return v * __builtin_amdgcn_rcpf(1.f + __builtin_amdgcn_exp2f(-1.4426950408889634f * v)); }
__device__ __forceinline__ float sigm_f(float v) { return __builtin_amdgcn_rcpf(1.f + __builtin_amdgcn_exp2f(-1.4426950408889634f * v)); }
__device__ __forceinline__ float gelu_tanh(float y) { const float u = 0.7978845608028654f * (y + 0.044715f * y * y * y); const float e = __builtin_amdgcn_exp2f(2.8853900817779268f * u); return y * (1.f - __builtin_amdgcn_rcpf(e + 1.f)); }
__device__ __forceinline__ float wave_sum(float v) {
#pragma unroll
    for (int o = 1; o < 64; o <<= 1) v += __shfl_xor(v, o);
    return v;
}
__device__ __forceinline__ int wq_next(unsigned* ctr) { unsigned v = 0; if ((threadIdx.x & 63) == 0) v = __hip_atomic_fetch_add(ctr, 1u, __ATOMIC_RELAXED, __HIP_MEMORY_SCOPE_AGENT); return (int)__builtin_amdgcn_readfirstlane(v); }
#define LDS_WAIT() asm volatile("s_waitcnt lgkmcnt(0)" ::: "memory")
#define VM_WAIT() asm volatile("s_waitcnt vmcnt(0)" ::: "memory")

namespace pg8 {
constexpr int BM = 256, BK = 64, HALF = 128, HTB = HALF * BK * 2, STAGE_BYTES = 8 * HTB, NXCD = 8, WGM = 8;
__host__ __device__ __forceinline__ int lds_byte(int r, int c) { const int st = (r >> 4) * 2 + (c >> 5), rr = r & 15, cc = c & 31, ob = rr * 64 + cc * 2; return st * 1024 + (ob ^ (((ob >> 9) & 1) << 5)); }
__host__ __device__ __forceinline__ int perm32(int rho) { const int n = rho >> 4, i = rho & 15; return 8 * (i >> 2) + 4 * n + (i & 3); }
__host__ __device__ __forceinline__ void stage_rc(int b, int& R, int& C) { const int st = b / 1024, sb = b % 1024, swz = sb ^ (((sb >> 9) & 1) << 5); R = (st >> 1) * 16 + swz / 64; C = (st & 1) * 32 + (swz % 64) / 2; }

struct Unit { size_t aoff, boff; int pm, pn, nt, aux; };
struct Gemm { const bf16_t* A; const bf16_t* Bt; int lda, ldb; int bhalf; size_t kstepA = 128, hstepA = 0; };

struct StaticOrder {
    int nM, nN, nwg, G, c, nt, rev = 0; size_t ta, tb;
    __device__ void init(int M_, int N_, int K_, int lda, int ldb, int G_, int c_) { nM = M_ / BM; nN = N_ / BM; nwg = nM * nN; G = G_; c = c_; nt = K_ / BK; ta = (size_t)BM * lda * 2; tb = (size_t)BM * ldb * 2; }
    __device__ bool next(int i, Unit& u) const {
        const long L = (long)i * G + c; if (L >= nwg) return false;
        int wgid = (int)L; { const int q = nwg / NXCD, r = nwg % NXCD, xcd = wgid % NXCD, off = wgid / NXCD; wgid = (xcd < r ? xcd * (q + 1) : r * (q + 1) + (xcd - r) * q) + off; }
        const int nig = WGM * nN, gid = wgid / nig, fm = gid * WGM, gsz = (nM - fm) < WGM ? (nM - fm) : WGM;
        u.pm = fm + ((wgid % nig) % gsz); if (rev) u.pm = nM - 1 - u.pm; u.pn = (wgid % nig) / gsz; u.aoff = (size_t)u.pm * ta; u.boff = (size_t)u.pn * tb; u.nt = nt; u.aux = 0; return true;
    }
};

template <class Epi, class Sched>
__device__ __forceinline__ void gemm_phase(LAS unsigned char* lds, const Gemm g, const Sched& S, const Epi& E) {
    int tid_ = threadIdx.x; asm volatile("" : "+v"(tid_));
    const int tid = tid_, wid = __builtin_amdgcn_readfirstlane(tid >> 6), lane = tid & 63, wr = wid >> 2, wc = wid & 3, fr = lane & 15, fq = lane >> 4;
    unsigned voffA[2], voffB[2];
#pragma unroll
    for (int i = 0; i < 2; ++i) { int R, C; stage_rc(tid * 16 + i * 8192, R, C); const int Rb = (R & ~31) + perm32(R & 31); voffA[i] = (unsigned)(R * g.lda + C) * 2u; voffB[i] = (unsigned)(Rb * g.ldb + C) * 2u; }
    const size_t kstep = (size_t)(BK * 2), kstepA = g.kstepA;
    const size_t hstepA = g.hstepA ? g.hstepA : (size_t)HALF * g.lda * 2, hstepB = g.bhalf ? (size_t)HALF * g.ldb * 2 : 0;
    const unsigned ldsw = (unsigned)wid * 1024u;
    const int aoff = lds_byte(wr * 64 + fr, fq * 8), boff = lds_byte(wc * 32 + fr, fq * 8);
#define PG8_SA(b, h) (((b) * 2 + (h)) * HTB)
#define PG8_SB(b, h) ((4 + (b) * 2 + (h)) * HTB)
#define PG8_STAGE(bufoff, gbase, voff) do { _Pragma("unroll") for (int _i = 0; _i < 2; ++_i) \
        __builtin_amdgcn_global_load_lds((const unsigned*)((const char*)(gbase) + (voff)[_i]), (LAS unsigned*)(lds + (bufoff) + ldsw + _i * 8192), 16, 0, 0); } while (0)
#define PG8_LDA(dst, b, h) do { _Pragma("unroll") for (int m = 0; m < 4; ++m) _Pragma("unroll") for (int k = 0; k < 2; ++k) dst[m][k] = *(const LAS bf16x8*)(lds + PG8_SA(b, h) + aoff + m * 2048 + k * 1024); } while (0)
#define PG8_LDB(dst, b, h) do { _Pragma("unroll") for (int n = 0; n < 2; ++n) _Pragma("unroll") for (int k = 0; k < 2; ++k) dst[n][k] = *(const LAS bf16x8*)(lds + PG8_SB(b, h) + boff + n * 2048 + k * 1024); } while (0)
#define PG8_MMA(ai, bj, At, Bt) do { __builtin_amdgcn_s_setprio(1); _Pragma("unroll") for (int m = 0; m < 4; ++m) _Pragma("unroll") for (int n = 0; n < 2; ++n) _Pragma("unroll") for (int k = 0; k < 2; ++k) \
        acc[ai][bj][m][n] = __builtin_amdgcn_mfma_f32_16x16x32_bf16(Bt[n][k], At[m][k], acc[ai][bj][m][n], 0, 0, 0); __builtin_amdgcn_s_setprio(0); } while (0)
#define PG8_WAIT_V(n) asm volatile("s_waitcnt vmcnt(" #n ")" ::: "memory")
#define PG8_WAIT_L(n) asm volatile("s_waitcnt lgkmcnt(" #n ")" ::: "memory")
#define PG8_BAR __builtin_amdgcn_s_barrier()
#define PG8_SCHED __builtin_amdgcn_sched_barrier(0)
    Unit cur, nxt; int ui = 0;
    if (!S.next(0, cur)) return;
    f32x4 acc[2][2][4][2];
#pragma unroll
    for (int a = 0; a < 2; ++a)
#pragma unroll
        for (int b = 0; b < 2; ++b)
#pragma unroll
            for (int m = 0; m < 4; ++m)
#pragma unroll
                for (int n = 0; n < 2; ++n) acc[a][b][m][n] = (f32x4){0.f, 0.f, 0.f, 0.f};
    bf16x8 At[4][2], B0[2][2], B1[2][2];
    const char* cA = (const char*)g.A + cur.aoff; const char* cB = (const char*)g.Bt + cur.boff;
    PG8_STAGE(PG8_SB(0, 0), cB, voffB); PG8_STAGE(PG8_SB(0, 1), cB + hstepB, voffB); PG8_STAGE(PG8_SA(0, 0), cA, voffA); PG8_STAGE(PG8_SA(0, 1), cA + hstepA, voffA);
    if (wr == 1) PG8_BAR;
    PG8_WAIT_V(2); PG8_BAR;
    PG8_STAGE(PG8_SB(1, 0), cB + kstep, voffB); PG8_STAGE(PG8_SA(1, 0), cA + kstepA, voffA); PG8_STAGE(PG8_SB(1, 1), cB + hstepB + kstep, voffB);
    PG8_WAIT_V(6); PG8_BAR;
    for (;;) {
        const bool has_next = S.next(ui + 1, nxt);
        const char* nA = has_next ? (const char*)g.A + nxt.aoff : cA; const char* nB = has_next ? (const char*)g.Bt + nxt.boff : cB;
        const int nt = cur.nt;
        for (int t = 0; t < nt; t += 2) {
            const bool last = (t == nt - 2);
            const char* a1 = cA + (size_t)(t + 1) * kstepA;
            const char* a2 = last ? nA : cA + (size_t)(t + 2) * kstepA; const char* b2 = last ? nB : cB + (size_t)(t + 2) * kstep;
            const char* a3 = a2 + kstepA; const char* b3 = b2 + kstep;
            if constexpr (Epi::HAS_MID) { if (t == Epi::MID_T) { int fr_ = fr, fq_ = fq; asm volatile("" : "+v"(fr_), "+v"(fq_)); E.mid(acc, cur, wr, wc, fr_, fq_); } }
            PG8_LDB(B0, 0, 0); PG8_LDB(B1, 0, 1); PG8_SCHED; PG8_LDA(At, 0, 0); PG8_STAGE(PG8_SA(1, 1), a1 + hstepA, voffA);
            PG8_WAIT_V(8); PG8_WAIT_L(0); PG8_BAR; PG8_MMA(0, 0, At, B0); PG8_MMA(0, 1, At, B1); PG8_BAR; PG8_SCHED;
            PG8_LDA(At, 0, 1); PG8_STAGE(PG8_SB(0, 0), b2, voffB); PG8_STAGE(PG8_SB(0, 1), b2 + hstepB, voffB); PG8_STAGE(PG8_SA(0, 0), a2, voffA);
            PG8_WAIT_V(8); PG8_WAIT_L(0); PG8_BAR; PG8_MMA(1, 0, At, B0); PG8_MMA(1, 1, At, B1); PG8_BAR; PG8_SCHED;
            PG8_LDB(B0, 1, 0); PG8_LDB(B1, 1, 1); PG8_SCHED; PG8_LDA(At, 1, 0); PG8_STAGE(PG8_SA(0, 1), a2 + hstepA, voffA);
            PG8_WAIT_V(8); PG8_WAIT_L(0); PG8_BAR; PG8_MMA(0, 0, At, B0); PG8_MMA(0, 1, At, B1); PG8_BAR; PG8_SCHED;
            PG8_LDA(At, 1, 1); PG8_STAGE(PG8_SB(1, 0), b3, voffB); PG8_STAGE(PG8_SB(1, 1), b3 + hstepB, voffB); PG8_STAGE(PG8_SA(1, 0), a3, voffA);
            PG8_WAIT_V(8); PG8_WAIT_L(0); PG8_BAR; PG8_MMA(1, 0, At, B0); PG8_MMA(1, 1, At, B1); PG8_BAR; PG8_SCHED;
        }
        if (wr == 0) PG8_BAR;
        { int fr_ = fr, fq_ = fq; asm volatile("" : "+v"(fr_), "+v"(fq_)); E(acc, cur, wr, wc, fr_, fq_);
#ifdef PROBE_EPI2
          if constexpr (Epi::EPI2) { asm volatile("" : "+v"(fr_), "+v"(fq_) :: "memory"); E(acc, cur, wr, wc, fr_, fq_); }
#endif
        }
        if (!has_next) break;
#pragma unroll
        for (int a = 0; a < 2; ++a)
#pragma unroll
            for (int b = 0; b < 2; ++b)
#pragma unroll
                for (int m = 0; m < 4; ++m)
#pragma unroll
                    for (int n = 0; n < 2; ++n) acc[a][b][m][n] = (f32x4){0.f, 0.f, 0.f, 0.f};
        cur = nxt; cA = nA; cB = nB; ++ui;
        if (wr == 1) PG8_BAR;
    }
    PG8_WAIT_V(0);
    PG8_BAR;
#undef PG8_SA
#undef PG8_SB
#undef PG8_STAGE
#undef PG8_LDA
#undef PG8_LDB
#undef PG8_MMA
#undef PG8_WAIT_V
#undef PG8_WAIT_L
#undef PG8_BAR
#undef PG8_SCHED
}
}

#define XB_TMO      128
#define XB_XCNT(j)  (256  + 64 * (j))
#define XB_XSUB(j)  (1280 + 64 * (j))
#define XB_XGEN(j)  (2304 + 64 * (j))
#define XB_TOP      3328
#define XB_TOPGEN   3392
#define XCD_BAR_WORDS 3456
#define XB_SPIN_CAP (1u << 18)
__device__ __forceinline__ unsigned xb_ld(unsigned* p)              { return __hip_atomic_load(p, __ATOMIC_RELAXED, __HIP_MEMORY_SCOPE_AGENT); }
__device__ __forceinline__ unsigned xb_add(unsigned* p, unsigned v) { return __hip_atomic_fetch_add(p, v, __ATOMIC_RELAXED, __HIP_MEMORY_SCOPE_AGENT); }
__device__ __forceinline__ unsigned xb_xcc_id() { return (unsigned)__builtin_amdgcn_s_getreg((3 << 11) | 20) & 0xFu; }
#define XB_SPIN(cond, bar) do { unsigned _sp = 0; while (cond) { __builtin_amdgcn_s_sleep(1); \
    if ((++_sp & 255u) == 0u) { if (xb_ld(&(bar)[XB_TMO])) break; if (_sp > XB_SPIN_CAP) { atomicAdd(&(bar)[XB_TMO], 1u); break; } } } } while (0)
struct XcdBarrier { unsigned* bar; unsigned x; volatile LAS unsigned* st; };
__device__ __forceinline__ XcdBarrier xcd_barrier_post(unsigned* bar, volatile LAS unsigned* st) {
    XcdBarrier b; b.bar = bar; b.x = xb_xcc_id(); b.st = st;
    if (threadIdx.x == 0) (void)xb_add(&bar[XB_XCNT(b.x)], 1u);
    return b;
}
__device__ __forceinline__ void xcd_barrier_complete(unsigned* bar, unsigned x, unsigned& nloc, unsigned& nx) {
    const unsigned G = gridDim.x * gridDim.y * gridDim.z;
    unsigned sum, cnt, mine, sp = 0u;
    for (;;) {
        sum = 0u; cnt = 0u; mine = 0u;
#pragma unroll
        for (unsigned j = 0; j < 16; ++j) { const unsigned c = xb_ld(&bar[XB_XCNT(j)]); sum += c; cnt += (c > 0u) ? 1u : 0u; mine = (j == x) ? c : mine; }
        if (sum == G) break;
        __builtin_amdgcn_s_sleep(1);
        if ((++sp & 255u) == 0u) { if (xb_ld(&bar[XB_TMO])) break; if (sp > XB_SPIN_CAP) { atomicAdd(&bar[XB_TMO], 1u); break; } }
    }
    nloc = mine > 0u ? mine : 1u; nx = cnt > 0u ? cnt : 1u;
}
__device__ __forceinline__ void xcd_barrier(const XcdBarrier& b) {
    asm volatile("s_waitcnt vmcnt(0)" ::: "memory");
    __syncthreads();
    if (threadIdx.x == 0) {
        unsigned* bar = b.bar;
        __builtin_amdgcn_s_waitcnt(0);
        unsigned nloc = b.st[0], nx = b.st[1];
        if (nloc == 0u) { xcd_barrier_complete(bar, b.x, nloc, nx); b.st[0] = nloc; b.st[1] = nx; }
        const unsigned old = xb_add(&bar[XB_XSUB(b.x)], 1u);
        const unsigned gen = old / nloc;
        if (old + 1u == (gen + 1u) * nloc) {
            __builtin_amdgcn_fence(__ATOMIC_RELEASE, "agent");
            asm volatile("s_waitcnt vmcnt(0)" ::: "memory");
            const unsigned og = xb_add(&bar[XB_TOP], 1u);
            const unsigned tg = og / nx;
            if (og + 1u == (tg + 1u) * nx) xb_add(&bar[XB_TOPGEN], 1u);
            else XB_SPIN(xb_ld(&bar[XB_TOPGEN]) == tg, bar);
            __builtin_amdgcn_fence(__ATOMIC_ACQUIRE, "agent");
            xb_add(&bar[XB_XGEN(b.x)], 1u);
            asm volatile("s_waitcnt vmcnt(0)" ::: "memory");
        } else {
            XB_SPIN(xb_ld(&bar[XB_XGEN(b.x)]) == gen, bar);
            __builtin_amdgcn_fence(__ATOMIC_ACQUIRE, "agent");
            asm volatile("s_waitcnt vmcnt(0)" ::: "memory");
        }
    }
    __syncthreads();
}

constexpr int RING_BYTES = 131072, LDSCTL_OFF = RING_BYTES, LDS_BYTES = 147456;
struct Args { const float* in[31]; float* out; unsigned char* ws; };
constexpr int PARAM_OFF = LDSCTL_OFF + 256;
struct Fr { LAS unsigned char* lds; int tid, lane, wave, vcu, G; };
__device__ __forceinline__ unsigned long long ldparam(const Fr& F, int i) { const LAS unsigned* p = (const LAS unsigned*)(F.lds + PARAM_OFF) + 2 * i;
    const unsigned lo = __builtin_amdgcn_readfirstlane(p[0]), hi = __builtin_amdgcn_readfirstlane(p[1]); return ((unsigned long long)hi << 32) | lo; }
__device__ __forceinline__ const float* inp(const Fr& F, int i) { return (const float*)(const GAS float*)ldparam(F, i); }
__device__ __forceinline__ float* outp(const Fr& F) { return (float*)(GAS float*)ldparam(F, 31); }
template <class T> __device__ __forceinline__ T* wsp(const Fr& F, size_t off) { return (T*)(GAS T*)(ldparam(F, 32) + off); }

__device__ __forceinline__ int in_srccol(int n) {
    const int pn = n >> 8, c = n & 255, bj = c >> 7, wc = (c >> 5) & 3, i = c & 31;
    if (pn < 2) return 64 * (4 * pn + wc) + 32 * bj + i;
    if (pn == 2) return (wc < 2 ? 512 + 64 * wc : 640 + 64 * (wc - 2)) + 32 * bj + i;
    return 768 + 256 * (pn - 3) + c;
}
__device__ __forceinline__ int gu_ff(int n) { return 128 * (n >> 8) + (n & 127); }

__device__ __forceinline__ void tr_item(const float* W, int ldw, int k0, int scol0, bf16_t* WT, int drow0, int ldt, int dk0, LAS float* scr, int lane) {
#pragma unroll 8
    for (int i = 0; i < 32; ++i) { const int kk = 2 * i + (lane >> 5); scr[kk * 33 + (lane & 31)] = W[(size_t)(k0 + kk) * ldw + scol0 + (lane & 31)]; }
    LDS_WAIT(); asm volatile("" ::: "memory");
    const int c = lane & 7;
#pragma unroll
    for (int j = 0; j < 4; ++j) { const int n = (lane >> 3) + 8 * j; const LAS float* s = scr + (8 * c) * 33 + n;
        u32x4 o; o.x = cvtpk(s[0 * 33], s[1 * 33]); o.y = cvtpk(s[2 * 33], s[3 * 33]); o.z = cvtpk(s[4 * 33], s[5 * 33]); o.w = cvtpk(s[6 * 33], s[7 * 33]);
        *(u32x4*)(WT + (size_t)(drow0 + n) * ldt + dk0 + 8 * c) = o; }
    LDS_WAIT(); asm volatile("" ::: "memory");
}
template <int MODE> __device__ __forceinline__ void gemv24(Fr& F, int item) {
    const int cl = F.lane & 31, kh = F.lane >> 5, n = 32 * item + cl; const float* W; int ldw, sc;
    if (MODE == 0) { W = inp(F, 7); ldw = NMOD; sc = n; } else if (MODE == 1) { W = inp(F, 10); ldw = NIN; sc = in_srccol(n); } else { W = ((item >> 2) & 1) ? inp(F, 29) : inp(F, 28); ldw = FF; sc = gu_ff(n); }
    const float* mod = wsp<float>(F, WS_MOD);
    float acc[24];
#pragma unroll
    for (int r = 0; r < 24; ++r) acc[r] = 0.f;
    LAS float* svl = (LAS float*)(F.lds + 32768) + F.wave * (128 * 24);
    const int k0 = 128 * F.wave;
    {
        const float* rp; size_t rstride;
        if (MODE == 0) { rp = inp(F, 5) + k0 + F.lane; rstride = D; } else { rp = mod + (MODE == 2 ? 3 * D : 0) + k0 + F.lane; rstride = NMOD; }
        const float* rp2 = inp(F, 6) + k0 + F.lane;
#pragma unroll
        for (int h = 0; h < 2; ++h) { float v[24];
#pragma unroll 24
            for (int r = 0; r < 24; ++r) v[r] = (MODE == 0 && r >= NB) ? rp2[(size_t)(r - NB) * D + 64 * h] : rp[(size_t)r * rstride + 64 * h];
#pragma unroll
            for (int r = 0; r < 24; ++r) svl[(F.lane + 64 * h) * 24 + r] = MODE == 0 ? silu_f(v[r]) : v[r]; }
        LDS_WAIT(); asm volatile("" ::: "memory"); }
    {
        float wv[64];
#pragma unroll
        for (int q = 0; q < 64; ++q) wv[q] = W[(size_t)(k0 + 2 * q + kh) * ldw + sc];
#pragma unroll
        for (int q = 0; q < 64; ++q) {
#pragma unroll
            for (int i = 0; i < 6; ++i) { const f32x4 sv4 = *(const LAS f32x4*)(svl + (2 * q + kh) * 24 + 4 * i);
#pragma unroll
                for (int j = 0; j < 4; ++j) acc[4 * i + j] += sv4[j] * wv[q]; } }
    }
    LDS_WAIT(); asm volatile("" ::: "memory");
#pragma unroll
    for (int r = 0; r < 24; ++r) acc[r] += __shfl_xor(acc[r], 32);
    LAS float* red = (LAS float*)F.lds;
    if (kh == 0) {
#pragma unroll
        for (int r = 0; r < 24; ++r) red[(F.wave * 24 + r) * 32 + cl] = acc[r]; }
    LDS_WAIT(); __syncthreads();
    for (int o = F.tid; o < 24 * 32; o += 512) { const int r = o >> 5, cc = o & 31; float t = 0.f;
#pragma unroll
        for (int w = 0; w < 8; ++w) t += red[(w * 24 + r) * 32 + cc];
        if (MODE == 0) wsp<float>(F, WS_MOD)[r * NMOD + 32 * item + cc] = t + inp(F, 8)[32 * item + cc];
        else if (MODE == 1) wsp<float>(F, WS_BIAS1)[r * NIN + 32 * item + cc] = t;
        else wsp<float>(F, WS_BIAS2)[r * NGU + 32 * item + cc] = t; }
    LDS_WAIT(); __syncthreads();
}
__device__ __forceinline__ void p0_item(Fr& F, int it) {
    LAS float* scr = (LAS float*)(F.lds + F.wave * 16384);
    constexpr int I_IN = 16 * 40, I_GLU = 8 * 16, I_OUT = 16 * 32, I_GU = 16 * 176, I_D = 44 * 32, I_TR = I_IN + I_GLU + I_OUT + I_GU + I_D, I_SSM = 32 * 65;
        int r = it < I_SSM ? it + I_TR : it - I_SSM;
        if (r < I_IN) { const int kb = r / 40, nb = r % 40; tr_item(inp(F, 10), NIN, 64 * kb, in_srccol(32 * nb), wsp<bf16_t>(F, WS_WIN), 32 * nb, D, 64 * kb, scr, F.lane); return; } r -= I_IN;
        if (r < I_GLU) { const int kb = r / 16, nb = r % 16; tr_item(inp(F, 22), 512, 64 * kb, 32 * nb, wsp<bf16_t>(F, WS_WGLU), 32 * nb, 512, 64 * kb, scr, F.lane); return; } r -= I_GLU;
        if (r < I_OUT) { const int kb = r / 32, nb = r % 32; tr_item(inp(F, 26), D, 64 * kb, 32 * nb, wsp<bf16_t>(F, WS_WOUT), 32 * nb, D, (64 * kb + 512) & 1023, scr, F.lane); return; } r -= I_OUT;
        if (r < I_GU) { const int kb = r / 176, nb = r % 176, n0 = 32 * nb; const int bj = (n0 >> 7) & 1; tr_item(bj ? inp(F, 29) : inp(F, 28), FF, 64 * kb, gu_ff(n0), wsp<bf16_t>(F, WS_WGU), n0, D, 64 * kb, scr, F.lane); return; } r -= I_GU;
        if (r < I_D) { const int kb = r / 32, nb = r % 32; tr_item(inp(F, 30), D, 64 * kb, 32 * nb, wsp<bf16_t>(F, WS_WD), 32 * nb, FF, 64 * kb, scr, F.lane); return; } r -= I_D;
        {
            const int g = r / 65, tau = r % 65, p = F.lane;
            const float are = inp(F, 14)[g * 64 + p], aim = inp(F, 15)[g * 64 + p], dt = __expf(inp(F, 16)[g]);
            const float x1 = are * dt, y1 = aim * dt, ex1 = expm1f(x1), sh = sinf(0.5f * y1), cy = cosf(y1), sy = sinf(y1);
            const float nr = ex1 * cy - 2.f * sh * sh, ni = (ex1 + 1.f) * sy, den = are * are + aim * aim, fr_ = (nr * are + ni * aim) / den, fi_ = (ni * are - nr * aim) / den;
            const float et = __expf(x1 * (float)tau), rev = __builtin_amdgcn_fractf(y1 * (float)tau * 0.15915494309189535f);
            const float wrf = et * __builtin_amdgcn_cosf(rev), wif = et * __builtin_amdgcn_sinf(rev);
            if (tau == 64) { f32x2* L = wsp<f32x2>(F, WS_LAM); L[g * 64 + p] = (f32x2){wrf, wif}; return; }
            float er[16], ei[16];
#pragma unroll
            for (int h = 0; h < 16; ++h) { const float br = inp(F, 17)[(g * 64 + p) * 16 + h], bi = inp(F, 18)[(g * 64 + p) * 16 + h];
                const float bbr = fr_ * br - fi_ * bi, bbi = fr_ * bi + fi_ * br; er[h] = wrf * bbr - wif * bbi; ei[h] = wrf * bbi + wif * bbr; }
            { bf16_t* S = wsp<bf16_t>(F, WS_BTS) + (size_t)g * 128 * 1024; const int s = 63 - tau;
              u32x4 a0, a1, b0, b1;
              a0.x = cvtpk(er[0], er[1]); a0.y = cvtpk(er[2], er[3]); a0.z = cvtpk(er[4], er[5]); a0.w = cvtpk(er[6], er[7]);
              a1.x = cvtpk(er[8], er[9]); a1.y = cvtpk(er[10], er[11]); a1.z = cvtpk(er[12], er[13]); a1.w = cvtpk(er[14], er[15]);
              b0.x = cvtpk(ei[0], ei[1]); b0.y = cvtpk(ei[2], ei[3]); b0.z = cvtpk(ei[4], ei[5]); b0.w = cvtpk(ei[6], ei[7]);
              b1.x = cvtpk(ei[8], ei[9]); b1.y = cvtpk(ei[10], ei[11]); b1.z = cvtpk(ei[12], ei[13]); b1.w = cvtpk(ei[14], ei[15]);
              *(u32x4*)(S + (size_t)p * 1024 + s * 16) = a0; *(u32x4*)(S + (size_t)p * 1024 + s * 16 + 8) = a1;
              *(u32x4*)(S + (size_t)(64 + p) * 1024 + s * 16) = b0; *(u32x4*)(S + (size_t)(64 + p) * 1024 + s * 16 + 8) = b1; }
            if (tau >= 1) { bf16_t* Y = wsp<bf16_t>(F, WS_BTY) + (size_t)g * 1024 * XS_LD; const int t = tau - 1;
#pragma unroll
                for (int ho = 0; ho < 16; ++ho) { const float cr = inp(F, 19)[(g * 16 + ho) * 64 + p], ci = inp(F, 20)[(g * 16 + ho) * 64 + p];
                    const float kr = cr * wrf - ci * wif, ki = -(cr * wif + ci * wrf);
                    Y[(size_t)(t * 16 + ho) * XS_LD + p] = (bf16_t)(cvtpk(kr, 0.f) & 0xffffu); Y[(size_t)(t * 16 + ho) * XS_LD + 64 + p] = (bf16_t)(cvtpk(ki, 0.f) & 0xffffu); } }
            LAS float* Es = scr;
#pragma unroll
            for (int h = 0; h < 16; ++h) { Es[p * 32 + h] = er[h]; Es[p * 32 + 16 + h] = ei[h]; }
            LDS_WAIT(); asm volatile("" ::: "memory");
            { const int ho = F.lane >> 2, h0 = 4 * (F.lane & 3); f32x4 a = {0.f, 0.f, 0.f, 0.f};
              const float* Cr = inp(F, 19) + (g * 16 + ho) * 64; const float* Ci = inp(F, 20) + (g * 16 + ho) * 64;
#pragma unroll 16
              for (int q = 0; q < 64; ++q) { const float cr = Cr[q], ci = Ci[q]; const f32x4 e_r = *(const LAS f32x4*)(Es + q * 32 + h0), e_i = *(const LAS f32x4*)(Es + q * 32 + 16 + h0); a += cr * e_r - ci * e_i; }
              if (tau == 0) {
#pragma unroll
                  for (int j = 0; j < 4; ++j) if (h0 + j == ho) a[j] += inp(F, 21)[g * 16 + ho]; }
              *(f32x4*)(wsp<float>(F, WS_KMAT) + ((size_t)(g * 64 + tau) * 16 + ho) * 16 + h0) = a; }
            LDS_WAIT(); asm volatile("" ::: "memory");
        }
}
constexpr int P0_NITEMS = 16 * 40 + 8 * 16 + 16 * 32 + 16 * 176 + 44 * 32 + 32 * 65, P0_STATIC_A = 64 * 8;
__device__ __forceinline__ void p0a(Fr& F) {
    if (F.vcu < 192) { gemv24<0>(F, F.vcu);
#ifdef PROBE_GEMV2
        gemv24<0>(F, F.vcu); gemv24<0>(F, F.vcu);
#endif
    } else p0_item(F, (F.vcu - 192) * 8 + F.wave);
}
__device__ __forceinline__ void toeplitz_rows16(Fr& F, int r0) {
    const int g = r0 >> 10, t = (r0 >> 4) & 63; const int ncol = 256 * ((t >> 4) + 1);
    bf16_t* Y = wsp<bf16_t>(F, WS_BTY) + ((size_t)g * 1024 + (r0 & 1023)) * XS_LD + 128; const float* KM = wsp<float>(F, WS_KMAT) + (size_t)g * 64 * 256;
    for (int c0 = 8 * F.lane; c0 < ncol; c0 += 512) { const int s = c0 >> 4, h0 = c0 & 15; const bool nz = s <= t; const float* kp = KM + (size_t)(nz ? t - s : 0) * 256 + h0;
#pragma unroll
        for (int hb = 0; hb < 16; hb += 4) { f32x4 a[4], b[4];
#pragma unroll
            for (int q = 0; q < 4; ++q) { a[q] = *(const f32x4*)(kp + (hb + q) * 16); b[q] = *(const f32x4*)(kp + (hb + q) * 16 + 4); }
#pragma unroll
            for (int q = 0; q < 4; ++q) { u32x4 o = {0u, 0u, 0u, 0u}; if (nz) o = pack8(a[q], b[q]); *(u32x4*)(Y + (size_t)(hb + q) * XS_LD + c0) = o; } }
    }
}
__device__ __forceinline__ void p0_rows16(Fr& F, int ch) {
    const float* g1 = inp(F, 9); const float* modp = wsp<float>(F, WS_MOD); float* r1p = wsp<float>(F, WS_R1); bf16_t* xb = wsp<bf16_t>(F, WS_XB); const float* xpp = inp(F, 0); const float* xsp = inp(F, 1);
    for (int it = 16 * ch; it < 16 * ch + 16; it += 2) {
        const int m0 = it, m1 = it + 1; const bool two = true;
        const float* xr0 = m0 < MP ? xpp + (size_t)m0 * D : xsp + (size_t)(m0 - MP) * D;
        const int m1c = two ? m1 : m0; const float* xr1 = m1c < MP ? xpp + (size_t)m1c * D : xsp + (size_t)(m1c - MP) * D;
        f32x4 v0[4], v1[4]; float s0 = 0.f, s1 = 0.f;
#pragma unroll
        for (int j = 0; j < 4; ++j) { v0[j] = *(const f32x4*)(xr0 + 256 * j + 4 * F.lane); v1[j] = *(const f32x4*)(xr1 + 256 * j + 4 * F.lane); }
#pragma unroll
        for (int j = 0; j < 4; ++j) { s0 += (v0[j].x * v0[j].x + v0[j].y * v0[j].y) + (v0[j].z * v0[j].z + v0[j].w * v0[j].w); s1 += (v1[j].x * v1[j].x + v1[j].y * v1[j].y) + (v1[j].z * v1[j].z + v1[j].w * v1[j].w); }
        s0 = wave_sum(s0); s1 = wave_sum(s1);
        if (F.lane == 0) { r1p[m0] = rsqrtf(s0 * (1.f / D) + EPS); if (two) r1p[m1] = rsqrtf(s1 * (1.f / D) + EPS); }
        const float* sc0 = modp + (size_t)modrow_of(m0) * NMOD + D; const float* sc1 = modp + (size_t)modrow_of(m1c) * NMOD + D;
#pragma unroll
        for (int j = 0; j < 4; ++j) { const int k = 256 * j + 4 * F.lane; const f32x4 gg = *(const f32x4*)(g1 + k);
            const f32x4 w0 = v0[j] * gg * (1.f + *(const f32x4*)(sc0 + k)); u32x2 p0; p0.x = cvtpk(w0[0], w0[1]); p0.y = cvtpk(w0[2], w0[3]); *(u32x2*)(xb + (size_t)m0 * D + k) = p0;
            if (two) { const f32x4 w1 = v1[j] * gg * (1.f + *(const f32x4*)(sc1 + k)); u32x2 p1; p1.x = cvtpk(w1[0], w1[1]); p1.y = cvtpk(w1[2], w1[3]); *(u32x2*)(xb + (size_t)m1 * D + k) = p1; } }
    }
}
__device__ __forceinline__ void p0b(Fr& F) {
    const int gw = F.vcu * 8 + F.wave, NGW = F.G * 8;
    if (F.vcu < NIN / 32) gemv24<1>(F, F.vcu);
    else if (F.vcu == F.G - 2) {
        const float* ck = inp(F, 2); const float* cv = inp(F, 3); bf16_t* kc = wsp<bf16_t>(F, WS_KC); bf16_t* vc = wsp<bf16_t>(F, WS_VC);
        for (int i = F.tid; i < DBT * 128 * 128 / 4; i += 512) { const f32x4 a = *(const f32x4*)(ck + 4 * i), b = *(const f32x4*)(cv + 4 * i); u32x2 p; p.x = cvtpk(a[0], a[1]); p.y = cvtpk(a[2], a[3]); *(u32x2*)(kc + 4 * i) = p; p.x = cvtpk(b[0], b[1]); p.y = cvtpk(b[2], b[3]); *(u32x2*)(vc + 4 * i) = p; } }
    else if (F.vcu == F.G - 1) {
        const float* md = wsp<float>(F, WS_MOD); bf16_t* o = wsp<bf16_t>(F, WS_SH2B);
        for (int i = F.tid; i < 32 * D; i += 512) { const int r = i >> 10, k = i & 1023; o[i] = r < 24 ? (bf16_t)(cvtpk(md[(size_t)r * NMOD + 3 * D + k], 0.f) & 0xffffu) : (bf16_t)0; } }
    unsigned* q0 = wsp<unsigned>(F, WS_CTL) + CW_Q; unsigned* q1 = q0 + 64;
    int ch = gw, ib = P0_STATIC_A + 2 * gw; bool rows_left = true, items_left = true;
    while (rows_left || items_left) {
        if (rows_left) { if (ch < M / 16) { p0_rows16(F, ch);
#ifdef PROBE_ROWS2
            asm volatile("" ::: "memory"); p0_rows16(F, ch);
#endif
            ch = NGW + wq_next(q1); } else rows_left = false; }
        if (items_left) { if (ib < P0_NITEMS) { p0_item(F, ib); if (ib + 1 < P0_NITEMS) p0_item(F, ib + 1);
#ifdef PROBE_ITEMS2
            asm volatile("" ::: "memory"); p0_item(F, ib); if (ib + 1 < P0_NITEMS) p0_item(F, ib + 1);
#endif
 ib = P0_STATIC_A + 2 * NGW + 2 * wq_next(q0); } else items_left = false; }
    }
}

#define RG_ROW(u, rg) ((u).pm * 256 + ((rg) >> 2) * 128 + wr * 64 + ((rg) & 3) * 16 + fr)
constexpr int R2TAB_OFF = LDSCTL_OFF + 6144;
constexpr int TAB_OFF = LDSCTL_OFF + 2048;
template <int NP> __device__ __forceinline__ LAS float* row_factor_table(const Fr& F, const float* part, const pg8::Unit& u, int wr, int wc, float inv_div) {
    LAS float* tab = (LAS float*)(F.lds + TAB_OFF) + (wr * 4 + wc) * 128; const int lane = F.lane;
    f32x4 p0[NP / 4], p1[NP / 4];
    const int r0 = u.pm * 256 + wr * 64 + lane, r1 = r0 + 128;
#pragma unroll
    for (int i = 0; i < NP / 4; ++i) { p0[i] = *(const f32x4*)(part + (size_t)r0 * NP + 4 * i); p1[i] = *(const f32x4*)(part + (size_t)r1 * NP + 4 * i); }
    float s0 = 0.f, s1 = 0.f;
#pragma unroll
    for (int i = 0; i < NP / 4; ++i) { s0 += (p0[i][0] + p0[i][1]) + (p0[i][2] + p0[i][3]); s1 += (p1[i][0] + p1[i][1]) + (p1[i][2] + p1[i][3]); }
    tab[lane] = rsqrtf(s0 * inv_div + EPS); tab[64 + lane] = rsqrtf(s1 * inv_div + EPS);
    LDS_WAIT(); asm volatile("" ::: "memory");
    return tab;
}

struct EpiIn {
    static constexpr bool EPI2 = false;
    static constexpr bool HAS_MID = false; static constexpr int MID_T = -1;
    Fr F;
    __device__ __forceinline__ void mid(f32x4 (&)[2][2][4][2], const pg8::Unit&, int, int, int, int) const {}
    template <bool UNI, int KIND> __device__ __forceinline__ void run(const f32x4 (&acc)[2][2][4][2], const pg8::Unit& u, int wr, int wc, int fr, int fq) const {
        const int pn = u.pn;
        const float* r1p = wsp<float>(F, WS_R1); float r1c = r1p[RG_ROW(u, 0)], r1n = 0.f;
        f32x4 ub[2][2], gn[2][2];
        if (UNI) { const float* bp = wsp<float>(F, WS_BIAS1) + (size_t)modrow_of(u.pm * 256) * NIN + pn * 256 + wc * 32 + 8 * fq;
#pragma unroll
            for (int bj = 0; bj < 2; ++bj) { ub[bj][0] = *(const f32x4*)(bp + bj * 128); ub[bj][1] = *(const f32x4*)(bp + bj * 128 + 4); } }
        if (KIND == 0) { const float* g = (pn < 2 ? inp(F, 11) : inp(F, 12)) + 8 * fq;
#pragma unroll
            for (int bj = 0; bj < 2; ++bj) { gn[bj][0] = *(const f32x4*)(g + 32 * bj); gn[bj][1] = *(const f32x4*)(g + 32 * bj + 4); }
        }
        bf16_t* Q = wsp<bf16_t>(F, WS_Q); bf16_t* Kb = wsp<bf16_t>(F, WS_KB); bf16_t* Vb = wsp<bf16_t>(F, WS_VB); bf16_t* XS = wsp<bf16_t>(F, WS_XS); float* us = wsp<float>(F, WS_US); float* out = outp(F);
#pragma unroll
        for (int rg = 0; rg < 8; ++rg) {
            const int ai = rg >> 2, m = rg & 3, row = RG_ROW(u, rg);
            if (rg < 7) r1n = r1p[RG_ROW(u, rg + 1)];
            const float* bpr = wsp<float>(F, WS_BIAS1) + (size_t)modrow_of(row) * NIN + pn * 256 + wc * 32 + 8 * fq;
#define VIN(bj, n) (acc[ai][bj][m][n] * r1c + (UNI ? ub[bj][n] : *(const f32x4*)(bpr + (bj) * 128 + 4 * (n))))
            if (KIND == 2) {
                if (row < MP) { const int bc = row >> 6, s = row & 63;
#pragma unroll
                    for (int bj = 0; bj < 2; ++bj) { const int g = 16 * (pn - 3) + 8 * bj + 2 * wc + (fq >> 1);
                        *(u32x4*)(XS + ((size_t)g * 1024 + bc) * XS_LD + 128 + s * 16 + 8 * (fq & 1)) = pack8(VIN(bj, 0), VIN(bj, 1)); } }
                else {
#pragma unroll
                    for (int bj = 0; bj < 2; ++bj) { float* p = us + (size_t)(row - MP) * 512 + 256 * (pn - 3) + 128 * bj + 32 * wc + 8 * fq; *(f32x4*)p = VIN(bj, 0); *(f32x4*)(p + 4) = VIN(bj, 1); } }
            } else if (KIND == 1) {
                const int kv = wc - 2;
#pragma unroll
                for (int bj = 0; bj < 2; ++bj) { const int d0 = 32 * bj + 8 * fq; const f32x4 v0 = VIN(bj, 0), v1 = VIN(bj, 1); *(u32x4*)(Vb + (size_t)row * 128 + kv * 64 + d0) = pack8(v0, v1);
                    float* op = nullptr;
                    if (row >= MP) op = out + O_VS + ((size_t)(row - MP) * 2 + kv) * 64 + d0;
                    else if ((row & (SEQ - 1)) >= SEQ - 128) op = out + O_VP + (((size_t)(row >> 12) * 128 + ((row & (SEQ - 1)) - (SEQ - 128))) * 2 + kv) * 64 + d0;
                    if (op) { *(f32x4*)op = v0; *(f32x4*)(op + 4) = v1; } }
            } else {
                float ss = 0.f;
#pragma unroll
                for (int bj = 0; bj < 2; ++bj)
#pragma unroll
                    for (int n = 0; n < 2; ++n) { const f32x4 t = VIN(bj, n); ss += (t[0] * t[0] + t[1] * t[1]) + (t[2] * t[2] + t[3] * t[3]); }
                ss += __shfl_xor(ss, 16); ss += __shfl_xor(ss, 32);
                const float rn = rsqrtf(ss * (1.f / 64.f) + EPS); const float posf = (float)pos_of(row);
                f32x4 o[2][2];
#pragma unroll
                for (int n = 0; n < 2; ++n) { const f32x4 x1 = VIN(0, n) * rn * gn[0][n], x2 = VIN(1, n) * rn * gn[1][n]; f32x4 cv, sv;
#pragma unroll
                    for (int j = 0; j < 4; ++j) { const float ivr = __builtin_amdgcn_exp2f(-(float)(8 * fq + 4 * n + j) * (13.287712379549449f / 32.f)) * 0.15915494309189535f;
                        const float fr_ = __builtin_amdgcn_fractf(posf * ivr); cv[j] = __builtin_amdgcn_cosf(fr_); sv[j] = __builtin_amdgcn_sinf(fr_); }
                    o[0][n] = x1 * cv - x2 * sv; o[1][n] = x2 * cv + x1 * sv; }
                if (pn < 2) { const int head = 4 * pn + wc;
#pragma unroll
                    for (int bj = 0; bj < 2; ++bj) *(u32x4*)(Q + (size_t)row * 512 + head * 64 + 32 * bj + 8 * fq) = pack8(o[bj][0] * QSCALE, o[bj][1] * QSCALE);
                } else { const int kv = wc;
#pragma unroll
                    for (int bj = 0; bj < 2; ++bj) { const int d0 = 32 * bj + 8 * fq; *(u32x4*)(Kb + (size_t)row * 128 + kv * 64 + d0) = pack8(o[bj][0], o[bj][1]);
                        float* op = nullptr;
                        if (row >= MP) op = out + O_KS + ((size_t)(row - MP) * 2 + kv) * 64 + d0;
                        else if ((row & (SEQ - 1)) >= SEQ - 128) op = out + O_KP + (((size_t)(row >> 12) * 128 + ((row & (SEQ - 1)) - (SEQ - 128))) * 2 + kv) * 64 + d0;
                        if (op) { *(f32x4*)op = o[bj][0]; *(f32x4*)(op + 4) = o[bj][1]; } }
                }
            }
#undef VIN
            r1c = r1n;
            asm volatile("" ::: "memory");
        }
    }
    __device__ __forceinline__ void operator()(const f32x4 (&acc)[2][2][4][2], const pg8::Unit& u, int wr, int wc, int fr, int fq) const {
        const int kind = u.pn >= 3 ? 2 : (u.pn == 2 && wc >= 2) ? 1 : 0;
        if (kind == 2) run<true, 2>(acc, u, wr, wc, fr, fq); else if (kind == 1) run<true, 1>(acc, u, wr, wc, fr, fq); else run<true, 0>(acc, u, wr, wc, fr, fq);
    }
};
struct EpiState {
    static constexpr bool EPI2 = false;
    static constexpr bool HAS_MID = false; static constexpr int MID_T = -1;
    Fr F;
    __device__ __forceinline__ void mid(f32x4 (&)[2][2][4][2], const pg8::Unit&, int, int, int, int) const {}
    __device__ __forceinline__ void operator()(const f32x4 (&acc)[2][2][4][2], const pg8::Unit& u, int wr, int wc, int fr, int fq) const {
        float* base = wsp<float>(F, WS_DS) + (size_t)u.aux * 1024 * 128;
#pragma unroll
        for (int rg = 0; rg < 8; ++rg) { const int bc = RG_ROW(u, rg); float* p = base + (size_t)bc * 128 + 32 * wc + 8 * fq; *(f32x4*)p = acc[rg >> 2][0][rg & 3][0]; *(f32x4*)(p + 4) = acc[rg >> 2][0][rg & 3][1]; }
    }
};
struct EpiY {
    static constexpr bool EPI2 = false;
    static constexpr bool HAS_MID = false; static constexpr int MID_T = -1;
    Fr F;
    __device__ __forceinline__ void mid(f32x4 (&)[2][2][4][2], const pg8::Unit&, int, int, int, int) const {}
    __device__ __forceinline__ void operator()(const f32x4 (&acc)[2][2][4][2], const pg8::Unit& u, int wr, int wc, int fr, int fq) const {
        bf16_t* Gb = wsp<bf16_t>(F, WS_GB); const int g = u.aux;
#pragma unroll
        for (int rg = 0; rg < 8; ++rg) { const int bc = RG_ROW(u, rg);
#pragma unroll
            for (int bj = 0; bj < 2; ++bj) { const int t = 16 * u.pn + 8 * bj + 2 * wc + (fq >> 1); f32x4 a = acc[rg >> 2][bj][rg & 3][0], b = acc[rg >> 2][bj][rg & 3][1];
#pragma unroll
                for (int j = 0; j < 4; ++j) { a[j] = gelu_tanh(a[j]); b[j] = gelu_tanh(b[j]); }
                *(u32x4*)(Gb + ((size_t)bc * 64 + t) * 512 + 16 * g + 8 * (fq & 1)) = pack8(a, b); } }
    }
};
struct EpiGlu {
    static constexpr bool EPI2 = false;
    static constexpr bool HAS_MID = false; static constexpr int MID_T = -1;
    Fr F;
    __device__ __forceinline__ void mid(f32x4 (&)[2][2][4][2], const pg8::Unit&, int, int, int, int) const {}
    __device__ __forceinline__ void operator()(const f32x4 (&acc)[2][2][4][2], const pg8::Unit& u, int wr, int wc, int fr, int fq) const {
        const bf16_t* Gb = wsp<bf16_t>(F, WS_GB); bf16_t* MG = wsp<bf16_t>(F, WS_MG); float* ssq = wsp<float>(F, WS_SSQ);
        const int c0 = u.pn * 256 + wc * 32 + 8 * fq;
        f32x4 gbv[2][2], gnv[2][2];
#pragma unroll
        for (int bj = 0; bj < 2; ++bj) { const float* a = inp(F, 23) + c0 + bj * 128; const float* b = inp(F, 25) + c0 + bj * 128; gbv[bj][0] = *(const f32x4*)a; gbv[bj][1] = *(const f32x4*)(a + 4); gnv[bj][0] = *(const f32x4*)b; gnv[bj][1] = *(const f32x4*)(b + 4); }
        u32x4 cur[2], nxt[2];
#pragma unroll
        for (int bj = 0; bj < 2; ++bj) cur[bj] = *(const u32x4*)(Gb + (size_t)RG_ROW(u, 0) * 512 + c0 + bj * 128);
#pragma unroll
        for (int rg = 0; rg < 8; ++rg) {
            if (rg < 7) {
#pragma unroll
                for (int bj = 0; bj < 2; ++bj) nxt[bj] = *(const u32x4*)(Gb + (size_t)RG_ROW(u, rg + 1) * 512 + c0 + bj * 128); }
            const int row = RG_ROW(u, rg); float ss = 0.f;
#pragma unroll
            for (int bj = 0; bj < 2; ++bj) { const u32x4 gw = cur[bj];
                const f32x4 g0 = {bflo(gw.x), bfhi(gw.x), bflo(gw.y), bfhi(gw.y)}, g1 = {bflo(gw.z), bfhi(gw.z), bflo(gw.w), bfhi(gw.w)};
                const f32x4 z0 = acc[rg >> 2][bj][rg & 3][0] + gbv[bj][0], z1 = acc[rg >> 2][bj][rg & 3][1] + gbv[bj][1]; f32x4 s0, s1;
#pragma unroll
                for (int j = 0; j < 4; ++j) { s0[j] = g0[j] * sigm_f(z0[j]); s1[j] = g1[j] * sigm_f(z1[j]); ss += s0[j] * s0[j] + s1[j] * s1[j]; }
                *(u32x4*)(MG + (size_t)row * D + c0 + bj * 128) = pack8(s0 * gnv[bj][0], s1 * gnv[bj][1]); }
            ss += __shfl_xor(ss, 16); ss += __shfl_xor(ss, 32);
            if (fq == 0) ssq[(size_t)row * 8 + u.pn * 4 + wc] = ss;
            if (rg < 7) { cur[0] = nxt[0]; cur[1] = nxt[1]; }
            asm volatile("" ::: "memory");
        }
    }
};
#ifndef XPF
#define XPF 3
#endif
struct EpiOut {
    static constexpr bool EPI2 = false;
    static constexpr bool HAS_MID = true; static constexpr int MID_T = 8;
    Fr F;
    int pm_min;
    __device__ __forceinline__ void mid(f32x4 (&acc)[2][2][4][2], const pg8::Unit& u, int wr, int wc, int fr, int fq) const {
        const LAS float* tab = (const LAS float*)(F.lds + R2TAB_OFF) + ((u.pm - pm_min) >> 3) * 512 + wr * 64;
#pragma unroll
        for (int rg = 0; rg < 8; ++rg) { const float rs = tab[(rg >> 2) * 128 + (rg & 3) * 16 + fr];
#pragma unroll
            for (int bj = 0; bj < 2; ++bj)
#pragma unroll
                for (int n = 0; n < 2; ++n) acc[rg >> 2][bj][rg & 3][n] *= rs; }
    }
    template <bool UNI> __device__ __forceinline__ void run(const f32x4 (&acc)[2][2][4][2], const pg8::Unit& u, int wr, int wc, int fr, int fq) const {
        bf16_t* X1 = wsp<bf16_t>(F, WS_X1B); bf16_t* A2 = wsp<bf16_t>(F, WS_A2); const float* xp = inp(F, 0); const float* xs = inp(F, 1); const float* modp = wsp<float>(F, WS_MOD); const float* l2p = inp(F, 27);
        float ssv[8], rav[8]; const LAS float* tab2 = (const LAS float*)(F.lds + R2TAB_OFF) + ((u.pm - pm_min) >> 3) * 512 + 256 + wr * 64;
#pragma unroll
        for (int rg = 0; rg < 8; ++rg) { ssv[rg] = 0.f; rav[rg] = tab2[(rg >> 2) * 128 + (rg & 3) * 16 + fr]; }
#pragma unroll
        for (int bj = 0; bj < 2; ++bj) {
            const int c0 = u.pn * 256 + bj * 128 + wc * 32 + 8 * fq;
            f32x4 ug1[2], uw2[2];
            if (UNI) { const float* md = modp + (size_t)modrow_of(u.pm * 256) * NMOD + c0;
#pragma unroll
                for (int n = 0; n < 2; ++n) { ug1[n] = *(const f32x4*)(md + 2 * D + 4 * n); uw2[n] = *(const f32x4*)(l2p + c0 + 4 * n) * (1.f + *(const f32x4*)(md + 4 * D + 4 * n)); } }
            f32x4 xv[8][2];
#pragma unroll
            for (int rg = 0; rg < XPF; ++rg) { const int row = RG_ROW(u, rg); const float* xr = (row < MP ? xp + (size_t)row * D : xs + (size_t)(row - MP) * D) + c0; xv[rg][0] = *(const f32x4*)xr; xv[rg][1] = *(const f32x4*)(xr + 4); }
#pragma unroll
            for (int rg = 0; rg < 8; ++rg) {
                if (rg + XPF < 8) { const int row = RG_ROW(u, rg + XPF); const float* xr = (row < MP ? xp + (size_t)row * D : xs + (size_t)(row - MP) * D) + c0; xv[rg + XPF][0] = *(const f32x4*)xr; xv[rg + XPF][1] = *(const f32x4*)(xr + 4); }
                const f32x4 cx[2] = {xv[rg][0], xv[rg][1]};
                const int row = RG_ROW(u, rg); const float* md = modp + (size_t)modrow_of(row) * NMOD + c0;
                f32x4 x1[2], w2[2];
#pragma unroll
                for (int n = 0; n < 2; ++n) { const f32x4 g1 = UNI ? ug1[n] : *(const f32x4*)(md + 2 * D + 4 * n);
                    w2[n] = UNI ? uw2[n] : *(const f32x4*)(l2p + c0 + 4 * n) * (1.f + *(const f32x4*)(md + 4 * D + 4 * n));
                    x1[n] = cx[n] + g1 * (acc[rg >> 2][bj][rg & 3][n] * rav[rg]);
                    ssv[rg] += (x1[n][0] * x1[n][0] + x1[n][1] * x1[n][1]) + (x1[n][2] * x1[n][2] + x1[n][3] * x1[n][3]); }
                asm volatile("" : "+v"(ssv[rg]));
                *(u32x4*)(X1 + (size_t)row * D + c0) = pack8(x1[0], x1[1]);
                *(u32x4*)(A2 + (size_t)row * D + c0) = pack8(x1[0] * w2[0], x1[1] * w2[1]);
                asm volatile("" ::: "memory");
            }
        }
        float* ssq2 = wsp<float>(F, WS_SSQ2);
#pragma unroll
        for (int rg = 0; rg < 8; ++rg) { float ss = ssv[rg]; ss += __shfl_xor(ss, 16); ss += __shfl_xor(ss, 32); if (fq == 0) ssq2[(size_t)RG_ROW(u, rg) * 16 + u.pn * 4 + wc] = ss; }
    }
    __device__ __forceinline__ void run_slow(const f32x4 (&acc)[2][2][4][2], const pg8::Unit& u, int wr, int wc, int fr, int fq) const {
        bf16_t* X1 = wsp<bf16_t>(F, WS_X1B); bf16_t* A2 = wsp<bf16_t>(F, WS_A2); const float* xs = inp(F, 1); const float* modp = wsp<float>(F, WS_MOD); const float* l2p = inp(F, 27); float* ssq2 = wsp<float>(F, WS_SSQ2);
#pragma unroll
        for (int rg = 0; rg < 8; ++rg) { const int row = RG_ROW(u, rg); float ss = 0.f; const float* md = modp + (size_t)modrow_of(row) * NMOD;
#pragma unroll
            for (int bj = 0; bj < 2; ++bj)
#pragma unroll
                for (int n = 0; n < 2; ++n) { const int c = u.pn * 256 + bj * 128 + wc * 32 + 8 * fq + 4 * n;
                    const f32x4 x1 = *(const f32x4*)(xs + (size_t)(row - MP) * D + c) + *(const f32x4*)(md + 2 * D + c) * acc[rg >> 2][bj][rg & 3][n];
                    ss += (x1[0] * x1[0] + x1[1] * x1[1]) + (x1[2] * x1[2] + x1[3] * x1[3]);
                    { u32x2 xk; xk.x = cvtpk(x1[0], x1[1]); xk.y = cvtpk(x1[2], x1[3]); *(u32x2*)(X1 + (size_t)row * D + c) = xk; }
                    const f32x4 w = x1 * *(const f32x4*)(l2p + c) * (1.f + *(const f32x4*)(md + 4 * D + c)); u32x2 pk; pk.x = cvtpk(w[0], w[1]); pk.y = cvtpk(w[2], w[3]); *(u32x2*)(A2 + (size_t)row * D + c) = pk;
                    asm volatile("" : "+v"(ss) :: "memory"); }
            ss += __shfl_xor(ss, 16); ss += __shfl_xor(ss, 32);
            if (fq == 0) ssq2[(size_t)row * 16 + u.pn * 4 + wc] = ss; }
    }
    __device__ __forceinline__ void operator()(const f32x4 (&acc)[2][2][4][2], const pg8::Unit& u, int wr, int wc, int fr, int fq) const {
        run<true>(acc, u, wr, wc, fr, fq);
    }
};
struct EpiUp {
    static constexpr bool EPI2 = false;
    static constexpr bool HAS_MID = false; static constexpr int MID_T = -1;
    Fr F;
    __device__ __forceinline__ void mid(f32x4 (&)[2][2][4][2], const pg8::Unit&, int, int, int, int) const {}
    int pm_min;
    template <bool UNI> __device__ __forceinline__ void run(const f32x4 (&acc)[2][2][4][2], const pg8::Unit& u, int wr, int wc, int fr, int fq) const {
        bf16_t* ACT = wsp<bf16_t>(F, WS_ACT); const float* bias2 = wsp<float>(F, WS_BIAS2);
        const LAS float* tab = (const LAS float*)(F.lds + R2TAB_OFF) + ((u.pm - pm_min) >> 3) * 256 + wr * 64;
        const int cb = u.pn * 256 + wc * 32 + 8 * fq;
        f32x4 ub[2][2];
        if (UNI) { const float* bp = bias2 + (size_t)modrow_of(u.pm * 256) * NGU + cb;
#pragma unroll
            for (int bj = 0; bj < 2; ++bj) { ub[bj][0] = *(const f32x4*)(bp + bj * 128); ub[bj][1] = *(const f32x4*)(bp + bj * 128 + 4); } }
#pragma unroll
        for (int rg = 0; rg < 8; ++rg) { const int row = RG_ROW(u, rg); const float r2 = tab[(rg >> 2) * 128 + (rg & 3) * 16 + fr];
            f32x4 b[2][2];
            if (UNI) { b[0][0] = ub[0][0]; b[0][1] = ub[0][1]; b[1][0] = ub[1][0]; b[1][1] = ub[1][1]; }
            else { const float* bp = bias2 + (size_t)modrow_of(row) * NGU + cb;
#pragma unroll
                for (int bj = 0; bj < 2; ++bj) { b[bj][0] = *(const f32x4*)(bp + bj * 128); b[bj][1] = *(const f32x4*)(bp + bj * 128 + 4); } }
            f32x4 o[2];
#pragma unroll
            for (int n = 0; n < 2; ++n) { const f32x4 gt = acc[rg >> 2][0][rg & 3][n] * r2 + b[0][n], up = acc[rg >> 2][1][rg & 3][n] * r2 + b[1][n];
#pragma unroll
                for (int j = 0; j < 4; ++j) o[n][j] = silu_f(gt[j]) * up[j]; }
            { const int ff = u.pn * 128 + wc * 32 + 8 * fq;
              *(u32x4*)(ACT + ((size_t)(u.pm * (FF / 64) + (ff >> 6)) * 256 + (row & 255)) * 64 + (ff & 63)) = pack8(o[0], o[1]); } }
    }
    __device__ __forceinline__ void operator()(const f32x4 (&acc)[2][2][4][2], const pg8::Unit& u, int wr, int wc, int fr, int fq) const {
        run<true>(acc, u, wr, wc, fr, fq);
    }
};
struct EpiDown {
    static constexpr bool EPI2 = false;
    static constexpr bool HAS_MID = false; static constexpr int MID_T = -1;
    Fr F;
    __device__ __forceinline__ void mid(f32x4 (&)[2][2][4][2], const pg8::Unit&, int, int, int, int) const {}
    template <bool UNI> __device__ __forceinline__ void run(const f32x4 (&acc)[2][2][4][2], const pg8::Unit& u, int wr, int wc, int fr, int fq) const {
        float* out = outp(F); const bf16_t* X1 = wsp<bf16_t>(F, WS_X1B); const float* modp = wsp<float>(F, WS_MOD) + 5 * D;
#pragma unroll
        for (int bj = 0; bj < 2; ++bj) {
            const int c0 = u.pn * 256 + bj * 128 + wc * 32 + 8 * fq;
            f32x4 ug[2];
            if (UNI) { const float* md = modp + (size_t)modrow_of(u.pm * 256) * NMOD + c0; ug[0] = *(const f32x4*)md; ug[1] = *(const f32x4*)(md + 4); }
            u32x4 xv[8];
#pragma unroll
            for (int rg = 0; rg < 8; ++rg) xv[rg] = *(const u32x4*)(X1 + (size_t)RG_ROW(u, rg) * D + c0);
            asm volatile("" ::: "memory");
#pragma unroll
            for (int rg = 0; rg < 8; ++rg) {
                const int row = RG_ROW(u, rg); const float* md = modp + (size_t)modrow_of(row) * NMOD + c0; float* op = out + (size_t)row * D + c0; const u32x4 cx = xv[rg];
                const f32x4 x0 = {bflo(cx.x), bfhi(cx.x), bflo(cx.y), bfhi(cx.y)}, x1 = {bflo(cx.z), bfhi(cx.z), bflo(cx.w), bfhi(cx.w)};
                *(f32x4*)op = x0 + (UNI ? ug[0] : *(const f32x4*)md) * acc[rg >> 2][bj][rg & 3][0];
                *(f32x4*)(op + 4) = x1 + (UNI ? ug[1] : *(const f32x4*)(md + 4)) * acc[rg >> 2][bj][rg & 3][1];
                asm volatile("" ::: "memory");
            }
        }
    }
    __device__ __forceinline__ void operator()(const f32x4 (&acc)[2][2][4][2], const pg8::Unit& u, int wr, int wc, int fr, int fq) const {
        run<true>(acc, u, wr, wc, fr, fq);
    }
};
struct StateOrder {
    int c;
    __device__ bool next(int i, pg8::Unit& u) const { if (i > 0) return false; const int g = c >> 3, pm = (c >> 1) & 3, kh = c & 1;
        u.pm = pm; u.pn = 0; u.nt = 8; u.aux = kh * 32 + g; u.aoff = (((size_t)g * 1024 + pm * 256) * XS_LD + 128 + kh * 512) * 2; u.boff = ((size_t)g * 128 * 1024 + kh * 512) * 2; return true; }
};
struct YOrder {
    int c;
    __device__ bool next(int i, pg8::Unit& u) const { if (i > 1) return false; const int g = c >> 3, pm = (c >> 1) & 3, w = c & 1; const int pn = (i == 0) ? (w ? 2 : 3) : (w ? 1 : 0);
        u.pm = pm; u.pn = pn; u.nt = 2 + 4 * (pn + 1); u.aux = g; u.aoff = ((size_t)g * 1024 + pm * 256) * XS_LD * 2; u.boff = ((size_t)g * 1024 + pn * 256) * XS_LD * 2; return true; }
};

constexpr int AK_C = 192 * 16 + 16, AK_H = 8 * AK_C, AV_D = 192 * 64 + 64, AV_H = 2 * AV_D, ABUF = AK_H + AV_H;
__device__ __forceinline__ s16x4 vtr(const LAS unsigned char* p) { typedef short v4i16_t __attribute__((ext_vector_type(4))); return __builtin_bit_cast(s16x4, __builtin_amdgcn_ds_read_tr16_b64_v4i16((LAS v4i16_t*)p)); }
__device__ __forceinline__ float swap_max(float v) { auto rr = __builtin_amdgcn_permlane32_swap(__float_as_uint(v), __float_as_uint(v), false, false); return fmaxf(__uint_as_float(rr[0]), __uint_as_float(rr[1])); }
__device__ __forceinline__ float swap_add(float v) { auto rr = __builtin_amdgcn_permlane32_swap(__float_as_uint(v), __float_as_uint(v), false, false); return __uint_as_float(rr[0]) + __uint_as_float(rr[1]); }
struct AUnit { int row0, nkeys, n0, kvh, npass; const bf16_t *kA, *kB, *vA, *vB; };
__device__ __forceinline__ AUnit attn_decode(Fr& F, int unit) {
    AUnit a; const bf16_t* Kb = wsp<bf16_t>(F, WS_KB); const bf16_t* Vb = wsp<bf16_t>(F, WS_VB);
    if (unit < 2048) { const int kvh = unit & 1, bc = unit >> 1, b = bc >> 6, c = bc & 63, nc = c < 2 ? c : 2; const size_t tok0 = (size_t)b * SEQ + 64 * (c - nc);
        a.row0 = b * SEQ + 64 * c; a.nkeys = 64 * (nc + 1); a.n0 = a.nkeys; a.kvh = kvh; a.npass = 2; a.kA = Kb + tok0 * 128 + kvh * 64; a.vA = Vb + tok0 * 128 + kvh * 64; a.kB = a.kA; a.vB = a.vA; }
    else { const int s = unit - 2048, kvh = s & 1, sb = s >> 1; a.row0 = MP + 32 * sb; a.nkeys = 160; a.n0 = 128; a.kvh = kvh; a.npass = 1;
        a.kA = wsp<bf16_t>(F, WS_KC) + (size_t)sb * 128 * 128 + kvh * 64; a.vA = wsp<bf16_t>(F, WS_VC) + (size_t)sb * 128 * 128 + kvh * 64; a.kB = Kb + (size_t)a.row0 * 128 + kvh * 64; a.vB = Vb + (size_t)a.row0 * 128 + kvh * 64; }
    return a;
}
__device__ __forceinline__ void attn_issue(Fr& F, const AUnit& a, LAS unsigned char* buf) {
#pragma unroll
    for (int j = 0; j < 6; ++j) { const int i = F.wave + 8 * j;
        if (i < 24) { const int c8 = i / 3, q = i % 3, k0 = 64 * q;
            if (k0 < a.nkeys) { const bf16_t* src = (k0 < a.n0 ? a.kA + (size_t)(k0 + F.lane) * 128 : a.kB + (size_t)(k0 - a.n0 + F.lane) * 128) + c8 * 8;
                __builtin_amdgcn_global_load_lds((const unsigned*)src, (LAS unsigned*)(buf + c8 * AK_C + q * 1024), 16, 0, 0); } }
        else { const int i2 = i - 24, db = i2 / 12, q = i2 % 12, k0 = 16 * q;
            if (k0 < a.nkeys) { const bf16_t* src = (k0 < a.n0 ? a.vA + (size_t)(k0 + (F.lane >> 2)) * 128 : a.vB + (size_t)(k0 - a.n0 + (F.lane >> 2)) * 128) + db * 32 + (F.lane & 3) * 8;
                __builtin_amdgcn_global_load_lds((const unsigned*)src, (LAS unsigned*)(buf + AK_H + db * AV_D + q * 1024), 16, 0, 0); } }
    }
}
__device__ __forceinline__ void attn_qload(Fr& F, const AUnit& a, bf16x8 (&qf)[4]) {
    const int r32 = F.lane & 31, hi = F.lane >> 5, hq = a.kvh * 4 + (F.wave & 3), pass = F.wave >> 2;
    const bf16_t* qp = wsp<bf16_t>(F, WS_Q) + (size_t)(a.row0 + 32 * (pass < a.npass ? pass : 0) + r32) * 512 + hq * 64 + 8 * hi;
    asm volatile("global_load_dwordx4 %0, %4, off\n\tglobal_load_dwordx4 %1, %4, off offset:32\n\tglobal_load_dwordx4 %2, %4, off offset:64\n\tglobal_load_dwordx4 %3, %4, off offset:96"
                 : "=&v"(qf[0]), "=&v"(qf[1]), "=&v"(qf[2]), "=&v"(qf[3]) : "v"(qp) : "memory");
}
__device__ __forceinline__ void attn_compute(Fr& F, const AUnit& a, const LAS unsigned char* buf, const bf16x8 (&qf)[4], float sinkL) {
    const int lane = F.lane, r32 = lane & 31, hi = lane >> 5, hq = a.kvh * 4 + (F.wave & 3), pass = F.wave >> 2;
    if (pass >= a.npass) return;
    const int qrow = a.row0 + 32 * pass + r32, nkb = a.nkeys >> 5;
    const LAS unsigned char* kbase = buf + hi * AK_C + r32 * 16;
    const LAS unsigned char* vbase = buf + AK_H + (4 * hi + ((lane & 15) >> 2)) * 64 + ((lane >> 4) & 1) * 32 + (lane & 3) * 8;
    f32x16 P[6];
#pragma unroll
    for (int kb = 0; kb < 6; ++kb) {
        if (kb < nkb) { f32x16 acc = {};
#pragma unroll
            for (int s = 0; s < 4; ++s) { const bf16x8 kf = *(const LAS bf16x8*)(kbase + (2 * s) * AK_C + kb * 512); acc = __builtin_amdgcn_mfma_f32_32x32x16_bf16(kf, qf[s], acc, 0, 0, 0); }
            P[kb] = acc;
        } else {
#pragma unroll
            for (int r = 0; r < 16; ++r) P[kb][r] = -INFINITY; }
    }
    float mx = sinkL;
#pragma unroll
    for (int kb = 0; kb < 6; ++kb)
#pragma unroll
        for (int r = 0; r < 16; ++r) mx = fmaxf(mx, P[kb][r]);
    mx = swap_max(mx);
    float l = 0.f;
#pragma unroll
    for (int kb = 0; kb < 6; ++kb)
#pragma unroll
        for (int r = 0; r < 16; ++r) { const float e = __builtin_amdgcn_exp2f(P[kb][r] - mx); P[kb][r] = e; l += e; }
    l = swap_add(l) + __builtin_amdgcn_exp2f(sinkL - mx);
    f32x16 o0 = {}, o1 = {};
#pragma unroll
    for (int kb = 0; kb < 6; ++kb) {
        if (kb < nkb) {
#pragma unroll
            for (int s2 = 0; s2 < 2; ++s2) {
                u32x4 pw; pw.x = cvtpk(P[kb][8 * s2 + 0], P[kb][8 * s2 + 1]); pw.y = cvtpk(P[kb][8 * s2 + 2], P[kb][8 * s2 + 3]); pw.z = cvtpk(P[kb][8 * s2 + 4], P[kb][8 * s2 + 5]); pw.w = cvtpk(P[kb][8 * s2 + 6], P[kb][8 * s2 + 7]);
                const bf16x8 pb = __builtin_bit_cast(bf16x8, pw);
                const LAS unsigned char* vp = vbase + (32 * kb + 16 * s2) * 64;
                const s16x4 a0l = vtr(vp), a0h = vtr(vp + 512), a1l = vtr(vp + AV_D), a1h = vtr(vp + AV_D + 512);
                const bf16x8 va0 = {a0l[0], a0l[1], a0l[2], a0l[3], a0h[0], a0h[1], a0h[2], a0h[3]}, va1 = {a1l[0], a1l[1], a1l[2], a1l[3], a1h[0], a1h[1], a1h[2], a1h[3]};
                o0 = __builtin_amdgcn_mfma_f32_32x32x16_bf16(va0, pb, o0, 0, 0, 0);
                o1 = __builtin_amdgcn_mfma_f32_32x32x16_bf16(va1, pb, o1, 0, 0, 0);
            }
        }
    }
    const float inv = __builtin_amdgcn_rcpf(l); float ss = 0.f;
#pragma unroll
    for (int r = 0; r < 16; ++r) { o0[r] *= inv; o1[r] *= inv; ss += o0[r] * o0[r] + o1[r] * o1[r]; }
    ss = swap_add(ss);
    if (hi == 0) wsp<float>(F, WS_SSQA)[(size_t)qrow * 8 + hq] = ss;
    const float* gain = inp(F, 24) + hq * 64; bf16_t* op = wsp<bf16_t>(F, WS_MG) + (size_t)qrow * D + 512 + hq * 64;
#pragma unroll
    for (int db = 0; db < 2; ++db)
#pragma unroll
        for (int r4 = 0; r4 < 4; ++r4) { const int d0 = 32 * db + 8 * r4 + 4 * hi; const f32x4 gn = *(const f32x4*)(gain + d0);
            const f32x16& o = db ? o1 : o0; u32x2 pk; pk.x = cvtpk(o[4 * r4 + 0] * gn[0], o[4 * r4 + 1] * gn[1]); pk.y = cvtpk(o[4 * r4 + 2] * gn[2], o[4 * r4 + 3] * gn[3]);
            *(u32x2*)(op + d0) = pk; }
}
__device__ __forceinline__ void attn_phase(Fr& F, int first, int stride, int last) {
    if (first >= last) return;
    AUnit cur = attn_decode(F, first); attn_issue(F, cur, F.lds);
    bf16x8 qc[4], qn[4]; attn_qload(F, cur, qc);
    const float sinkL = inp(F, 13)[cur.kvh * 4 + (F.wave & 3)] * 1.4426950408889634f;
    asm volatile("s_waitcnt vmcnt(0)" ::: "memory"); __builtin_amdgcn_sched_barrier(0); __syncthreads();
    int par = 0;
    for (int u = first; u < last; u += stride) {
        const bool has_next = u + stride < last; AUnit nxt = cur;
        if (has_next) { nxt = attn_decode(F, u + stride); attn_issue(F, nxt, F.lds + (par ^ 1) * ABUF); }
        attn_compute(F, cur, F.lds + par * ABUF, qc, sinkL);
        if (has_next) attn_qload(F, nxt, qn);
        asm volatile("s_waitcnt vmcnt(0) lgkmcnt(0)" ::: "memory"); __builtin_amdgcn_sched_barrier(0); __syncthreads();
        if (has_next) {
#pragma unroll
            for (int s = 0; s < 4; ++s) qc[s] = qn[s]; }
        cur = nxt; par ^= 1;
    }
}

__device__ __forceinline__ void scan_item(Fr& F, int b, int g) {
    const int p = F.lane; const f32x2 L = wsp<f32x2>(F, WS_LAM)[g * 64 + p];
    const float* d0 = wsp<float>(F, WS_DS) + ((size_t)g * 1024 + b * 64) * 128; const float* d1 = d0 + (size_t)32 * 1024 * 128;
    bf16_t* X = wsp<bf16_t>(F, WS_XS) + ((size_t)g * 1024 + b * 64) * XS_LD;
    float hr = 0.f, hi_ = 0.f;
#pragma unroll 16
    for (int c = 0; c < 64; ++c) {
        const float ar = d0[c * 128 + p] + d1[c * 128 + p], ai = d0[c * 128 + 64 + p] + d1[c * 128 + 64 + p];
        X[(size_t)c * XS_LD + p] = (bf16_t)(cvtpk(hr, 0.f) & 0xffffu); X[(size_t)c * XS_LD + 64 + p] = (bf16_t)(cvtpk(hi_, 0.f) & 0xffffu);
        const float nr = L.x * hr - L.y * hi_ + ar, ni = L.x * hi_ + L.y * hr + ai; hr = nr; hi_ = ni;
    }
    *(f32x2*)(outp(F) + O_HP + ((size_t)(b * 32 + g) * 64 + p) * 2) = (f32x2){hr, hi_};
}
__device__ __forceinline__ void sample_s5_item(Fr& F, int item, LAS unsigned char* lds) {
    const int p = F.lane, sb = item >> 5, g = item & 31;
    LAS float* hs = (LAS float*)lds; LAS float* ul = (LAS float*)(lds + 16384); LAS float* Cl = (LAS float*)(lds + 18432);
    const float* us = wsp<float>(F, WS_US) + (size_t)sb * 32 * 512 + g * 16;
    { const int t = p >> 1, h0 = 8 * (p & 1); const f32x4 a = *(const f32x4*)(us + t * 512 + h0), b = *(const f32x4*)(us + t * 512 + h0 + 4); *(LAS f32x4*)(ul + t * 16 + h0) = a; *(LAS f32x4*)(ul + t * 16 + h0 + 4) = b;
      const float* cr = inp(F, 19) + g * 1024; const float* ci = inp(F, 20) + g * 1024;
#pragma unroll
      for (int i = 0; i < 4; ++i) { const int e = 4 * (p + 64 * i), ho = e >> 6, q = e & 63; const f32x4 x = *(const f32x4*)(cr + e), y = *(const f32x4*)(ci + e);
#pragma unroll
          for (int j = 0; j < 4; ++j) { Cl[ho * 129 + q + j] = x[j]; Cl[ho * 129 + 64 + q + j] = y[j]; } } }
    const float are = inp(F, 14)[g * 64 + p], aim = inp(F, 15)[g * 64 + p], dt = __expf(inp(F, 16)[g]);
    const float x1 = are * dt, y1 = aim * dt, ex1 = expm1f(x1), sh = sinf(0.5f * y1), cy = cosf(y1), sy = sinf(y1);
    const float nr = ex1 * cy - 2.f * sh * sh, ni = (ex1 + 1.f) * sy, den = are * are + aim * aim, fr_ = (nr * are + ni * aim) / den, fi_ = (ni * are - nr * aim) / den;
    const float lr = (ex1 + 1.f) * cy, li = (ex1 + 1.f) * sy;
    float bbr[16], bbi[16];
#pragma unroll
    for (int h = 0; h < 16; ++h) { const float br = inp(F, 17)[(g * 64 + p) * 16 + h], bi = inp(F, 18)[(g * 64 + p) * 16 + h]; bbr[h] = fr_ * br - fi_ * bi; bbi[h] = fr_ * bi + fi_ * br; }
    float hr = inp(F, 4)[((sb * 32 + g) * 64 + p) * 2], hi_ = inp(F, 4)[((sb * 32 + g) * 64 + p) * 2 + 1];
    LDS_WAIT(); asm volatile("" ::: "memory");
#pragma unroll 4
    for (int t = 0; t < 32; ++t) {
        const f32x4 u0 = *(const LAS f32x4*)(ul + t * 16), u1 = *(const LAS f32x4*)(ul + t * 16 + 4), u2 = *(const LAS f32x4*)(ul + t * 16 + 8), u3 = *(const LAS f32x4*)(ul + t * 16 + 12);
        const float uu[16] = {u0[0], u0[1], u0[2], u0[3], u1[0], u1[1], u1[2], u1[3], u2[0], u2[1], u2[2], u2[3], u3[0], u3[1], u3[2], u3[3]};
        float sr = 0.f, si = 0.f;
#pragma unroll
        for (int h = 0; h < 16; ++h) { sr += bbr[h] * uu[h]; si += bbi[h] * uu[h]; }
        const float n_r = lr * hr - li * hi_ + sr, n_i = lr * hi_ + li * hr + si; hr = n_r; hi_ = n_i;
        hs[t * 128 + p] = hr; hs[t * 128 + 64 + p] = hi_;
    }
    *(f32x2*)(outp(F) + O_HS + ((size_t)(sb * 32 + g) * 64 + p) * 2) = (f32x2){hr, hi_};
    LDS_WAIT(); asm volatile("" ::: "memory");
    const int ho = p & 15; const float dsk = inp(F, 21)[g * 16 + ho];
    float y[8];
#pragma unroll
    for (int j = 0; j < 8; ++j) y[j] = 0.f;
#pragma unroll 8
    for (int q = 0; q < 64; ++q) { const float cr = Cl[ho * 129 + q], ci = Cl[ho * 129 + 64 + q];
#pragma unroll
        for (int j = 0; j < 8; ++j) { const int t = (p >> 4) + 4 * j; y[j] += cr * hs[t * 128 + q] - ci * hs[t * 128 + 64 + q]; } }
    bf16_t* Gb = wsp<bf16_t>(F, WS_GB);
#pragma unroll
    for (int j = 0; j < 8; ++j) { const int t = (p >> 4) + 4 * j; const float yy = y[j] + dsk * ul[t * 16 + ho]; Gb[((size_t)MP + sb * 32 + t) * 512 + g * 16 + ho] = (bf16_t)(cvtpk(gelu_tanh(yy), 0.f) & 0xffffu); }
    LDS_WAIT(); asm volatile("" ::: "memory");
}
__device__ __forceinline__ void p2_side(Fr& F) {
    unsigned* q2 = wsp<unsigned>(F, WS_CTL) + CW_Q + 128;
    if (F.wave == 0) sample_s5_item(F, F.vcu, F.lds);
    for (int it = F.wave ? F.vcu * 7 + F.wave - 1 : F.G * 7 + wq_next(q2); it < 2048; it = F.G * 7 + wq_next(q2)) toeplitz_rows16(F, 16 * it);
}

__device__ __forceinline__ f32x4 mtile(Fr& F, const bf16_t* A, int lda, const bf16_t* B0, const bf16_t* B1, int ldb, int nspw, float first_scale, float second_scale = 1.f) {
    const int r32 = F.lane & 31, h = F.lane >> 5;
    f32x16 c0 = {}, c1 = {};
    const bf16_t* ap = A + (size_t)r32 * lda + 8 * h + (size_t)F.wave * nspw * 16; const bf16_t* b0p = B0 + (size_t)r32 * ldb + 8 * h + (size_t)F.wave * nspw * 16; const bf16_t* b1p = B1 + (size_t)r32 * ldb + 8 * h + (size_t)F.wave * nspw * 16;
    for (int s0 = 0; s0 < nspw; s0 += 8) {
        bf16x8 av[8], b0v[8], b1v[8];
#pragma unroll
        for (int s = 0; s < 8; ++s) if (s0 + s < nspw) { av[s] = *(const bf16x8*)(ap + 16 * (s0 + s)); b0v[s] = *(const bf16x8*)(b0p + 16 * (s0 + s)); b1v[s] = *(const bf16x8*)(b1p + 16 * (s0 + s)); }
        __builtin_amdgcn_sched_barrier(0);
#pragma unroll
        for (int s = 0; s < 8; ++s) if (s0 + s < nspw) { c0 = __builtin_amdgcn_mfma_f32_32x32x16_bf16(av[s], b0v[s], c0, 0, 0, 0); c1 = __builtin_amdgcn_mfma_f32_32x32x16_bf16(av[s], b1v[s], c1, 0, 0, 0); }
        __builtin_amdgcn_sched_barrier(0);
    }
    LAS float* part = (LAS float*)F.lds;
#pragma unroll
    for (int r = 0; r < 16; ++r) { part[((F.wave * 2 + 0) * 16 + r) * 64 + F.lane] = c0[r]; part[((F.wave * 2 + 1) * 16 + r) * 64 + F.lane] = c1[r]; }
    LDS_WAIT(); __syncthreads();
    const int row = F.tid >> 4, cg = F.tid & 15, j = cg >> 3, hi = (row >> 2) & 1, r = (row & 3) + 4 * (row >> 3);
    f32x4 lo = {0.f, 0.f, 0.f, 0.f}, hi4 = {0.f, 0.f, 0.f, 0.f};
#pragma unroll
    for (int w = 0; w < 8; ++w) { const f32x4 p = *(const LAS f32x4*)(part + ((w * 2 + j) * 16 + r) * 64 + 32 * hi + 4 * (cg & 7)); if (w < 4) lo += p; else hi4 += p; }
    LDS_WAIT(); __syncthreads();
    return lo * first_scale + hi4 * second_scale;
}
__device__ __forceinline__ float sum16(float v) { v += __shfl_xor(v, 1); v += __shfl_xor(v, 2); v += __shfl_xor(v, 4); v += __shfl_xor(v, 8); return v; }
__device__ __forceinline__ void samp_inproj(Fr& F) {
    const bf16_t* A = wsp<bf16_t>(F, WS_XB) + (size_t)MP * D; const bf16_t* W = wsp<bf16_t>(F, WS_WIN);
    for (int t = F.vcu; t < 8 * 20; t += F.G) {
        const int rt = t / 20, ht = t % 20; int n0, n1;
        if (ht < 8) { n0 = 256 * (ht >> 2) + 32 * (ht & 3); n1 = n0 + 128; } else if (ht < 12) { n0 = 512 + 32 * (ht - 8); n1 = n0 + 128; } else { n0 = 768 + 64 * (ht - 12); n1 = n0 + 32; }
        const int rl = F.tid >> 4, cg = F.tid & 15, dim = 4 * cg, row = MP + rt * 32 + rl, mr = NB + rt;
        const int nb = (dim < 32 ? n0 : n1) + (dim & 31);
        const float r1v = wsp<float>(F, WS_R1)[row]; const f32x4 bv = *(const f32x4*)(wsp<float>(F, WS_BIAS1) + (size_t)mr * NIN + nb);
        const f32x4 gnv = *(const f32x4*)((ht < 8 ? inp(F, 11) : inp(F, 12)) + dim);
        const f32x4 acc = mtile(F, A + (size_t)rt * 32 * D, D, W + (size_t)n0 * D, W + (size_t)n1 * D, D, 8, 1.f);
        const f32x4 v = acc * r1v + bv;
        if (ht >= 12) { *(f32x4*)(wsp<float>(F, WS_US) + (size_t)(row - MP) * 512 + 64 * (ht - 12) + dim) = v; continue; }
        if (ht >= 10) { const int kv = ht - 10; u32x2 pk; pk.x = cvtpk(v[0], v[1]); pk.y = cvtpk(v[2], v[3]); *(u32x2*)(wsp<bf16_t>(F, WS_VB) + (size_t)row * 128 + kv * 64 + dim) = pk;
            *(f32x4*)(outp(F) + O_VS + ((size_t)(row - MP) * 2 + kv) * 64 + dim) = v; continue; }
        const float ss = sum16((v[0] * v[0] + v[1] * v[1]) + (v[2] * v[2] + v[3] * v[3])); const float rn = rsqrtf(ss * (1.f / 64.f) + EPS);
        const f32x4 y = v * rn * gnv;
        f32x4 o, pr;
#pragma unroll
        for (int e = 0; e < 4; ++e) pr[e] = __shfl_xor(y[e], 8);
        const float posf = (float)(PAST + rl);
#pragma unroll
        for (int e = 0; e < 4; ++e) { const float ivr = __builtin_amdgcn_exp2f(-(float)((dim & 31) + e) * (13.287712379549449f / 32.f)) * 0.15915494309189535f; const float fr_ = __builtin_amdgcn_fractf(posf * ivr);
            const float cs = __builtin_amdgcn_cosf(fr_), sn = __builtin_amdgcn_sinf(fr_); o[e] = dim < 32 ? y[e] * cs - pr[e] * sn : y[e] * cs + pr[e] * sn; }
        if (ht < 8) { const f32x4 q = o * QSCALE; u32x2 pk; pk.x = cvtpk(q[0], q[1]); pk.y = cvtpk(q[2], q[3]); *(u32x2*)(wsp<bf16_t>(F, WS_Q) + (size_t)row * 512 + ht * 64 + dim) = pk; }
        else { const int kv = ht - 8; u32x2 pk; pk.x = cvtpk(o[0], o[1]); pk.y = cvtpk(o[2], o[3]); *(u32x2*)(wsp<bf16_t>(F, WS_KB) + (size_t)row * 128 + kv * 64 + dim) = pk;
            *(f32x4*)(outp(F) + O_KS + ((size_t)(row - MP) * 2 + kv) * 64 + dim) = o; }
    }
}
__device__ __forceinline__ void samp_glu(Fr& F) {
    const bf16_t* A = wsp<bf16_t>(F, WS_GB) + (size_t)MP * 512; const bf16_t* W = wsp<bf16_t>(F, WS_WGLU);
    for (int t = F.vcu; t < 8 * 8; t += F.G) {
        const int rt = t >> 3, ct = t & 7;
        const int rl = F.tid >> 4, col = 64 * ct + 4 * (F.tid & 15), row = MP + rt * 32 + rl;
        const u32x2 gw = *(const u32x2*)(wsp<bf16_t>(F, WS_GB) + (size_t)row * 512 + col); const f32x4 gbv = *(const f32x4*)(inp(F, 23) + col), gainv = *(const f32x4*)(inp(F, 25) + col);
        const f32x4 acc = mtile(F, A + (size_t)rt * 32 * 512, 512, W + (size_t)(64 * ct) * 512, W + (size_t)(64 * ct + 32) * 512, 512, 4, 1.f);
        const f32x4 g = {bflo(gw.x), bfhi(gw.x), bflo(gw.y), bfhi(gw.y)};
        const f32x4 z = acc + gbv; f32x4 so; float ss = 0.f;
#pragma unroll
        for (int e = 0; e < 4; ++e) { so[e] = g[e] * sigm_f(z[e]); ss += so[e] * so[e]; }
        ss = sum16(ss); if ((F.tid & 15) == 0) wsp<float>(F, WS_SSQ)[(size_t)row * 8 + ct] = ss;
        const f32x4 w = so * gainv; u32x2 pk; pk.x = cvtpk(w[0], w[1]); pk.y = cvtpk(w[2], w[3]); *(u32x2*)(wsp<bf16_t>(F, WS_MG) + (size_t)row * D + col) = pk;
    }
}
__device__ __forceinline__ void samp_outproj(Fr& F) {
    const bf16_t* A = wsp<bf16_t>(F, WS_MG) + (size_t)MP * D; const bf16_t* W = wsp<bf16_t>(F, WS_WOUT);
    for (int t = F.vcu; t < 8 * 16; t += F.G) {
        const int rt = t >> 4, ct = t & 15, rl = F.tid >> 4, col = 64 * ct + 4 * (F.tid & 15), row = MP + rt * 32 + rl, mr = NB + rt;
        const float* sp = wsp<float>(F, WS_SSQ) + (size_t)row * 8; const f32x4 a = *(const f32x4*)sp, b = *(const f32x4*)(sp + 4);
        const float rs = rsqrtf((((a[0] + a[1]) + (a[2] + a[3])) + ((b[0] + b[1]) + (b[2] + b[3]))) * (1.f / 512.f) + EPS);
        const float* md = wsp<float>(F, WS_MOD) + (size_t)mr * NMOD;
        const f32x4 xv = *(const f32x4*)(inp(F, 1) + (size_t)(row - MP) * D + col), g1v = *(const f32x4*)(md + 2 * D + col), w2v = *(const f32x4*)(inp(F, 27) + col) * (1.f + *(const f32x4*)(md + 4 * D + col));
        const float* spa = wsp<float>(F, WS_SSQA) + (size_t)row * 8; const f32x4 a2 = *(const f32x4*)spa, b2 = *(const f32x4*)(spa + 4);
        const float ra = rsqrtf((((a2[0] + a2[1]) + (a2[2] + a2[3])) + ((b2[0] + b2[1]) + (b2[2] + b2[3]))) * (1.f / 512.f) + EPS);
        const f32x4 acc = mtile(F, A + (size_t)rt * 32 * D, D, W + (size_t)(64 * ct) * D, W + (size_t)(64 * ct + 32) * D, D, 8, rs, ra);
        const f32x4 x1 = xv + g1v * acc;
        const float ss = sum16((x1[0] * x1[0] + x1[1] * x1[1]) + (x1[2] * x1[2] + x1[3] * x1[3])); if ((F.tid & 15) == 0) wsp<float>(F, WS_SSQ2)[(size_t)row * 16 + ct] = ss;
        u32x2 pk; pk.x = cvtpk(x1[0], x1[1]); pk.y = cvtpk(x1[2], x1[3]); *(u32x2*)(wsp<bf16_t>(F, WS_X1B) + (size_t)row * D + col) = pk;
        const f32x4 w = x1 * w2v; pk.x = cvtpk(w[0], w[1]); pk.y = cvtpk(w[2], w[3]); *(u32x2*)(wsp<bf16_t>(F, WS_A2) + (size_t)row * D + col) = pk;
    }
}
__device__ __forceinline__ void samp_up(Fr& F) {
    const bf16_t* A = wsp<bf16_t>(F, WS_A2) + (size_t)MP * D; const bf16_t* W = wsp<bf16_t>(F, WS_WGU);
    for (int t = F.vcu; t < 8 * 88; t += F.G) {
        const int rt = t / 88, ft = t % 88, ff0 = 32 * ft, n0 = 256 * (ff0 >> 7) + (ff0 & 127), rl = F.tid >> 4, cg = F.tid & 15, row = MP + rt * 32 + rl, mr = NB + rt;
        const f32x4 bv = *(const f32x4*)(wsp<float>(F, WS_BIAS2) + (size_t)mr * NGU + n0 + (cg < 8 ? 0 : 128) + 4 * (cg & 7));
        const float* sp = wsp<float>(F, WS_SSQ2) + (size_t)row * 16; const f32x4 a = *(const f32x4*)sp, b = *(const f32x4*)(sp + 4), c = *(const f32x4*)(sp + 8), d = *(const f32x4*)(sp + 12);
        const float r2 = rsqrtf(((((a[0] + a[1]) + (a[2] + a[3])) + ((b[0] + b[1]) + (b[2] + b[3]))) + (((c[0] + c[1]) + (c[2] + c[3])) + ((d[0] + d[1]) + (d[2] + d[3])))) * (1.f / D) + EPS);
        const f32x4 acc = mtile(F, A + (size_t)rt * 32 * D, D, W + (size_t)n0 * D, W + (size_t)(n0 + 128) * D, D, 8, 1.f);
        const f32x4 v = acc * r2 + bv;
        f32x4 up;
#pragma unroll
        for (int e = 0; e < 4; ++e) up[e] = __shfl_xor(v[e], 8);
        if (cg < 8) { u32x2 pk; pk.x = cvtpk(silu_f(v[0]) * up[0], silu_f(v[1]) * up[1]); pk.y = cvtpk(silu_f(v[2]) * up[2], silu_f(v[3]) * up[3]); *(u32x2*)(wsp<bf16_t>(F, WS_ACT) + (size_t)row * FF + ff0 + 4 * cg) = pk; }
    }
}
__device__ __forceinline__ void samp_down(Fr& F) {
    const bf16_t* A = wsp<bf16_t>(F, WS_ACT) + (size_t)MP * FF; const bf16_t* W = wsp<bf16_t>(F, WS_WD);
    for (int t = F.vcu; t < 8 * 16; t += F.G) {
        const int rt = t >> 4, ct = t & 15, rl = F.tid >> 4, col = 64 * ct + 4 * (F.tid & 15), row = MP + rt * 32 + rl, mr = NB + rt;
        const u32x2 xw = *(const u32x2*)(wsp<bf16_t>(F, WS_X1B) + (size_t)row * D + col); const f32x4 g2v = *(const f32x4*)(wsp<float>(F, WS_MOD) + (size_t)mr * NMOD + 5 * D + col);
        const f32x4 acc = mtile(F, A + (size_t)rt * 32 * FF, FF, W + (size_t)(64 * ct) * FF, W + (size_t)(64 * ct + 32) * FF, FF, 22, 1.f);
        const f32x4 x1 = {bflo(xw.x), bfhi(xw.x), bflo(xw.y), bfhi(xw.y)};
        *(f32x4*)(outp(F) + (size_t)row * D + col) = x1 + g2v * acc;
    }
}

__device__ __forceinline__ void bias2_tiles(Fr& F) {
    const bf16_t* A = wsp<bf16_t>(F, WS_SH2B); const bf16_t* W = wsp<bf16_t>(F, WS_WGU);
    for (int t = F.vcu - 104; t >= 0 && t < NGU / 64; t += F.G) {
        const f32x4 acc = mtile(F, A, D, W + (size_t)(64 * t) * D, W + (size_t)(64 * t + 32) * D, D, 8, 1.f);
        const int r = F.tid >> 4, col = 64 * t + 4 * (F.tid & 15);
        if (r < 24) *(f32x4*)(wsp<float>(F, WS_BIAS2) + (size_t)r * NGU + col) = acc;
    }
}
__device__ __forceinline__ int r2_table_fill(Fr& F, const pg8::StaticOrder& S) {
    pg8::Unit u; int pmin = 1 << 30, pmax = 0;
    for (int i = 0; S.next(i, u); ++i) { pmin = u.pm < pmin ? u.pm : pmin; pmax = u.pm > pmax ? u.pm : pmax; }
    const float* part = wsp<float>(F, WS_SSQ2); LAS float* tab = (LAS float*)(F.lds + R2TAB_OFF);
    for (int j = 0; pmin + 8 * j <= pmax && j < 6; ++j) { const int row = (pmin + 8 * j) * 256 + (F.tid >> 1); const float* p = part + (size_t)row * 16 + 8 * (F.tid & 1);
        const f32x4 a = *(const f32x4*)p, b = *(const f32x4*)(p + 4); float sum = ((a[0] + a[1]) + (a[2] + a[3])) + ((b[0] + b[1]) + (b[2] + b[3])); sum += __shfl_xor(sum, 1);
        if ((F.tid & 1) == 0) tab[j * 256 + (F.tid >> 1)] = rsqrtf(sum * (1.f / D) + EPS); }
    LDS_WAIT(); __syncthreads();
    return pmin;
}
__device__ __forceinline__ int rsra_table_fill(Fr& F, const pg8::StaticOrder& S) {
    pg8::Unit u; int pmin = 1 << 30, pmax = 0;
    for (int i = 0; S.next(i, u); ++i) { pmin = u.pm < pmin ? u.pm : pmin; pmax = u.pm > pmax ? u.pm : pmax; }
    const float* ps = wsp<float>(F, WS_SSQ); const float* pa = wsp<float>(F, WS_SSQA); LAS float* tab = (LAS float*)(F.lds + R2TAB_OFF);
    for (int j = 0; pmin + 8 * j <= pmax && j < 4; ++j) { const int row = (pmin + 8 * j) * 256 + (F.tid >> 1); const float* p = ((F.tid & 1) ? pa : ps) + (size_t)row * 8;
        const f32x4 a = *(const f32x4*)p, b = *(const f32x4*)(p + 4); const float r = rsqrtf((((a[0] + a[1]) + (a[2] + a[3])) + ((b[0] + b[1]) + (b[2] + b[3]))) * (1.f / 512.f) + EPS);
        const float ra = __shfl_xor(r, 1);
        if ((F.tid & 1) == 0) { tab[j * 512 + (F.tid >> 1)] = r * __builtin_amdgcn_rcpf(ra); tab[j * 512 + 256 + (F.tid >> 1)] = ra; } }
    LDS_WAIT(); __syncthreads();
    return pmin;
}
__global__ void __launch_bounds__(512, 2) mega_fwd(Args args) {
    extern __shared__ __attribute__((aligned(16))) unsigned char lds_raw[];
    Fr F; F.lds = (LAS unsigned char*)lds_raw; F.tid = threadIdx.x; F.lane = F.tid & 63; F.wave = __builtin_amdgcn_readfirstlane(F.tid >> 6);
    F.G = gridDim.x; { const int bx = blockIdx.x; F.vcu = (F.G % 8 == 0) ? (bx % 8) * (F.G / 8) + bx / 8 : bx; }
    volatile LAS unsigned* MISC = (volatile LAS unsigned*)(F.lds + LDSCTL_OFF);
    for (int u = F.tid; u < (LDS_BYTES - LDSCTL_OFF) / 4; u += 512) ((LAS unsigned*)(F.lds + LDSCTL_OFF))[u] = 0u;
    __syncthreads();
    { const unsigned long long* ka = (const unsigned long long*)__builtin_amdgcn_kernarg_segment_ptr(); if (F.tid < 33) ((LAS unsigned long long*)(F.lds + PARAM_OFF))[F.tid] = ka[F.tid]; }
    LDS_WAIT(); __syncthreads();
    unsigned* ctl = wsp<unsigned>(F, WS_CTL);
    XcdBarrier bar = xcd_barrier_post(ctl + CW_BAR, MISC + 8);
    const int bx = (int)blockIdx.x;
#ifdef PROBE_LO
    LAS unsigned long long* tsl = (LAS unsigned long long*)(F.lds + LDSCTL_OFF + 1024); int n_st = 0;
#define STAMP() do { if (F.tid == 0) tsl[n_st] = __builtin_amdgcn_s_memrealtime(); ++n_st; } while (0)
#else
#define STAMP() do {} while (0)
#endif
#define REFRESH() do { int t_ = threadIdx.x; asm volatile("" : "+v"(t_)); F.tid = t_; F.lane = t_ & 63; } while (0)
    STAMP();
    REFRESH(); p0a(F);
    xcd_barrier(bar); STAMP();
    REFRESH(); p0b(F);
    xcd_barrier(bar); STAMP();
    {
        REFRESH(); samp_inproj(F);
#ifdef PROBE_SAMP2
        REFRESH(); samp_inproj(F);
#endif
        pg8::Gemm g{wsp<bf16_t>(F, WS_XB), wsp<bf16_t>(F, WS_WIN), D, D, 1}; pg8::StaticOrder S; S.init(MP, NIN, D, D, D, F.G, bx);
        EpiIn E{F};
        pg8::gemm_phase<EpiIn, pg8::StaticOrder>(F.lds, g, S, E);
    }
    xcd_barrier(bar); STAMP();
    {
        REFRESH();
        attn_phase(F, F.vcu, F.G, 2048);
        pg8::Gemm g{wsp<bf16_t>(F, WS_XS), wsp<bf16_t>(F, WS_BTS), XS_LD, 1024, 0}; StateOrder S{F.vcu}; EpiState E{F};
        pg8::gemm_phase<EpiState, StateOrder>(F.lds, g, S, E);
        REFRESH(); if (F.vcu < 2 * DBT) attn_phase(F, 2048 + F.vcu, F.G, 2048 + 2 * DBT);
        bias2_tiles(F); REFRESH();
        p2_side(F);
#ifdef PROBE_SIDE2
        REFRESH(); if (F.vcu < 2 * DBT) attn_phase(F, 2048 + F.vcu, F.G, 2048 + 2 * DBT);
        bias2_tiles(F); REFRESH(); p2_side(F);
#endif
    }
    xcd_barrier(bar); STAMP();
    {
        REFRESH(); if (F.wave < 4) scan_item(F, 4 * ((F.vcu >> 1) & 3) + F.wave, F.vcu >> 3);
        asm volatile("s_waitcnt vmcnt(0)" ::: "memory"); __syncthreads();
        REFRESH(); samp_glu(F);
#ifdef PROBE_SAMP2
        REFRESH(); samp_glu(F);
#endif
        pg8::Gemm g{wsp<bf16_t>(F, WS_XS), wsp<bf16_t>(F, WS_BTY), XS_LD, XS_LD, 1}; YOrder S{F.vcu}; EpiY E{F};
        pg8::gemm_phase<EpiY, YOrder>(F.lds, g, S, E);
    }
    xcd_barrier(bar); STAMP();
    {
        REFRESH(); samp_outproj(F);
#ifdef PROBE_SAMP2
        REFRESH(); samp_outproj(F);
#endif
        pg8::Gemm g{wsp<bf16_t>(F, WS_GB), wsp<bf16_t>(F, WS_WGLU), 512, 512, 1}; pg8::StaticOrder S; S.init(MP, 512, 512, 512, 512, F.G, bx);
        EpiGlu E{F};
        pg8::gemm_phase<EpiGlu, pg8::StaticOrder>(F.lds, g, S, E);
    }
    xcd_barrier(bar); STAMP();
    {
        REFRESH(); samp_up(F);
#ifdef PROBE_SAMP2
        REFRESH(); samp_up(F);
#endif
        pg8::Gemm g{wsp<bf16_t>(F, WS_MG), wsp<bf16_t>(F, WS_WOUT), D, D, 1}; pg8::StaticOrder S; S.init(MP, D, D, D, D, F.G, bx);
        REFRESH(); EpiOut E{F, rsra_table_fill(F, S)};
        pg8::gemm_phase<EpiOut, pg8::StaticOrder>(F.lds, g, S, E);
    }
    xcd_barrier(bar); STAMP();
    {
        REFRESH(); samp_down(F);
#ifdef PROBE_SAMP2
        REFRESH(); samp_down(F);
#endif
        pg8::Gemm g{wsp<bf16_t>(F, WS_A2), wsp<bf16_t>(F, WS_WGU), D, D, 1}; pg8::StaticOrder S; S.init(MP, NGU, D, D, D, F.G, bx);
        REFRESH(); EpiUp E{F, r2_table_fill(F, S)};
        pg8::gemm_phase<EpiUp, pg8::StaticOrder>(F.lds, g, S, E);
    }
    xcd_barrier(bar); STAMP();
    {
        pg8::Gemm g{wsp<bf16_t>(F, WS_ACT), wsp<bf16_t>(F, WS_WD), 64, FF, 1, 32768, 16384}; pg8::StaticOrder S; S.init(MP, D, FF, FF, FF, F.G, bx); S.ta = (size_t)(FF / 64) * 32768;
        EpiDown E{F};
        pg8::gemm_phase<EpiDown, pg8::StaticOrder>(F.lds, g, S, E);
    }
    STAMP();
#ifdef PROBE_LO
    if (bx == 0 && F.tid == 0) { asm volatile("s_waitcnt lgkmcnt(0)" ::: "memory"); const unsigned long long d = (tsl[PROBE_HI] - tsl[PROBE_LO]) * PROBE_SCALE, t0 = __builtin_amdgcn_s_memrealtime();
        while (__builtin_amdgcn_s_memrealtime() - t0 < d) __builtin_amdgcn_s_sleep(8); }
#endif
}

extern "C" void kernel_launch(void* const* d_in, const int* in_sizes, int n_in, void* d_out, int out_size, void* d_ws, size_t ws_size, hipStream_t stream) {
    static int ready = 0;
    if (ready == 0) {
        ready = -1;
        if (n_in != 31 || ws_size < WS_END) { fprintf(stderr, "kernel_launch: unexpected n_in %d / ws %zu\n", n_in, ws_size); return; }
        int dev = 0, cus = 0;
        if (hipGetDevice(&dev) != hipSuccess || hipDeviceGetAttribute(&cus, hipDeviceAttributeMultiprocessorCount, dev) != hipSuccess) return;
        if (hipFuncSetAttribute((const void*)mega_fwd, hipFuncAttributeMaxDynamicSharedMemorySize, LDS_BYTES) != hipSuccess) { fprintf(stderr, "kernel_launch: hipFuncSetAttribute failed\n"); return; }
        if (cus != 256) fprintf(stderr, "kernel_launch: %d CUs (built for 256)\n", cus);
        (void)hipGetLastError();
        ready = 1;
    }
    if (ready < 0) return;
    (void)hipMemsetAsync((char*)d_ws + WS_CTL, 0, CTL_ZERO_BYTES, stream);
    Args a{};
    for (int i = 0; i < 31; ++i) a.in[i] = (const float*)d_in[i];
    a.out = (float*)d_out; a.ws = (unsigned char*)d_ws;
    hipLaunchKernelGGL(mega_fwd, dim3(256), dim3(512), LDS_BYTES, stream, a);
}
```

```cpp
#include <hip/hip_runtime.h>
#include <cstdio>
#include <cstdint>
#include <cmath>

#define LAS __attribute__((address_space(3)))
#define GAS __attribute__((address_space(1)))
typedef unsigned short bf16_t;
typedef short bf16x8 __attribute__((ext_vector_type(8)));
typedef short s16x4 __attribute__((ext_vector_type(4)));
typedef float f32x4 __attribute__((ext_vector_type(4)));
typedef float f32x2 __attribute__((ext_vector_type(2)));
typedef float f32x16 __attribute__((ext_vector_type(16)));
typedef unsigned u32x4 __attribute__((ext_vector_type(4)));
typedef unsigned u32x2 __attribute__((ext_vector_type(2)));
typedef __bf16 bf16x2_t __attribute__((ext_vector_type(2)));

constexpr int D = 1024, NB = 16, SEQ = 4096, DBT = 8, DS = 32, PAST = 1024;
constexpr int MP = NB * SEQ, MS = DBT * DS, M = MP + MS;
constexpr int NIN = 1280, FF = 2816, NGU = 2 * FF, NMOD = 6 * D;
constexpr int XS_LD = 1152;
constexpr float EPS = 1e-6f;
constexpr float QSCALE = 0.125f * 1.4426950408889634f;
constexpr size_t O_Y = 0, O_YS = (size_t)MP * D, O_KP = O_YS + (size_t)MS * D, O_VP = O_KP + 262144, O_HP = O_VP + 262144,
                 O_KS = O_HP + 65536, O_VS = O_KS + 32768, O_HS = O_VS + 32768;
constexpr size_t MiB = 1u << 20;
constexpr size_t WS_CTL = 0, CTL_ZERO_BYTES = 64 * 1024;
constexpr size_t WS_MOD = 1 * MiB, WS_BIAS1 = 2 * MiB, WS_BIAS2 = 2 * MiB + 128 * 1024, WS_R1 = 3 * MiB, WS_ROPE = 4 * MiB, WS_SSQ = 5 * MiB, WS_SSQ2 = 8 * MiB,
                 WS_KMAT = 13 * MiB, WS_LAM = 15 * MiB, WS_SH2B = 15 * MiB + 32 * 1024, WS_US = 15 * MiB + 128 * 1024, WS_SSQA = 913 * MiB, WS_KC = 916 * MiB, WS_VC = 917 * MiB,
                 WS_WIN = 16 * MiB, WS_WGLU = 19 * MiB, WS_WOUT = 20 * MiB, WS_WGU = 22 * MiB, WS_WD = 33 * MiB, WS_BTS = 39 * MiB, WS_BTY = 48 * MiB,
                 WS_A2 = 128 * MiB, WS_XB = 257 * MiB, WS_Q = 386 * MiB, WS_KB = 451 * MiB, WS_VB = 468 * MiB, WS_XS = 485 * MiB, WS_DS = 557 * MiB,
                 WS_GB = 589 * MiB, WS_MG = 654 * MiB, WS_ACT = 257 * MiB, WS_X1B = 784 * MiB, WS_END = 918 * MiB;
constexpr int CW_TMO = 0, CW_BAR = 4096, CW_Q = 8192;

__device__ __forceinline__ unsigned cvtpk(float lo, float hi) { f32x2 v = {lo, hi}; bf16x2_t b = __builtin_convertvector(v, bf16x2_t); return __builtin_bit_cast(unsigned, b); }
__device__ __forceinline__ u32x4 pack8(const f32x4& a, const f32x4& b) { u32x4 o; o.x = cvtpk(a[0], a[1]); o.y = cvtpk(a[2], a[3]); o.z = cvtpk(b[0], b[1]); o.w = cvtpk(b[2], b[3]); return o; }
__device__ __forceinline__ float bf2f(unsigned short h) { return __uint_as_float((unsigned)h << 16); }
__device__ __forceinline__ float bflo(unsigned w) { return __uint_as_float(w << 16); }
__device__ __forceinline__ float bfhi(unsigned w) { return __uint_as_float(w & 0xffff0000u); }
__device__ __forceinline__ int modrow_of(int m) { return m < MP ? (m >> 12) : NB + ((m - MP) >> 5); }
__device__ __forceinline__ int pos_of(int m) { return m < MP ? (m & (SEQ - 1)) : PAST + ((m - MP) & (DS - 1)); }
__device__ __forceinline__ float silu_f(float v) { return v * __builtin_amdgcn_rcpf(1.f + __builtin_amdgcn_exp2f(-1.4426950408889634f * v)); }
__device__ __forceinline__ float sigm_f(float v) { return __builtin_amdgcn_rcpf(1.f + __builtin_amdgcn_exp2f(-1.4426950408889634f * v)); }
__device__ __forceinline__ float gelu_tanh(float y) { const float u = 0.7978845608028654f * (y + 0.044715f * y * y * y); const float e = __builtin_amdgcn_exp2f(2.8853900817779268f * u); return y * (1.f - __builtin_amdgcn_rcpf(e + 1.f)); }
__device__ __forceinline__ float wave_sum(float v) {
#pragma unroll
    for (int o = 1; o < 64; o <<= 1) v += __shfl_xor(v, o);
    return v;
}
__device__ __forceinline__ int wq_next(unsigned* ctr) { unsigned v = 0; if ((threadIdx.x & 63) == 0) v = __hip_atomic_fetch_add(ctr, 1u, __ATOMIC_RELAXED, __HIP_MEMORY_SCOPE_AGENT); return (int)__builtin_amdgcn_readfirstlane(v); }
#define LDS_WAIT() asm volatile("s_waitcnt lgkmcnt(0)" ::: "memory")
#define VM_WAIT() asm volatile("s_waitcnt vmcnt(0)" ::: "memory")

namespace pg8 {
constexpr int BM = 256, BK = 64, HALF = 128, HTB = HALF * BK * 2, STAGE_BYTES = 8 * HTB, NXCD = 8, WGM = 8;
__host__ __device__ __forceinline__ int lds_byte(int r, int c) { const int st = (r >> 4) * 2 + (c >> 5), rr = r & 15, cc = c & 31, ob = rr * 64 + cc * 2; return st * 1024 + (ob ^ (((ob >> 9) & 1) << 5)); }
__host__ __device__ __forceinline__ int perm32(int rho) { const int n = rho >> 4, i = rho & 15; return 8 * (i >> 2) + 4 * n + (i & 3); }
__host__ __device__ __forceinline__ void stage_rc(int b, int& R, int& C) { const int st = b / 1024, sb = b % 1024, swz = sb ^ (((sb >> 9) & 1) << 5); R = (st >> 1) * 16 + swz / 64; C = (st & 1) * 32 + (swz % 64) / 2; }

struct Unit { size_t aoff, boff; int pm, pn, nt, aux; };
struct Gemm { const bf16_t* A; const bf16_t* Bt; int lda, ldb; int bhalf; size_t kstepA = 128, hstepA = 0; };

struct StaticOrder {
    int nM, nN, nwg, G, c, nt, rev = 0; size_t ta, tb;
    __device__ void init(int M_, int N_, int K_, int lda, int ldb, int G_, int c_) { nM = M_ / BM; nN = N_ / BM; nwg = nM * nN; G = G_; c = c_; nt = K_ / BK; ta = (size_t)BM * lda * 2; tb = (size_t)BM * ldb * 2; }
    __device__ bool next(int i, Unit& u) const {
        const long L = (long)i * G + c; if (L >= nwg) return false;
        int wgid = (int)L; { const int q = nwg / NXCD, r = nwg % NXCD, xcd = wgid % NXCD, off = wgid / NXCD; wgid = (xcd < r ? xcd * (q + 1) : r * (q + 1) + (xcd - r) * q) + off; }
        const int nig = WGM * nN, gid = wgid / nig, fm = gid * WGM, gsz = (nM - fm) < WGM ? (nM - fm) : WGM;
        u.pm = fm + ((wgid % nig) % gsz); if (rev) u.pm = nM - 1 - u.pm; u.pn = (wgid % nig) / gsz; u.aoff = (size_t)u.pm * ta; u.boff = (size_t)u.pn * tb; u.nt = nt; u.aux = 0; return true;
    }
};

template <class Epi, class Sched>
__device__ __forceinline__ void gemm_phase(LAS unsigned char* lds, const Gemm g, const Sched& S, const Epi& E) {
    int tid_ = threadIdx.x; asm volatile("" : "+v"(tid_));
    const int tid = tid_, wid = __builtin_amdgcn_readfirstlane(tid >> 6), lane = tid & 63, wr = wid >> 2, wc = wid & 3, fr = lane & 15, fq = lane >> 4;
    unsigned voffA[2], voffB[2];
#pragma unroll
    for (int i = 0; i < 2; ++i) { int R, C; stage_rc(tid * 16 + i * 8192, R, C); const int Rb = (R & ~31) + perm32(R & 31); voffA[i] = (unsigned)(R * g.lda + C) * 2u; voffB[i] = (unsigned)(Rb * g.ldb + C) * 2u; }
    const size_t kstep = (size_t)(BK * 2), kstepA = g.kstepA;
    const size_t hstepA = g.hstepA ? g.hstepA : (size_t)HALF * g.lda * 2, hstepB = g.bhalf ? (size_t)HALF * g.ldb * 2 : 0;
    const unsigned ldsw = (unsigned)wid * 1024u;
    const int aoff = lds_byte(wr * 64 + fr, fq * 8), boff = lds_byte(wc * 32 + fr, fq * 8);
#define PG8_SA(b, h) (((b) * 2 + (h)) * HTB)
#define PG8_SB(b, h) ((4 + (b) * 2 + (h)) * HTB)
#define PG8_STAGE(bufoff, gbase, voff) do { _Pragma("unroll") for (int _i = 0; _i < 2; ++_i) \
        __builtin_amdgcn_global_load_lds((const unsigned*)((const char*)(gbase) + (voff)[_i]), (LAS unsigned*)(lds + (bufoff) + ldsw + _i * 8192), 16, 0, 0); } while (0)
#define PG8_LDA(dst, b, h) do { _Pragma("unroll") for (int m = 0; m < 4; ++m) _Pragma("unroll") for (int k = 0; k < 2; ++k) dst[m][k] = *(const LAS bf16x8*)(lds + PG8_SA(b, h) + aoff + m * 2048 + k * 1024); } while (0)
#define PG8_LDB(dst, b, h) do { _Pragma("unroll") for (int n = 0; n < 2; ++n) _Pragma("unroll") for (int k = 0; k < 2; ++k) dst[n][k] = *(const LAS bf16x8*)(lds + PG8_SB(b, h) + boff + n * 2048 + k * 1024); } while (0)
#define PG8_MMA(ai, bj, At, Bt) do { __builtin_amdgcn_s_setprio(1); _Pragma("unroll") for (int m = 0; m < 4; ++m) _Pragma("unroll") for (int n = 0; n < 2; ++n) _Pragma("unroll") for (int k = 0; k < 2; ++k) \
        acc[ai][bj][m][n] = __builtin_amdgcn_mfma_f32_16x16x32_bf16(Bt[n][k], At[m][k], acc[ai][bj][m][n], 0, 0, 0); __builtin_amdgcn_s_setprio(0); } while (0)
#define PG8_WAIT_V(n) asm volatile("s_waitcnt vmcnt(" #n ")" ::: "memory")
#define PG8_WAIT_L(n) asm volatile("s_waitcnt lgkmcnt(" #n ")" ::: "memory")
#define PG8_BAR __builtin_amdgcn_s_barrier()
#define PG8_SCHED __builtin_amdgcn_sched_barrier(0)
    Unit cur, nxt; int ui = 0;
    if (!S.next(0, cur)) return;
    f32x4 acc[2][2][4][2];
#pragma unroll
    for (int a = 0; a < 2; ++a)
#pragma unroll
        for (int b = 0; b < 2; ++b)
#pragma unroll
            for (int m = 0; m < 4; ++m)
#pragma unroll
                for (int n = 0; n < 2; ++n) acc[a][b][m][n] = (f32x4){0.f, 0.f, 0.f, 0.f};
    bf16x8 At[4][2], B0[2][2], B1[2][2];
    const char* cA = (const char*)g.A + cur.aoff; const char* cB = (const char*)g.Bt + cur.boff;
    PG8_STAGE(PG8_SB(0, 0), cB, voffB); PG8_STAGE(PG8_SB(0, 1), cB + hstepB, voffB); PG8_STAGE(PG8_SA(0, 0), cA, voffA); PG8_STAGE(PG8_SA(0, 1), cA + hstepA, voffA);
    if (wr == 1) PG8_BAR;
    PG8_WAIT_V(2); PG8_BAR;
    PG8_STAGE(PG8_SB(1, 0), cB + kstep, voffB); PG8_STAGE(PG8_SA(1, 0), cA + kstepA, voffA); PG8_STAGE(PG8_SB(1, 1), cB + hstepB + kstep, voffB);
    PG8_WAIT_V(6); PG8_BAR;
    for (;;) {
        const bool has_next = S.next(ui + 1, nxt);
        const char* nA = has_next ? (const char*)g.A + nxt.aoff : cA; const char* nB = has_next ? (const char*)g.Bt + nxt.boff : cB;
        const int nt = cur.nt;
        for (int t = 0; t < nt; t += 2) {
            const bool last = (t == nt - 2);
            const char* a1 = cA + (size_t)(t + 1) * kstepA;
            const char* a2 = last ? nA : cA + (size_t)(t + 2) * kstepA; const char* b2 = last ? nB : cB + (size_t)(t + 2) * kstep;
            const char* a3 = a2 + kstepA; const char* b3 = b2 + kstep;
            if constexpr (Epi::HAS_MID) { if (t == Epi::MID_T) { int fr_ = fr, fq_ = fq; asm volatile("" : "+v"(fr_), "+v"(fq_)); E.mid(acc, cur, wr, wc, fr_, fq_); } }
            PG8_LDB(B0, 0, 0); PG8_LDB(B1, 0, 1); PG8_SCHED; PG8_LDA(At, 0, 0); PG8_STAGE(PG8_SA(1, 1), a1 + hstepA, voffA);
            PG8_WAIT_V(8); PG8_WAIT_L(0); PG8_BAR; PG8_MMA(0, 0, At, B0); PG8_MMA(0, 1, At, B1); PG8_BAR; PG8_SCHED;
            PG8_LDA(At, 0, 1); PG8_STAGE(PG8_SB(0, 0), b2, voffB); PG8_STAGE(PG8_SB(0, 1), b2 + hstepB, voffB); PG8_STAGE(PG8_SA(0, 0), a2, voffA);
            PG8_WAIT_V(8); PG8_WAIT_L(0); PG8_BAR; PG8_MMA(1, 0, At, B0); PG8_MMA(1, 1, At, B1); PG8_BAR; PG8_SCHED;
            PG8_LDB(B0, 1, 0); PG8_LDB(B1, 1, 1); PG8_SCHED; PG8_LDA(At, 1, 0); PG8_STAGE(PG8_SA(0, 1), a2 + hstepA, voffA);
            PG8_WAIT_V(8); PG8_WAIT_L(0); PG8_BAR; PG8_MMA(0, 0, At, B0); PG8_MMA(0, 1, At, B1); PG8_BAR; PG8_SCHED;
            PG8_LDA(At, 1, 1); PG8_STAGE(PG8_SB(1, 0), b3, voffB); PG8_STAGE(PG8_SB(1, 1), b3 + hstepB, voffB); PG8_STAGE(PG8_SA(1, 0), a3, voffA);
            PG8_WAIT_V(8); PG8_WAIT_L(0); PG8_BAR; PG8_MMA(1, 0, At, B0); PG8_MMA(1, 1, At, B1); PG8_BAR; PG8_SCHED;
        }
        if (wr == 0) PG8_BAR;
        { int fr_ = fr, fq_ = fq; asm volatile("" : "+v"(fr_), "+v"(fq_)); E(acc, cur, wr, wc, fr_, fq_);
#ifdef PROBE_EPI2
          if constexpr (Epi::EPI2) { asm volatile("" : "+v"(fr_), "+v"(fq_) :: "memory"); E(acc, cur, wr, wc, fr_, fq_); }
#endif
        }
        if (!has_next) break;
#pragma unroll
        for (int a = 0; a < 2; ++a)
#pragma unroll
            for (int b = 0; b < 2; ++b)
#pragma unroll
                for (int m = 0; m < 4; ++m)
#pragma unroll
                    for (int n = 0; n < 2; ++n) acc[a][b][m][n] = (f32x4){0.f, 0.f, 0.f, 0.f};
        cur = nxt; cA = nA; cB = nB; ++ui;
        if (wr == 1) PG8_BAR;
    }
    PG8_WAIT_V(0);
    PG8_BAR;
#undef PG8_SA
#undef PG8_SB
#undef PG8_STAGE
#undef PG8_LDA
#undef PG8_LDB
#undef PG8_MMA
#undef PG8_WAIT_V
#undef PG8_WAIT_L
#undef PG8_BAR
#undef PG8_SCHED
}
}

#define XB_TMO      128
#define XB_XCNT(j)  (256  + 64 * (j))
#define XB_XSUB(j)  (1280 + 64 * (j))
#define XB_XGEN(j)  (2304 + 64 * (j))
#define XB_TOP      3328
#define XB_TOPGEN   3392
#define XCD_BAR_WORDS 3456
#define XB_SPIN_CAP (1u << 18)
__device__ __forceinline__ unsigned xb_ld(unsigned* p)              { return __hip_atomic_load(p, __ATOMIC_RELAXED, __HIP_MEMORY_SCOPE_AGENT); }
__device__ __forceinline__ unsigned xb_add(unsigned* p, unsigned v) { return __hip_atomic_fetch_add(p, v, __ATOMIC_RELAXED, __HIP_MEMORY_SCOPE_AGENT); }
__device__ __forceinline__ unsigned xb_xcc_id() { return (unsigned)__builtin_amdgcn_s_getreg((3 << 11) | 20) & 0xFu; }
#define XB_SPIN(cond, bar) do { unsigned _sp = 0; while (cond) { __builtin_amdgcn_s_sleep(1); \
    if ((++_sp & 255u) == 0u) { if (xb_ld(&(bar)[XB_TMO])) break; if (_sp > XB_SPIN_CAP) { atomicAdd(&(bar)[XB_TMO], 1u); break; } } } } while (0)
struct XcdBarrier { unsigned* bar; unsigned x; volatile LAS unsigned* st; };
__device__ __forceinline__ XcdBarrier xcd_barrier_post(unsigned* bar, volatile LAS unsigned* st) {
    XcdBarrier b; b.bar = bar; b.x = xb_xcc_id(); b.st = st;
    if (threadIdx.x == 0) (void)xb_add(&bar[XB_XCNT(b.x)], 1u);
    return b;
}
__device__ __forceinline__ void xcd_barrier_complete(unsigned* bar, unsigned x, unsigned& nloc, unsigned& nx) {
    const unsigned G = gridDim.x * gridDim.y * gridDim.z;
    unsigned sum, cnt, mine, sp = 0u;
    for (;;) {
        sum = 0u; cnt = 0u; mine = 0u;
#pragma unroll
        for (unsigned j = 0; j < 16; ++j) { const unsigned c = xb_ld(&bar[XB_XCNT(j)]); sum += c; cnt += (c > 0u) ? 1u : 0u; mine = (j == x) ? c : mine; }
        if (sum == G) break;
        __builtin_amdgcn_s_sleep(1);
        if ((++sp & 255u) == 0u) { if (xb_ld(&bar[XB_TMO])) break; if (sp > XB_SPIN_CAP) { atomicAdd(&bar[XB_TMO], 1u); break; } }
    }
    nloc = mine > 0u ? mine : 1u; nx = cnt > 0u ? cnt : 1u;
}
__device__ __forceinline__ void xcd_barrier(const XcdBarrier& b) {
    asm volatile("s_waitcnt vmcnt(0)" ::: "memory");
    __syncthreads();
    if (threadIdx.x == 0) {
        unsigned* bar = b.bar;
        __builtin_amdgcn_s_waitcnt(0);
        unsigned nloc = b.st[0], nx = b.st[1];
        if (nloc == 0u) { xcd_barrier_complete(bar, b.x, nloc, nx); b.st[0] = nloc; b.st[1] = nx; }
        const unsigned old = xb_add(&bar[XB_XSUB(b.x)], 1u);
        const unsigned gen = old / nloc;
        if (old + 1u == (gen + 1u) * nloc) {
            __builtin_amdgcn_fence(__ATOMIC_RELEASE, "agent");
            asm volatile("s_waitcnt vmcnt(0)" ::: "memory");
            const unsigned og = xb_add(&bar[XB_TOP], 1u);
            const unsigned tg = og / nx;
            if (og + 1u == (tg + 1u) * nx) xb_add(&bar[XB_TOPGEN], 1u);
            else XB_SPIN(xb_ld(&bar[XB_TOPGEN]) == tg, bar);
            __builtin_amdgcn_fence(__ATOMIC_ACQUIRE, "agent");
            xb_add(&bar[XB_XGEN(b.x)], 1u);
            asm volatile("s_waitcnt vmcnt(0)" ::: "memory");
        } else {
            XB_SPIN(xb_ld(&bar[XB_XGEN(b.x)]) == gen, bar);
            __builtin_amdgcn_fence(__ATOMIC_ACQUIRE, "agent");
            asm volatile("s_waitcnt vmcnt(0)" ::: "memory");
        }
    }
    __syncthreads();
}

constexpr int RING_BYTES = 131072, LDSCTL_OFF = RING_BYTES, LDS_BYTES = 147456;
struct Args { const float* in[31]; float* out; unsigned char* ws; };
constexpr int PARAM_OFF = LDSCTL_OFF + 256;
struct Fr { LAS unsigned char* lds; int tid, lane, wave, vcu, G; };
__device__ __forceinline__ unsigned long long ldparam(const Fr& F, int i) { const LAS unsigned* p = (const LAS unsigned*)(F.lds + PARAM_OFF) + 2 * i;
    const unsigned lo = __builtin_amdgcn_readfirstlane(p[0]), hi = __builtin_amdgcn_readfirstlane(p[1]); return ((unsigned long long)hi << 32) | lo; }
__device__ __forceinline__ const float* inp(const Fr& F, int i) { return (const float*)(const GAS float*)ldparam(F, i); }
__device__ __forceinline__ float* outp(const Fr& F) { return (float*)(GAS float*)ldparam(F, 31); }
template <class T> __device__ __forceinline__ T* wsp(const Fr& F, size_t off) { return (T*)(GAS T*)(ldparam(F, 32) + off); }

struct BTick { unsigned* q; unsigned nv; };
__device__ __forceinline__ int bt_pub(Fr& F, unsigned v) { volatile LAS int* slot = (volatile LAS int*)(F.lds + RING_BYTES) + 14; if (F.tid == 0) *slot = (int)v; asm volatile("s_waitcnt lgkmcnt(0)" ::: "memory"); __syncthreads(); const int t = *slot; __syncthreads(); return t; }
__device__ __forceinline__ int bt_first(Fr& F, BTick& T) { unsigned v = 0; if (F.tid == 0) v = __hip_atomic_fetch_add(T.q, 1u, __ATOMIC_RELAXED, __HIP_MEMORY_SCOPE_AGENT); return bt_pub(F, v); }
__device__ __forceinline__ void bt_issue(Fr& F, BTick& T) { T.nv = 0; if (F.tid == 0) T.nv = __hip_atomic_fetch_add(T.q, 1u, __ATOMIC_RELAXED, __HIP_MEMORY_SCOPE_AGENT); }
__device__ __forceinline__ int bt_take(Fr& F, BTick& T) { return bt_pub(F, T.nv); }
__device__ __forceinline__ int in_srccol(int n) {
    const int pn = n >> 8, c = n & 255, bj = c >> 7, wc = (c >> 5) & 3, i = c & 31;
    if (pn < 2) return 64 * (4 * pn + wc) + 32 * bj + i;
    if (pn == 2) return (wc < 2 ? 512 + 64 * wc : 640 + 64 * (wc - 2)) + 32 * bj + i;
    return 768 + 256 * (pn - 3) + c;
}
__device__ __forceinline__ int gu_ff(int n) { return 128 * (n >> 8) + (n & 127); }

__device__ __forceinline__ void tr_item(const float* W, int ldw, int k0, int scol0, bf16_t* WT, int drow0, int ldt, int dk0, LAS float* scr, int lane) {
    { float t[32]; const float* wp = W + (size_t)(k0 + (lane >> 5)) * ldw + scol0 + (lane & 31);
#pragma unroll
      for (int i = 0; i < 32; ++i) t[i] = wp[(size_t)(2 * i) * ldw];
#pragma unroll
      for (int i = 0; i < 32; ++i) scr[(2 * i + (lane >> 5)) * 33 + (lane & 31)] = t[i]; }
    LDS_WAIT(); asm volatile("" ::: "memory");
    const int c = lane & 7;
#pragma unroll
    for (int j = 0; j < 4; ++j) { const int n = (lane >> 3) + 8 * j; const LAS float* s = scr + (8 * c) * 33 + n;
        u32x4 o; o.x = cvtpk(s[0 * 33], s[1 * 33]); o.y = cvtpk(s[2 * 33], s[3 * 33]); o.z = cvtpk(s[4 * 33], s[5 * 33]); o.w = cvtpk(s[6 * 33], s[7 * 33]);
        *(u32x4*)(WT + (size_t)(drow0 + n) * ldt + dk0 + 8 * c) = o; }
    LDS_WAIT(); asm volatile("" ::: "memory");
}
template <int MODE> __device__ __forceinline__ void gemv24(Fr& F, int item) {
    const int cl = F.lane & 31, kh = F.lane >> 5, n = 32 * item + cl; const float* W; int ldw, sc;
    if (MODE == 0) { W = inp(F, 7); ldw = NMOD; sc = n; } else if (MODE == 1) { W = inp(F, 10); ldw = NIN; sc = in_srccol(n); } else { W = ((item >> 2) & 1) ? inp(F, 29) : inp(F, 28); ldw = FF; sc = gu_ff(n); }
    const float* mod = wsp<float>(F, WS_MOD);
    float acc[24];
#pragma unroll
    for (int r = 0; r < 24; ++r) acc[r] = 0.f;
    LAS float* svl = (LAS float*)(F.lds + 32768) + F.wave * (128 * 24);
    const int k0 = 128 * F.wave;
    {
        const float* rp; size_t rstride;
        if (MODE == 0) { rp = inp(F, 5) + k0 + F.lane; rstride = D; } else { rp = mod + (MODE == 2 ? 3 * D : 0) + k0 + F.lane; rstride = NMOD; }
        const float* rp2 = inp(F, 6) + k0 + F.lane;
#pragma unroll
        for (int h = 0; h < 2; ++h) { float v[24];
#pragma unroll 24
            for (int r = 0; r < 24; ++r) v[r] = (MODE == 0 && r >= NB) ? rp2[(size_t)(r - NB) * D + 64 * h] : rp[(size_t)r * rstride + 64 * h];
#pragma unroll
            for (int r = 0; r < 24; ++r) svl[(F.lane + 64 * h) * 24 + r] = MODE == 0 ? silu_f(v[r]) : v[r]; }
        LDS_WAIT(); asm volatile("" ::: "memory"); }
    {
        float wv[64];
#pragma unroll
        for (int q = 0; q < 64; ++q) wv[q] = W[(size_t)(k0 + 2 * q + kh) * ldw + sc];
#pragma unroll
        for (int q = 0; q < 64; ++q) {
#pragma unroll
            for (int i = 0; i < 6; ++i) { const f32x4 sv4 = *(const LAS f32x4*)(svl + (2 * q + kh) * 24 + 4 * i);
#pragma unroll
                for (int j = 0; j < 4; ++j) acc[4 * i + j] += sv4[j] * wv[q]; } }
    }
    LDS_WAIT(); asm volatile("" ::: "memory");
#pragma unroll
    for (int r = 0; r < 24; ++r) acc[r] += __shfl_xor(acc[r], 32);
    LAS float* red = (LAS float*)F.lds;
    if (kh == 0) {
#pragma unroll
        for (int r = 0; r < 24; ++r) red[(F.wave * 24 + r) * 32 + cl] = acc[r]; }
    LDS_WAIT(); __syncthreads();
    for (int o = F.tid; o < 24 * 32; o += 512) { const int r = o >> 5, cc = o & 31; float t = 0.f;
#pragma unroll
        for (int w = 0; w < 8; ++w) t += red[(w * 24 + r) * 32 + cc];
        if (MODE == 0) wsp<float>(F, WS_MOD)[r * NMOD + 32 * item + cc] = t + inp(F, 8)[32 * item + cc];
        else if (MODE == 1) wsp<float>(F, WS_BIAS1)[r * NIN + 32 * item + cc] = t;
        else wsp<float>(F, WS_BIAS2)[r * NGU + 32 * item + cc] = t; }
    LDS_WAIT(); __syncthreads();
}
__device__ __forceinline__ void p0_item(Fr& F, int it) {
    LAS float* scr = (LAS float*)(F.lds + F.wave * 16384);
    constexpr int I_IN = 16 * 40, I_GLU = 8 * 16, I_OUT = 16 * 32, I_GU = 16 * 176, I_D = 44 * 32, I_TR = I_IN + I_GLU + I_OUT + I_GU + I_D, I_SSM = 32 * 65;
        int r = it < I_SSM ? it + I_TR : it - I_SSM;
        if (r < I_IN) { const int kb = r / 40, nb = r % 40; tr_item(inp(F, 10), NIN, 64 * kb, in_srccol(32 * nb), wsp<bf16_t>(F, WS_WIN), 32 * nb, D, 64 * kb, scr, F.lane); return; } r -= I_IN;
        if (r < I_GLU) { const int kb = r / 16, nb = r % 16; tr_item(inp(F, 22), 512, 64 * kb, 32 * nb, wsp<bf16_t>(F, WS_WGLU), 32 * nb, 512, 64 * kb, scr, F.lane); return; } r -= I_GLU;
        if (r < I_OUT) { const int kb = r / 32, nb = r % 32; tr_item(inp(F, 26), D, 64 * kb, 32 * nb, wsp<bf16_t>(F, WS_WOUT), 32 * nb, D, (64 * kb + 512) & 1023, scr, F.lane); return; } r -= I_OUT;
        if (r < I_GU) { const int kb = r / 176, nb = r % 176, n0 = 32 * nb; const int bj = (n0 >> 7) & 1; tr_item(bj ? inp(F, 29) : inp(F, 28), FF, 64 * kb, gu_ff(n0), wsp<bf16_t>(F, WS_WGU), n0, D, 64 * kb, scr, F.lane); return; } r -= I_GU;
        if (r < I_D) { const int kb = r / 32, nb = r % 32; tr_item(inp(F, 30), D, 64 * kb, 32 * nb, wsp<bf16_t>(F, WS_WD), 32 * nb, FF, 64 * kb, scr, F.lane); return; } r -= I_D;
        {
            const int g = r / 65, tau = r % 65, p = F.lane;
            const float are = inp(F, 14)[g * 64 + p], aim = inp(F, 15)[g * 64 + p], dt = __expf(inp(F, 16)[g]);
            const float x1 = are * dt, y1 = aim * dt, ex1 = expm1f(x1), sh = sinf(0.5f * y1), cy = cosf(y1), sy = sinf(y1);
            const float nr = ex1 * cy - 2.f * sh * sh, ni = (ex1 + 1.f) * sy, den = are * are + aim * aim, fr_ = (nr * are + ni * aim) / den, fi_ = (ni * are - nr * aim) / den;
            const float et = __expf(x1 * (float)tau), rev = __builtin_amdgcn_fractf(y1 * (float)tau * 0.15915494309189535f);
            const float wrf = et * __builtin_amdgcn_cosf(rev), wif = et * __builtin_amdgcn_sinf(rev);
            if (tau == 64) { f32x2* L = wsp<f32x2>(F, WS_LAM); L[g * 64 + p] = (f32x2){wrf, wif}; return; }
            float er[16], ei[16];
#pragma unroll
            for (int h = 0; h < 16; ++h) { const float br = inp(F, 17)[(g * 64 + p) * 16 + h], bi = inp(F, 18)[(g * 64 + p) * 16 + h];
                const float bbr = fr_ * br - fi_ * bi, bbi = fr_ * bi + fi_ * br; er[h] = wrf * bbr - wif * bbi; ei[h] = wrf * bbi + wif * bbr; }
            { bf16_t* S = wsp<bf16_t>(F, WS_BTS) + (size_t)g * 128 * 1024; const int s = 63 - tau;
              u32x4 a0, a1, b0, b1;
              a0.x = cvtpk(er[0], er[1]); a0.y = cvtpk(er[2], er[3]); a0.z = cvtpk(er[4], er[5]); a0.w = cvtpk(er[6], er[7]);
              a1.x = cvtpk(er[8], er[9]); a1.y = cvtpk(er[10], er[11]); a1.z = cvtpk(er[12], er[13]); a1.w = cvtpk(er[14], er[15]);
              b0.x = cvtpk(ei[0], ei[1]); b0.y = cvtpk(ei[2], ei[3]); b0.z = cvtpk(ei[4], ei[5]); b0.w = cvtpk(ei[6], ei[7]);
              b1.x = cvtpk(ei[8], ei[9]); b1.y = cvtpk(ei[10], ei[11]); b1.z = cvtpk(ei[12], ei[13]); b1.w = cvtpk(ei[14], ei[15]);
              *(u32x4*)(S + (size_t)p * 1024 + s * 16) = a0; *(u32x4*)(S + (size_t)p * 1024 + s * 16 + 8) = a1;
              *(u32x4*)(S + (size_t)(64 + p) * 1024 + s * 16) = b0; *(u32x4*)(S + (size_t)(64 + p) * 1024 + s * 16 + 8) = b1; }
            if (tau >= 1) { bf16_t* Y = wsp<bf16_t>(F, WS_BTY) + (size_t)g * 1024 * XS_LD; const int t = tau - 1;
#pragma unroll
                for (int ho = 0; ho < 16; ++ho) { const float cr = inp(F, 19)[(g * 16 + ho) * 64 + p], ci = inp(F, 20)[(g * 16 + ho) * 64 + p];
                    const float kr = cr * wrf - ci * wif, ki = -(cr * wif + ci * wrf);
                    Y[(size_t)(t * 16 + ho) * XS_LD + p] = (bf16_t)(cvtpk(kr, 0.f) & 0xffffu); Y[(size_t)(t * 16 + ho) * XS_LD + 64 + p] = (bf16_t)(cvtpk(ki, 0.f) & 0xffffu); } }
            LAS float* Es = scr;
#pragma unroll
            for (int h = 0; h < 16; ++h) { Es[p * 32 + h] = er[h]; Es[p * 32 + 16 + h] = ei[h]; }
            LDS_WAIT(); asm volatile("" ::: "memory");
            { const int ho = F.lane >> 2, h0 = 4 * (F.lane & 3); f32x4 a = {0.f, 0.f, 0.f, 0.f};
              const float* Cr = inp(F, 19) + (g * 16 + ho) * 64; const float* Ci = inp(F, 20) + (g * 16 + ho) * 64;
#pragma unroll 16
              for (int q = 0; q < 64; ++q) { const float cr = Cr[q], ci = Ci[q]; const f32x4 e_r = *(const LAS f32x4*)(Es + q * 32 + h0), e_i = *(const LAS f32x4*)(Es + q * 32 + 16 + h0); a += cr * e_r - ci * e_i; }
              if (tau == 0) {
#pragma unroll
                  for (int j = 0; j < 4; ++j) if (h0 + j == ho) a[j] += inp(F, 21)[g * 16 + ho]; }
              *(f32x4*)(wsp<float>(F, WS_KMAT) + ((size_t)(g * 64 + tau) * 16 + ho) * 16 + h0) = a; }
            LDS_WAIT(); asm volatile("" ::: "memory");
        }
}
constexpr int P0_NITEMS = 16 * 40 + 8 * 16 + 16 * 32 + 16 * 176 + 44 * 32 + 32 * 65, P0_STATIC_A = 64 * 8;
__device__ __forceinline__ void p0a(Fr& F) {
    if (F.vcu < 192) { gemv24<0>(F, F.vcu);
#ifdef PROBE_GEMV2
        gemv24<0>(F, F.vcu); gemv24<0>(F, F.vcu);
#endif
    } else p0_item(F, (F.vcu - 192) * 8 + F.wave);
}
__device__ __forceinline__ void toeplitz_rows16(Fr& F, int r0) {
    const int g = r0 >> 10, t = (r0 >> 4) & 63; const int ncol = 256 * ((t >> 4) + 1);
    bf16_t* Y = wsp<bf16_t>(F, WS_BTY) + ((size_t)g * 1024 + (r0 & 1023)) * XS_LD + 128; const float* KM = wsp<float>(F, WS_KMAT) + (size_t)g * 64 * 256;
    for (int c0 = 8 * F.lane; c0 < ncol; c0 += 512) { const int s = c0 >> 4, h0 = c0 & 15; const bool nz = s <= t; const float* kp = KM + (size_t)(nz ? t - s : 0) * 256 + h0;
#pragma unroll
        for (int hb = 0; hb < 16; hb += 8) { f32x4 a[8], b[8];
#pragma unroll
            for (int q = 0; q < 8; ++q) { a[q] = *(const f32x4*)(kp + (hb + q) * 16); b[q] = *(const f32x4*)(kp + (hb + q) * 16 + 4); }
#pragma unroll
            for (int q = 0; q < 8; ++q) { u32x4 o = {0u, 0u, 0u, 0u}; if (nz) o = pack8(a[q], b[q]); *(u32x4*)(Y + (size_t)(hb + q) * XS_LD + c0) = o; } }
    }
}
__device__ __forceinline__ void p0_rows(Fr& F, int m0, int ntrips, int stride) {
    const float* g1 = inp(F, 9) + 4 * F.lane; float* r1p = wsp<float>(F, WS_R1); bf16_t* xbp = wsp<bf16_t>(F, WS_XB) + 4 * F.lane; const float* modp = wsp<float>(F, WS_MOD) + D + 4 * F.lane;
    const float* xpp = inp(F, 0) + 4 * F.lane; const float* xsp = inp(F, 1) + 4 * F.lane;
    f32x4 g[4], sc[4], v0[4], v1[4], n0[4], n1[4], q0[4], q1[4];
#define P0R_LOAD(d0, d1, mm) do { const int m_ = (mm); const float* xr = m_ < MP ? xpp + (size_t)m_ * D : xsp + (size_t)(m_ - MP) * D; \
        _Pragma("unroll") for (int j = 0; j < 4; ++j) { d0[j] = *(const f32x4*)(xr + 256 * j); d1[j] = *(const f32x4*)(xr + D + 256 * j); } } while (0)
    P0R_LOAD(v0, v1, m0);
    if (ntrips > 1) P0R_LOAD(n0, n1, m0 + stride);
    { const float* scp = modp + (size_t)modrow_of(m0) * NMOD;
#pragma unroll
      for (int j = 0; j < 4; ++j) { g[j] = *(const f32x4*)(g1 + 256 * j); sc[j] = *(const f32x4*)(scp + 256 * j); } }
    for (int t = 0; t < ntrips; ++t) {
        const int m = m0 + t * stride;
        if (t + 2 < ntrips) P0R_LOAD(q0, q1, m + 2 * stride);
        float s0 = 0.f, s1 = 0.f;
#pragma unroll
        for (int j = 0; j < 4; ++j) { s0 += (v0[j].x * v0[j].x + v0[j].y * v0[j].y) + (v0[j].z * v0[j].z + v0[j].w * v0[j].w); s1 += (v1[j].x * v1[j].x + v1[j].y * v1[j].y) + (v1[j].z * v1[j].z + v1[j].w * v1[j].w); }
        s0 = wave_sum(s0); s1 = wave_sum(s1);
        if (F.lane == 0) { r1p[m] = rsqrtf(s0 * (1.f / D) + EPS); r1p[m + 1] = rsqrtf(s1 * (1.f / D) + EPS); }
        bf16_t* xb = xbp + (size_t)m * D;
#pragma unroll
        for (int j = 0; j < 4; ++j) { const f32x4 w = g[j] * (1.f + sc[j]);
            const f32x4 w0 = v0[j] * w; u32x2 p0; p0.x = cvtpk(w0[0], w0[1]); p0.y = cvtpk(w0[2], w0[3]); *(u32x2*)(xb + 256 * j) = p0;
            const f32x4 w1 = v1[j] * w; u32x2 p1; p1.x = cvtpk(w1[0], w1[1]); p1.y = cvtpk(w1[2], w1[3]); *(u32x2*)(xb + D + 256 * j) = p1; }
#pragma unroll
        for (int j = 0; j < 4; ++j) { v0[j] = n0[j]; v1[j] = n1[j]; n0[j] = q0[j]; n1[j] = q1[j]; }
    }
#undef P0R_LOAD
}
__device__ __forceinline__ unsigned wq_issue(unsigned* ctr) { unsigned v = 0; if ((threadIdx.x & 63) == 0) v = __hip_atomic_fetch_add(ctr, 1u, __ATOMIC_RELAXED, __HIP_MEMORY_SCOPE_AGENT); return v; }
#ifndef P0_RWV
#define P0_RWV 4
#endif
#ifdef PROBE_LO
#ifndef PROBE_BX
#define PROBE_BX 0
#endif
#define P0STAMP(k) do { if (F.tid == 0) ((LAS unsigned long long*)(F.lds + LDSCTL_OFF + 1024))[20 + (k)] = __builtin_amdgcn_s_memrealtime(); } while (0)
#else
#define P0STAMP(k) do {} while (0)
#endif
__device__ __forceinline__ void p0b(Fr& F) {
    const int gw = F.vcu * 8 + F.wave, NGW = F.G * 8;
#ifdef PROBE_WHO
    const unsigned long long pw_t0 = __builtin_amdgcn_s_memrealtime();
#endif
    if (F.vcu < NIN / 32) gemv24<1>(F, F.vcu);
    else if (F.vcu >= F.G - 64) {
        const int i = (F.vcu - (F.G - 64)) * 512 + F.tid;
        {
            const float* ck = inp(F, 2); const float* cv = inp(F, 3); bf16_t* kc = wsp<bf16_t>(F, WS_KC); bf16_t* vc = wsp<bf16_t>(F, WS_VC);
            const f32x4 a = *(const f32x4*)(ck + 4 * i), b = *(const f32x4*)(cv + 4 * i); u32x2 p; p.x = cvtpk(a[0], a[1]); p.y = cvtpk(a[2], a[3]); *(u32x2*)(kc + 4 * i) = p; p.x = cvtpk(b[0], b[1]); p.y = cvtpk(b[2], b[3]); *(u32x2*)(vc + 4 * i) = p; }
        {
            const float* md = wsp<float>(F, WS_MOD); bf16_t* o = wsp<bf16_t>(F, WS_SH2B);
            const int r = i >> 10, k = i & 1023; o[i] = r < 24 ? (bf16_t)(cvtpk(md[(size_t)r * NMOD + 3 * D + k], 0.f) & 0xffffu) : (bf16_t)0; } }
    unsigned* q0 = wsp<unsigned>(F, WS_CTL) + CW_Q;
    P0STAMP(0);
    unsigned* q1 = q0 + 64; constexpr int NCH = M / 16, RWV = P0_RWV, NRW = 256 * RWV, NIW = 256 * (8 - RWV);
#define P0_PAIR() do { p0_item(F, ib); if (ib + 1 < P0_NITEMS) p0_item(F, ib + 1); } while (0)
    if (F.wave < RWV) {
        int ch = F.vcu * RWV + F.wave; unsigned tk = wq_issue(q1);
        while (ch < NCH) { p0_rows(F, 16 * ch, 8, 2); ch = NRW + (int)__builtin_amdgcn_readfirstlane(tk); if (ch < NCH) tk = wq_issue(q1); }
        P0STAMP(1);
        for (int ib = P0_STATIC_A + 2 * NIW + 2 * wq_next(q0); ib < P0_NITEMS; ib = P0_STATIC_A + 2 * NIW + 2 * wq_next(q0)) P0_PAIR();
    } else {
        int ib = P0_STATIC_A + 2 * (F.vcu * (8 - RWV) + F.wave - RWV); unsigned tk = wq_issue(q0);
        while (ib < P0_NITEMS) { P0_PAIR(); ib = P0_STATIC_A + 2 * NIW + 2 * (int)__builtin_amdgcn_readfirstlane(tk); if (ib < P0_NITEMS) tk = wq_issue(q0); }
        for (int ch = NRW + wq_next(q1); ch < NCH; ch = NRW + wq_next(q1)) p0_rows(F, 16 * ch, 8, 2);
    }
    P0STAMP(4);
#ifdef PROBE_WHO
    if (F.lane == 0) { const unsigned d_ = (unsigned)(__builtin_amdgcn_s_memrealtime() - pw_t0); atomicMax(wsp<unsigned>(F, WS_CTL) + 12000, (d_ << 12) | (unsigned)gw); }
#endif
}

#if defined(PROBE_BW) || defined(PROBE_BW0)
template <int MODE> __device__ __forceinline__ void bw_pass(Fr& F) {
    const int gw = F.vcu * 8 + F.wave; const float* xpp = inp(F, 0) + 4 * F.lane; bf16_t* xbp = wsp<bf16_t>(F, WS_XB) + 4 * F.lane; float* r1p = wsp<float>(F, WS_R1);
    f32x4 v0[4], v1[4], n0[4], n1[4]; float acc = 0.f;
#pragma unroll
    for (int j = 0; j < 4; ++j) { v0[j] = n0[j] = (f32x4){1.f, 2.f, 3.f, (float)F.lane}; v1[j] = n1[j] = v0[j]; }
    if (MODE != 3) { const float* xr = xpp + (size_t)(2 * gw) * D;
#pragma unroll
        for (int j = 0; j < 4; ++j) { v0[j] = *(const f32x4*)(xr + 256 * j); v1[j] = *(const f32x4*)(xr + D + 256 * j); } }
    for (int t = 0; t < 16; ++t) { const int m = t * SEQ + 2 * gw;
        if (MODE != 3 && t + 1 < 16) { const float* xr = xpp + (size_t)(m + SEQ) * D;
#pragma unroll
            for (int j = 0; j < 4; ++j) { n0[j] = *(const f32x4*)(xr + 256 * j); n1[j] = *(const f32x4*)(xr + D + 256 * j); } }
        if (MODE == 2) {
#pragma unroll
            for (int j = 0; j < 4; ++j) acc += (v0[j].x + v0[j].y) + (v0[j].z + v0[j].w) + (v1[j].x + v1[j].y) + (v1[j].z + v1[j].w);
        } else { bf16_t* xb = xbp + (size_t)m * D;
#pragma unroll
            for (int j = 0; j < 4; ++j) { u32x2 p0; p0.x = cvtpk(v0[j][0], v0[j][1]); p0.y = cvtpk(v0[j][2], v0[j][3]); *(u32x2*)(xb + 256 * j) = p0;
                u32x2 p1; p1.x = cvtpk(v1[j][0], v1[j][1]); p1.y = cvtpk(v1[j][2], v1[j][3]); *(u32x2*)(xb + D + 256 * j) = p1; } }
#pragma unroll
        for (int j = 0; j < 4; ++j) { v0[j] = n0[j]; v1[j] = n1[j]; }
        asm volatile("" ::: "memory");
    }
    if (MODE == 2) { acc = wave_sum(acc); if (F.lane == 0) r1p[gw] = acc; }
}
#endif
#define RG_ROW(u, rg) ((u).pm * 256 + ((rg) >> 2) * 128 + wr * 64 + ((rg) & 3) * 16 + fr)
constexpr int R2TAB_OFF = LDSCTL_OFF + 6144;
constexpr int TAB_OFF = LDSCTL_OFF + 2048;
template <int NP> __device__ __forceinline__ LAS float* row_factor_table(const Fr& F, const float* part, const pg8::Unit& u, int wr, int wc, float inv_div) {
    LAS float* tab = (LAS float*)(F.lds + TAB_OFF) + (wr * 4 + wc) * 128; const int lane = F.lane;
    f32x4 p0[NP / 4], p1[NP / 4];
    const int r0 = u.pm * 256 + wr * 64 + lane, r1 = r0 + 128;
#pragma unroll
    for (int i = 0; i < NP / 4; ++i) { p0[i] = *(const f32x4*)(part + (size_t)r0 * NP + 4 * i); p1[i] = *(const f32x4*)(part + (size_t)r1 * NP + 4 * i); }
    float s0 = 0.f, s1 = 0.f;
#pragma unroll
    for (int i = 0; i < NP / 4; ++i) { s0 += (p0[i][0] + p0[i][1]) + (p0[i][2] + p0[i][3]); s1 += (p1[i][0] + p1[i][1]) + (p1[i][2] + p1[i][3]); }
    tab[lane] = rsqrtf(s0 * inv_div + EPS); tab[64 + lane] = rsqrtf(s1 * inv_div + EPS);
    LDS_WAIT(); asm volatile("" ::: "memory");
    return tab;
}

struct EpiIn {
    static constexpr bool EPI2 = false;
    static constexpr bool HAS_MID = false; static constexpr int MID_T = -1;
    Fr F;
    __device__ __forceinline__ void mid(f32x4 (&)[2][2][4][2], const pg8::Unit&, int, int, int, int) const {}
    template <bool UNI, int KIND> __device__ __forceinline__ void run(const f32x4 (&acc)[2][2][4][2], const pg8::Unit& u, int wr, int wc, int fr, int fq) const {
        const int pn = u.pn;
        const float* r1p = wsp<float>(F, WS_R1); float r1v[8];
#pragma unroll
        for (int rg = 0; rg < 8; ++rg) r1v[rg] = r1p[RG_ROW(u, rg)];
        f32x4 ub[2][2], gn[2][2];
        if (UNI) { const float* bp = wsp<float>(F, WS_BIAS1) + (size_t)modrow_of(u.pm * 256) * NIN + pn * 256 + wc * 32 + 8 * fq;
#pragma unroll
            for (int bj = 0; bj < 2; ++bj) { ub[bj][0] = *(const f32x4*)(bp + bj * 128); ub[bj][1] = *(const f32x4*)(bp + bj * 128 + 4); } }
        if (KIND == 0) { const float* g = (pn < 2 ? inp(F, 11) : inp(F, 12)) + 8 * fq;
#pragma unroll
            for (int bj = 0; bj < 2; ++bj) { gn[bj][0] = *(const f32x4*)(g + 32 * bj); gn[bj][1] = *(const f32x4*)(g + 32 * bj + 4); }
        }
        bf16_t* Q = wsp<bf16_t>(F, WS_Q); bf16_t* Kb = wsp<bf16_t>(F, WS_KB); bf16_t* Vb = wsp<bf16_t>(F, WS_VB); bf16_t* XS = wsp<bf16_t>(F, WS_XS); float* us = wsp<float>(F, WS_US); float* out = outp(F);
#pragma unroll
        for (int rg = 0; rg < 8; ++rg) {
            const int ai = rg >> 2, m = rg & 3, row = RG_ROW(u, rg); const float r1c = r1v[rg];
            const float* bpr = wsp<float>(F, WS_BIAS1) + (size_t)modrow_of(row) * NIN + pn * 256 + wc * 32 + 8 * fq;
#define VIN(bj, n) (acc[ai][bj][m][n] * r1c + (UNI ? ub[bj][n] : *(const f32x4*)(bpr + (bj) * 128 + 4 * (n))))
            if (KIND == 2) {
                if (row < MP) { const int bc = row >> 6, s = row & 63;
#pragma unroll
                    for (int bj = 0; bj < 2; ++bj) { const int g = 16 * (pn - 3) + 8 * bj + 2 * wc + (fq >> 1);
                        *(u32x4*)(XS + ((size_t)g * 1024 + bc) * XS_LD + 128 + s * 16 + 8 * (fq & 1)) = pack8(VIN(bj, 0), VIN(bj, 1)); } }
                else {
#pragma unroll
                    for (int bj = 0; bj < 2; ++bj) { float* p = us + (size_t)(row - MP) * 512 + 256 * (pn - 3) + 128 * bj + 32 * wc + 8 * fq; *(f32x4*)p = VIN(bj, 0); *(f32x4*)(p + 4) = VIN(bj, 1); } }
            } else if (KIND == 1) {
                const int kv = wc - 2;
#pragma unroll
                for (int bj = 0; bj < 2; ++bj) { const int d0 = 32 * bj + 8 * fq; const f32x4 v0 = VIN(bj, 0), v1 = VIN(bj, 1); *(u32x4*)(Vb + (size_t)row * 128 + kv * 64 + d0) = pack8(v0, v1);
                    float* op = nullptr;
                    if (row >= MP) op = out + O_VS + ((size_t)(row - MP) * 2 + kv) * 64 + d0;
                    else if ((row & (SEQ - 1)) >= SEQ - 128) op = out + O_VP + (((size_t)(row >> 12) * 128 + ((row & (SEQ - 1)) - (SEQ - 128))) * 2 + kv) * 64 + d0;
                    if (op) { *(f32x4*)op = v0; *(f32x4*)(op + 4) = v1; } }
            } else {
                float ss = 0.f;
#pragma unroll
                for (int bj = 0; bj < 2; ++bj)
#pragma unroll
                    for (int n = 0; n < 2; ++n) { const f32x4 t = VIN(bj, n); ss += (t[0] * t[0] + t[1] * t[1]) + (t[2] * t[2] + t[3] * t[3]); }
                ss += __shfl_xor(ss, 16); ss += __shfl_xor(ss, 32);
                const float rn = rsqrtf(ss * (1.f / 64.f) + EPS); const float posf = (float)pos_of(row);
                f32x4 o[2][2];
#pragma unroll
                for (int n = 0; n < 2; ++n) { const f32x4 x1 = VIN(0, n) * rn * gn[0][n], x2 = VIN(1, n) * rn * gn[1][n]; f32x4 cv, sv;
#pragma unroll
                    for (int j = 0; j < 4; ++j) { const float ivr = __builtin_amdgcn_exp2f(-(float)(8 * fq + 4 * n + j) * (13.287712379549449f / 32.f)) * 0.15915494309189535f;
                        const float fr_ = __builtin_amdgcn_fractf(posf * ivr); cv[j] = __builtin_amdgcn_cosf(fr_); sv[j] = __builtin_amdgcn_sinf(fr_); }
                    o[0][n] = x1 * cv - x2 * sv; o[1][n] = x2 * cv + x1 * sv; }
                if (pn < 2) { const int head = 4 * pn + wc;
#pragma unroll
                    for (int bj = 0; bj < 2; ++bj) *(u32x4*)(Q + (size_t)row * 512 + head * 64 + 32 * bj + 8 * fq) = pack8(o[bj][0] * QSCALE, o[bj][1] * QSCALE);
                } else { const int kv = wc;
#pragma unroll
                    for (int bj = 0; bj < 2; ++bj) { const int d0 = 32 * bj + 8 * fq; *(u32x4*)(Kb + (size_t)row * 128 + kv * 64 + d0) = pack8(o[bj][0], o[bj][1]);
                        float* op = nullptr;
                        if (row >= MP) op = out + O_KS + ((size_t)(row - MP) * 2 + kv) * 64 + d0;
                        else if ((row & (SEQ - 1)) >= SEQ - 128) op = out + O_KP + (((size_t)(row >> 12) * 128 + ((row & (SEQ - 1)) - (SEQ - 128))) * 2 + kv) * 64 + d0;
                        if (op) { *(f32x4*)op = o[bj][0]; *(f32x4*)(op + 4) = o[bj][1]; } }
                }
            }
#undef VIN
            asm volatile("" ::: "memory");
        }
    }
    __device__ __forceinline__ void operator()(const f32x4 (&acc)[2][2][4][2], const pg8::Unit& u, int wr, int wc, int fr, int fq) const {
        const int kind = u.pn >= 3 ? 2 : (u.pn == 2 && wc >= 2) ? 1 : 0;
        if (kind == 2) run<true, 2>(acc, u, wr, wc, fr, fq); else if (kind == 1) run<true, 1>(acc, u, wr, wc, fr, fq); else run<true, 0>(acc, u, wr, wc, fr, fq);
    }
};
struct EpiState {
    static constexpr bool EPI2 = false;
    static constexpr bool HAS_MID = false; static constexpr int MID_T = -1;
    Fr F;
    __device__ __forceinline__ void mid(f32x4 (&)[2][2][4][2], const pg8::Unit&, int, int, int, int) const {}
    __device__ __forceinline__ void operator()(const f32x4 (&acc)[2][2][4][2], const pg8::Unit& u, int wr, int wc, int fr, int fq) const {
        float* base = wsp<float>(F, WS_DS) + (size_t)u.aux * 1024 * 128;
#pragma unroll
        for (int rg = 0; rg < 8; ++rg) { const int bc = RG_ROW(u, rg); float* p = base + (size_t)bc * 128 + 32 * wc + 8 * fq; *(f32x4*)p = acc[rg >> 2][0][rg & 3][0]; *(f32x4*)(p + 4) = acc[rg >> 2][0][rg & 3][1]; }
    }
};
struct EpiY {
    static constexpr bool EPI2 = false;
    static constexpr bool HAS_MID = false; static constexpr int MID_T = -1;
    Fr F;
    __device__ __forceinline__ void mid(f32x4 (&)[2][2][4][2], const pg8::Unit&, int, int, int, int) const {}
    __device__ __forceinline__ void operator()(const f32x4 (&acc)[2][2][4][2], const pg8::Unit& u, int wr, int wc, int fr, int fq) const {
        bf16_t* Gb = wsp<bf16_t>(F, WS_GB); const int g = u.aux;
#pragma unroll
        for (int rg = 0; rg < 8; ++rg) { const int bc = RG_ROW(u, rg);
#pragma unroll
            for (int bj = 0; bj < 2; ++bj) { const int t = 16 * u.pn + 8 * bj + 2 * wc + (fq >> 1); f32x4 a = acc[rg >> 2][bj][rg & 3][0], b = acc[rg >> 2][bj][rg & 3][1];
#pragma unroll
                for (int j = 0; j < 4; ++j) { a[j] = gelu_tanh(a[j]); b[j] = gelu_tanh(b[j]); }
                *(u32x4*)(Gb + ((size_t)bc * 64 + t) * 512 + 16 * g + 8 * (fq & 1)) = pack8(a, b); } }
    }
};
struct EpiGlu {
    static constexpr bool EPI2 = false;
    static constexpr bool HAS_MID = false; static constexpr int MID_T = -1;
    Fr F;
    __device__ __forceinline__ void mid(f32x4 (&)[2][2][4][2], const pg8::Unit&, int, int, int, int) const {}
    __device__ __forceinline__ void operator()(const f32x4 (&acc)[2][2][4][2], const pg8::Unit& u, int wr, int wc, int fr, int fq) const {
        const bf16_t* Gb = wsp<bf16_t>(F, WS_GB); bf16_t* MG = wsp<bf16_t>(F, WS_MG); float* ssq = wsp<float>(F, WS_SSQ);
        const int c0 = u.pn * 256 + wc * 32 + 8 * fq;
        float ssv[8];
#pragma unroll
        for (int rg = 0; rg < 8; ++rg) ssv[rg] = 0.f;
#pragma unroll
        for (int bj = 0; bj < 2; ++bj) {
            u32x4 gv[8];
#pragma unroll
            for (int rg = 0; rg < 8; ++rg) gv[rg] = *(const u32x4*)(Gb + (size_t)RG_ROW(u, rg) * 512 + c0 + bj * 128);
            const float* pa = inp(F, 23) + c0 + bj * 128; const float* pb = inp(F, 25) + c0 + bj * 128;
            const f32x4 gb0 = *(const f32x4*)pa * -1.4426950408889634f, gb1 = *(const f32x4*)(pa + 4) * -1.4426950408889634f, gn0 = *(const f32x4*)pb, gn1 = *(const f32x4*)(pb + 4);
            asm volatile("" ::: "memory");
#pragma unroll
            for (int rg = 0; rg < 8; ++rg) { const int row = RG_ROW(u, rg); const u32x4 gw = gv[rg];
                const f32x4 g0 = {bflo(gw.x), bfhi(gw.x), bflo(gw.y), bfhi(gw.y)}, g1 = {bflo(gw.z), bfhi(gw.z), bflo(gw.w), bfhi(gw.w)};
                const f32x4 z0 = acc[rg >> 2][bj][rg & 3][0] * -1.4426950408889634f + gb0, z1 = acc[rg >> 2][bj][rg & 3][1] * -1.4426950408889634f + gb1; f32x4 s0, s1;
#pragma unroll
                for (int j = 0; j < 4; ++j) { s0[j] = g0[j] * __builtin_amdgcn_rcpf(1.f + __builtin_amdgcn_exp2f(z0[j])); s1[j] = g1[j] * __builtin_amdgcn_rcpf(1.f + __builtin_amdgcn_exp2f(z1[j])); ssv[rg] += s0[j] * s0[j] + s1[j] * s1[j]; }
                asm volatile("" : "+v"(ssv[rg]));
                *(u32x4*)(MG + (size_t)row * D + c0 + bj * 128) = pack8(s0 * gn0, s1 * gn1);
                asm volatile("" ::: "memory"); }
        }
#pragma unroll
        for (int rg = 0; rg < 8; ++rg) { float ss = ssv[rg]; ss += __shfl_xor(ss, 16); ss += __shfl_xor(ss, 32); if (fq == 0) ssq[(size_t)RG_ROW(u, rg) * 8 + u.pn * 4 + wc] = ss; }
    }
};
#ifndef XPF
#define XPF 3
#endif
struct EpiOut {
    static constexpr bool EPI2 = false;
    static constexpr bool HAS_MID = true; static constexpr int MID_T = 8;
    Fr F;
    int pm_min;
    __device__ __forceinline__ void mid(f32x4 (&acc)[2][2][4][2], const pg8::Unit& u, int wr, int wc, int fr, int fq) const {
        const LAS float* tab = (const LAS float*)(F.lds + R2TAB_OFF) + ((u.pm - pm_min) >> 3) * 512 + wr * 64;
#pragma unroll
        for (int rg = 0; rg < 8; ++rg) { const float rs = tab[(rg >> 2) * 128 + (rg & 3) * 16 + fr];
#pragma unroll
            for (int bj = 0; bj < 2; ++bj)
#pragma unroll
                for (int n = 0; n < 2; ++n) acc[rg >> 2][bj][rg & 3][n] *= rs; }
    }
    template <bool UNI> __device__ __forceinline__ void run(const f32x4 (&acc)[2][2][4][2], const pg8::Unit& u, int wr, int wc, int fr, int fq) const {
        bf16_t* X1 = wsp<bf16_t>(F, WS_X1B); bf16_t* A2 = wsp<bf16_t>(F, WS_A2); const float* xp = inp(F, 0); const float* xs = inp(F, 1); const float* modp = wsp<float>(F, WS_MOD); const float* l2p = inp(F, 27);
        float ssv[8], rav[8]; const LAS float* tab2 = (const LAS float*)(F.lds + R2TAB_OFF) + ((u.pm - pm_min) >> 3) * 512 + 256 + wr * 64;
#pragma unroll
        for (int rg = 0; rg < 8; ++rg) { ssv[rg] = 0.f; rav[rg] = tab2[(rg >> 2) * 128 + (rg & 3) * 16 + fr]; }
#pragma unroll
        for (int bj = 0; bj < 2; ++bj) {
            const int c0 = u.pn * 256 + bj * 128 + wc * 32 + 8 * fq;
            f32x4 ug1[2], uw2[2];
            if (UNI) { const float* md = modp + (size_t)modrow_of(u.pm * 256) * NMOD + c0;
#pragma unroll
                for (int n = 0; n < 2; ++n) { ug1[n] = *(const f32x4*)(md + 2 * D + 4 * n); uw2[n] = *(const f32x4*)(l2p + c0 + 4 * n) * (1.f + *(const f32x4*)(md + 4 * D + 4 * n)); } }
            f32x4 xv[8][2];
#pragma unroll
            for (int rg = 0; rg < XPF; ++rg) { const int row = RG_ROW(u, rg); const float* xr = (row < MP ? xp + (size_t)row * D : xs + (size_t)(row - MP) * D) + c0; xv[rg][0] = *(const f32x4*)xr; xv[rg][1] = *(const f32x4*)(xr + 4); }
#pragma unroll
            for (int rg = 0; rg < 8; ++rg) {
                if (rg + XPF < 8) { const int row = RG_ROW(u, rg + XPF); const float* xr = (row < MP ? xp + (size_t)row * D : xs + (size_t)(row - MP) * D) + c0; xv[rg + XPF][0] = *(const f32x4*)xr; xv[rg + XPF][1] = *(const f32x4*)(xr + 4); }
                const f32x4 cx[2] = {xv[rg][0], xv[rg][1]};
                const int row = RG_ROW(u, rg); const float* md = modp + (size_t)modrow_of(row) * NMOD + c0;
                f32x4 x1[2], w2[2];
#pragma unroll
                for (int n = 0; n < 2; ++n) { const f32x4 g1 = UNI ? ug1[n] : *(const f32x4*)(md + 2 * D + 4 * n);
                    w2[n] = UNI ? uw2[n] : *(const f32x4*)(l2p + c0 + 4 * n) * (1.f + *(const f32x4*)(md + 4 * D + 4 * n));
                    x1[n] = cx[n] + g1 * (acc[rg >> 2][bj][rg & 3][n] * rav[rg]);
                    ssv[rg] += (x1[n][0] * x1[n][0] + x1[n][1] * x1[n][1]) + (x1[n][2] * x1[n][2] + x1[n][3] * x1[n][3]); }
                asm volatile("" : "+v"(ssv[rg]));
                *(u32x4*)(X1 + (size_t)row * D + c0) = pack8(x1[0], x1[1]);
                *(u32x4*)(A2 + (size_t)row * D + c0) = pack8(x1[0] * w2[0], x1[1] * w2[1]);
                asm volatile("" ::: "memory");
            }
        }
        float* ssq2 = wsp<float>(F, WS_SSQ2);
#pragma unroll
        for (int rg = 0; rg < 8; ++rg) { float ss = ssv[rg]; ss += __shfl_xor(ss, 16); ss += __shfl_xor(ss, 32); if (fq == 0) ssq2[(size_t)RG_ROW(u, rg) * 16 + u.pn * 4 + wc] = ss; }
    }
    __device__ __forceinline__ void run_slow(const f32x4 (&acc)[2][2][4][2], const pg8::Unit& u, int wr, int wc, int fr, int fq) const {
        bf16_t* X1 = wsp<bf16_t>(F, WS_X1B); bf16_t* A2 = wsp<bf16_t>(F, WS_A2); const float* xs = inp(F, 1); const float* modp = wsp<float>(F, WS_MOD); const float* l2p = inp(F, 27); float* ssq2 = wsp<float>(F, WS_SSQ2);
#pragma unroll
        for (int rg = 0; rg < 8; ++rg) { const int row = RG_ROW(u, rg); float ss = 0.f; const float* md = modp + (size_t)modrow_of(row) * NMOD;
#pragma unroll
            for (int bj = 0; bj < 2; ++bj)
#pragma unroll
                for (int n = 0; n < 2; ++n) { const int c = u.pn * 256 + bj * 128 + wc * 32 + 8 * fq + 4 * n;
                    const f32x4 x1 = *(const f32x4*)(xs + (size_t)(row - MP) * D + c) + *(const f32x4*)(md + 2 * D + c) * acc[rg >> 2][bj][rg & 3][n];
                    ss += (x1[0] * x1[0] + x1[1] * x1[1]) + (x1[2] * x1[2] + x1[3] * x1[3]);
                    { u32x2 xk; xk.x = cvtpk(x1[0], x1[1]); xk.y = cvtpk(x1[2], x1[3]); *(u32x2*)(X1 + (size_t)row * D + c) = xk; }
                    const f32x4 w = x1 * *(const f32x4*)(l2p + c) * (1.f + *(const f32x4*)(md + 4 * D + c)); u32x2 pk; pk.x = cvtpk(w[0], w[1]); pk.y = cvtpk(w[2], w[3]); *(u32x2*)(A2 + (size_t)row * D + c) = pk;
                    asm volatile("" : "+v"(ss) :: "memory"); }
            ss += __shfl_xor(ss, 16); ss += __shfl_xor(ss, 32);
            if (fq == 0) ssq2[(size_t)row * 16 + u.pn * 4 + wc] = ss; }
    }
    __device__ __forceinline__ void operator()(const f32x4 (&acc)[2][2][4][2], const pg8::Unit& u, int wr, int wc, int fr, int fq) const {
        run<true>(acc, u, wr, wc, fr, fq);
    }
};
struct EpiUp {
    static constexpr bool EPI2 = false;
    static constexpr bool HAS_MID = false; static constexpr int MID_T = -1;
    Fr F;
    __device__ __forceinline__ void mid(f32x4 (&)[2][2][4][2], const pg8::Unit&, int, int, int, int) const {}
    int pm_min;
    template <bool UNI> __device__ __forceinline__ void run(const f32x4 (&acc)[2][2][4][2], const pg8::Unit& u, int wr, int wc, int fr, int fq) const {
        bf16_t* ACT = wsp<bf16_t>(F, WS_ACT); const float* bias2 = wsp<float>(F, WS_BIAS2);
        const LAS float* tab = (const LAS float*)(F.lds + R2TAB_OFF) + ((u.pm - pm_min) >> 3) * 256 + wr * 64;
        const int cb = u.pn * 256 + wc * 32 + 8 * fq;
        f32x4 ub[2][2];
        if (UNI) { const float* bp = bias2 + (size_t)modrow_of(u.pm * 256) * NGU + cb;
#pragma unroll
            for (int bj = 0; bj < 2; ++bj) { ub[bj][0] = *(const f32x4*)(bp + bj * 128); ub[bj][1] = *(const f32x4*)(bp + bj * 128 + 4); } }
#pragma unroll
        for (int rg = 0; rg < 8; ++rg) { const int row = RG_ROW(u, rg); const float r2 = tab[(rg >> 2) * 128 + (rg & 3) * 16 + fr];
            f32x4 b[2][2];
            if (UNI) { b[0][0] = ub[0][0]; b[0][1] = ub[0][1]; b[1][0] = ub[1][0]; b[1][1] = ub[1][1]; }
            else { const float* bp = bias2 + (size_t)modrow_of(row) * NGU + cb;
#pragma unroll
                for (int bj = 0; bj < 2; ++bj) { b[bj][0] = *(const f32x4*)(bp + bj * 128); b[bj][1] = *(const f32x4*)(bp + bj * 128 + 4); } }
            f32x4 o[2];
#pragma unroll
            for (int n = 0; n < 2; ++n) { const f32x4 gt = acc[rg >> 2][0][rg & 3][n] * r2 + b[0][n], up = acc[rg >> 2][1][rg & 3][n] * r2 + b[1][n];
#pragma unroll
                for (int j = 0; j < 4; ++j) o[n][j] = silu_f(gt[j]) * up[j]; }
            { const int ff = u.pn * 128 + wc * 32 + 8 * fq;
              *(u32x4*)(ACT + ((size_t)(u.pm * (FF / 64) + (ff >> 6)) * 256 + (row & 255)) * 64 + (ff & 63)) = pack8(o[0], o[1]); } }
    }
    __device__ __forceinline__ void operator()(const f32x4 (&acc)[2][2][4][2], const pg8::Unit& u, int wr, int wc, int fr, int fq) const {
        run<true>(acc, u, wr, wc, fr, fq);
    }
};
struct EpiDown {
    static constexpr bool EPI2 = false;
    static constexpr bool HAS_MID = false; static constexpr int MID_T = -1;
    Fr F;
    __device__ __forceinline__ void mid(f32x4 (&)[2][2][4][2], const pg8::Unit&, int, int, int, int) const {}
    template <bool UNI> __device__ __forceinline__ void run(const f32x4 (&acc)[2][2][4][2], const pg8::Unit& u, int wr, int wc, int fr, int fq) const {
        float* out = outp(F); const bf16_t* X1 = wsp<bf16_t>(F, WS_X1B); const float* modp = wsp<float>(F, WS_MOD) + 5 * D;
#pragma unroll
        for (int bj = 0; bj < 2; ++bj) {
            const int c0 = u.pn * 256 + bj * 128 + wc * 32 + 8 * fq;
            f32x4 ug[2];
            if (UNI) { const float* md = modp + (size_t)modrow_of(u.pm * 256) * NMOD + c0; ug[0] = *(const f32x4*)md; ug[1] = *(const f32x4*)(md + 4); }
            u32x4 xv[8];
#pragma unroll
            for (int rg = 0; rg < 8; ++rg) xv[rg] = *(const u32x4*)(X1 + (size_t)RG_ROW(u, rg) * D + c0);
            asm volatile("" ::: "memory");
#pragma unroll
            for (int rg = 0; rg < 8; ++rg) {
                const int row = RG_ROW(u, rg); const float* md = modp + (size_t)modrow_of(row) * NMOD + c0; float* op = out + (size_t)row * D + c0; const u32x4 cx = xv[rg];
                const f32x4 x0 = {bflo(cx.x), bfhi(cx.x), bflo(cx.y), bfhi(cx.y)}, x1 = {bflo(cx.z), bfhi(cx.z), bflo(cx.w), bfhi(cx.w)};
                *(f32x4*)op = x0 + (UNI ? ug[0] : *(const f32x4*)md) * acc[rg >> 2][bj][rg & 3][0];
                *(f32x4*)(op + 4) = x1 + (UNI ? ug[1] : *(const f32x4*)(md + 4)) * acc[rg >> 2][bj][rg & 3][1];
                asm volatile("" ::: "memory");
            }
        }
    }
    __device__ __forceinline__ void operator()(const f32x4 (&acc)[2][2][4][2], const pg8::Unit& u, int wr, int wc, int fr, int fq) const {
        run<true>(acc, u, wr, wc, fr, fq);
    }
};
struct StateOrder {
    int c;
    __device__ bool next(int i, pg8::Unit& u) const { if (i > 0) return false; const int g = c >> 3, pm = (c >> 1) & 3, kh = c & 1;
        u.pm = pm; u.pn = 0; u.nt = 8; u.aux = kh * 32 + g; u.aoff = (((size_t)g * 1024 + pm * 256) * XS_LD + 128 + kh * 512) * 2; u.boff = ((size_t)g * 128 * 1024 + kh * 512) * 2; return true; }
};
struct YOrder {
    int c;
    __device__ bool next(int i, pg8::Unit& u) const { if (i > 1) return false; const int g = c >> 3, pm = (c >> 1) & 3, w = c & 1; const int pn = (i == 0) ? (w ? 2 : 3) : (w ? 1 : 0);
        u.pm = pm; u.pn = pn; u.nt = 2 + 4 * (pn + 1); u.aux = g; u.aoff = ((size_t)g * 1024 + pm * 256) * XS_LD * 2; u.boff = ((size_t)g * 1024 + pn * 256) * XS_LD * 2; return true; }
};

constexpr int AK_C = 192 * 16 + 16, AK_H = 8 * AK_C, AV_D = 192 * 64 + 64, AV_H = 2 * AV_D, ABUF = AK_H + AV_H;
__device__ __forceinline__ s16x4 vtr(const LAS unsigned char* p) { typedef short v4i16_t __attribute__((ext_vector_type(4))); return __builtin_bit_cast(s16x4, __builtin_amdgcn_ds_read_tr16_b64_v4i16((LAS v4i16_t*)p)); }
__device__ __forceinline__ float swap_max(float v) { auto rr = __builtin_amdgcn_permlane32_swap(__float_as_uint(v), __float_as_uint(v), false, false); return fmaxf(__uint_as_float(rr[0]), __uint_as_float(rr[1])); }
__device__ __forceinline__ float swap_add(float v) { auto rr = __builtin_amdgcn_permlane32_swap(__float_as_uint(v), __float_as_uint(v), false, false); return __uint_as_float(rr[0]) + __uint_as_float(rr[1]); }
struct AUnit { int row0, nkeys, n0, kvh, npass; const bf16_t *kA, *kB, *vA, *vB; };
__device__ __forceinline__ AUnit attn_decode(Fr& F, int unit) {
    AUnit a; const bf16_t* Kb = wsp<bf16_t>(F, WS_KB); const bf16_t* Vb = wsp<bf16_t>(F, WS_VB);
    if (unit < 2048) { const int kvh = unit & 1, bc = unit >> 1, b = bc >> 6, c = bc & 63, nc = c < 2 ? c : 2; const size_t tok0 = (size_t)b * SEQ + 64 * (c - nc);
        a.row0 = b * SEQ + 64 * c; a.nkeys = 64 * (nc + 1); a.n0 = a.nkeys; a.kvh = kvh; a.npass = 2; a.kA = Kb + tok0 * 128 + kvh * 64; a.vA = Vb + tok0 * 128 + kvh * 64; a.kB = a.kA; a.vB = a.vA; }
    else { const int s = unit - 2048, kvh = s & 1, sb = s >> 1; a.row0 = MP + 32 * sb; a.nkeys = 160; a.n0 = 128; a.kvh = kvh; a.npass = 1;
        a.kA = wsp<bf16_t>(F, WS_KC) + (size_t)sb * 128 * 128 + kvh * 64; a.vA = wsp<bf16_t>(F, WS_VC) + (size_t)sb * 128 * 128 + kvh * 64; a.kB = Kb + (size_t)a.row0 * 128 + kvh * 64; a.vB = Vb + (size_t)a.row0 * 128 + kvh * 64; }
    return a;
}
__device__ __forceinline__ void attn_issue(Fr& F, const AUnit& a, LAS unsigned char* buf) {
#pragma unroll
    for (int j = 0; j < 6; ++j) { const int i = F.wave + 8 * j;
        if (i < 24) { const int c8 = i / 3, q = i % 3, k0 = 64 * q;
            if (k0 < a.nkeys) { const bf16_t* src = (k0 < a.n0 ? a.kA + (size_t)(k0 + F.lane) * 128 : a.kB + (size_t)(k0 - a.n0 + F.lane) * 128) + c8 * 8;
                __builtin_amdgcn_global_load_lds((const unsigned*)src, (LAS unsigned*)(buf + c8 * AK_C + q * 1024), 16, 0, 0); } }
        else { const int i2 = i - 24, db = i2 / 12, q = i2 % 12, k0 = 16 * q;
            if (k0 < a.nkeys) { const bf16_t* src = (k0 < a.n0 ? a.vA + (size_t)(k0 + (F.lane >> 2)) * 128 : a.vB + (size_t)(k0 - a.n0 + (F.lane >> 2)) * 128) + db * 32 + (F.lane & 3) * 8;
                __builtin_amdgcn_global_load_lds((const unsigned*)src, (LAS unsigned*)(buf + AK_H + db * AV_D + q * 1024), 16, 0, 0); } }
    }
}
__device__ __forceinline__ void attn_qload(Fr& F, const AUnit& a, bf16x8 (&qf)[4]) {
    const int r32 = F.lane & 31, hi = F.lane >> 5, hq = a.kvh * 4 + (F.wave & 3), pass = F.wave >> 2;
    const bf16_t* qp = wsp<bf16_t>(F, WS_Q) + (size_t)(a.row0 + 32 * (pass < a.npass ? pass : 0) + r32) * 512 + hq * 64 + 8 * hi;
    asm volatile("global_load_dwordx4 %0, %4, off\n\tglobal_load_dwordx4 %1, %4, off offset:32\n\tglobal_load_dwordx4 %2, %4, off offset:64\n\tglobal_load_dwordx4 %3, %4, off offset:96"
                 : "=&v"(qf[0]), "=&v"(qf[1]), "=&v"(qf[2]), "=&v"(qf[3]) : "v"(qp) : "memory");
}
__device__ __forceinline__ void attn_compute(Fr& F, const AUnit& a, const LAS unsigned char* buf, const bf16x8 (&qf)[4], float sinkL, const f32x4 (&gn)[2][4]) {
    const int lane = F.lane, r32 = lane & 31, hi = lane >> 5, hq = a.kvh * 4 + (F.wave & 3), pass = F.wave >> 2;
    if (pass >= a.npass) { asm volatile("s_waitcnt vmcnt(0)" ::: "memory"); return; }
    const int qrow = a.row0 + 32 * pass + r32, nkb = a.nkeys >> 5;
    const LAS unsigned char* kbase = buf + hi * AK_C + r32 * 16;
    const LAS unsigned char* vbase = buf + AK_H + (4 * hi + ((lane & 15) >> 2)) * 64 + ((lane >> 4) & 1) * 32 + (lane & 3) * 8;
    f32x16 P[6];
#pragma unroll
    for (int kb = 0; kb < 6; ++kb) {
        if (kb < nkb) { f32x16 acc = {};
#pragma unroll
            for (int s = 0; s < 4; ++s) { const bf16x8 kf = *(const LAS bf16x8*)(kbase + (2 * s) * AK_C + kb * 512); acc = __builtin_amdgcn_mfma_f32_32x32x16_bf16(kf, qf[s], acc, 0, 0, 0); }
            P[kb] = acc;
        } else {
#pragma unroll
            for (int r = 0; r < 16; ++r) P[kb][r] = -INFINITY; }
    }
    float mx = sinkL;
#pragma unroll
    for (int kb = 0; kb < 6; ++kb)
#pragma unroll
        for (int r = 0; r < 16; ++r) mx = fmaxf(mx, P[kb][r]);
    mx = swap_max(mx);
    float l = 0.f;
#pragma unroll
    for (int kb = 0; kb < 6; ++kb)
#pragma unroll
        for (int r = 0; r < 16; ++r) { const float e = __builtin_amdgcn_exp2f(P[kb][r] - mx); P[kb][r] = e; l += e; }
    l = swap_add(l) + __builtin_amdgcn_exp2f(sinkL - mx);
    f32x16 o0 = {}, o1 = {};
#pragma unroll
    for (int kb = 0; kb < 6; ++kb) {
        if (kb < nkb) {
#pragma unroll
            for (int s2 = 0; s2 < 2; ++s2) {
                u32x4 pw; pw.x = cvtpk(P[kb][8 * s2 + 0], P[kb][8 * s2 + 1]); pw.y = cvtpk(P[kb][8 * s2 + 2], P[kb][8 * s2 + 3]); pw.z = cvtpk(P[kb][8 * s2 + 4], P[kb][8 * s2 + 5]); pw.w = cvtpk(P[kb][8 * s2 + 6], P[kb][8 * s2 + 7]);
                const bf16x8 pb = __builtin_bit_cast(bf16x8, pw);
                const LAS unsigned char* vp = vbase + (32 * kb + 16 * s2) * 64;
                const s16x4 a0l = vtr(vp), a0h = vtr(vp + 512), a1l = vtr(vp + AV_D), a1h = vtr(vp + AV_D + 512);
                const bf16x8 va0 = {a0l[0], a0l[1], a0l[2], a0l[3], a0h[0], a0h[1], a0h[2], a0h[3]}, va1 = {a1l[0], a1l[1], a1l[2], a1l[3], a1h[0], a1h[1], a1h[2], a1h[3]};
                o0 = __builtin_amdgcn_mfma_f32_32x32x16_bf16(va0, pb, o0, 0, 0, 0);
                o1 = __builtin_amdgcn_mfma_f32_32x32x16_bf16(va1, pb, o1, 0, 0, 0);
            }
        }
    }
    const float inv = __builtin_amdgcn_rcpf(l); float ss = 0.f;
#pragma unroll
    for (int r = 0; r < 16; ++r) { o0[r] *= inv; o1[r] *= inv; ss += o0[r] * o0[r] + o1[r] * o1[r]; }
    ss = swap_add(ss);
    asm volatile("s_waitcnt vmcnt(0)" ::: "memory"); __builtin_amdgcn_sched_barrier(0);
    if (hi == 0) wsp<float>(F, WS_SSQA)[(size_t)qrow * 8 + hq] = ss;
    bf16_t* op = wsp<bf16_t>(F, WS_MG) + (size_t)qrow * D + 512 + hq * 64;
#pragma unroll
    for (int db = 0; db < 2; ++db)
#pragma unroll
        for (int r4 = 0; r4 < 4; r4 += 2) { const f32x16& o = db ? o1 : o0; const f32x4 ga = gn[db][r4], gb = gn[db][r4 + 1];
            unsigned ax = cvtpk(o[4 * r4 + 0] * ga[0], o[4 * r4 + 1] * ga[1]), ay = cvtpk(o[4 * r4 + 2] * ga[2], o[4 * r4 + 3] * ga[3]);
            unsigned bx = cvtpk(o[4 * r4 + 4] * gb[0], o[4 * r4 + 5] * gb[1]), by = cvtpk(o[4 * r4 + 6] * gb[2], o[4 * r4 + 7] * gb[3]);
            { auto r = __builtin_amdgcn_permlane32_swap(ax, bx, false, false); ax = r[0]; bx = r[1]; }
            { auto r = __builtin_amdgcn_permlane32_swap(ay, by, false, false); ay = r[0]; by = r[1]; }
            u32x4 pk; pk.x = ax; pk.y = ay; pk.z = bx; pk.w = by;
            *(u32x4*)(op + 32 * db + 8 * r4 + 8 * hi) = pk; }
}
__device__ __forceinline__ void attn_phase(Fr& F, int first, int stride, int last) {
    if (first >= last) return;
    AUnit cur = attn_decode(F, first); attn_issue(F, cur, F.lds);
    bf16x8 qc[4], qn[4]; attn_qload(F, cur, qc);
    const float sinkL = inp(F, 13)[cur.kvh * 4 + (F.wave & 3)] * 1.4426950408889634f;
    f32x4 gn[2][4];
    { const float* gain = inp(F, 24) + (cur.kvh * 4 + (F.wave & 3)) * 64 + 4 * (F.lane >> 5);
#pragma unroll
      for (int db = 0; db < 2; ++db)
#pragma unroll
          for (int r4 = 0; r4 < 4; ++r4) gn[db][r4] = *(const f32x4*)(gain + 32 * db + 8 * r4); }
    asm volatile("s_waitcnt vmcnt(0)" ::: "memory"); __builtin_amdgcn_sched_barrier(0); __syncthreads();
    int par = 0;
    for (int u = first; u < last; u += stride) {
        const bool has_next = u + stride < last; AUnit nxt = cur;
        if (has_next) { nxt = attn_decode(F, u + stride); attn_issue(F, nxt, F.lds + (par ^ 1) * ABUF); attn_qload(F, nxt, qn); }
        attn_compute(F, cur, F.lds + par * ABUF, qc, sinkL, gn);
        asm volatile("s_waitcnt lgkmcnt(0)" ::: "memory"); __builtin_amdgcn_sched_barrier(0); __syncthreads();
        if (has_next) {
#pragma unroll
            for (int s = 0; s < 4; ++s) qc[s] = qn[s]; }
        cur = nxt; par ^= 1;
    }
}

__device__ __forceinline__ void scan_item(Fr& F, int b, int g) {
    const int p = F.lane; const f32x2 L = wsp<f32x2>(F, WS_LAM)[g * 64 + p];
    const float* d0 = wsp<float>(F, WS_DS) + ((size_t)g * 1024 + b * 64) * 128; const float* d1 = d0 + (size_t)32 * 1024 * 128;
    bf16_t* X = wsp<bf16_t>(F, WS_XS) + ((size_t)g * 1024 + b * 64) * XS_LD;
    float hr = 0.f, hi_ = 0.f;
#pragma unroll 32
    for (int c = 0; c < 64; ++c) {
        const float ar = d0[c * 128 + p] + d1[c * 128 + p], ai = d0[c * 128 + 64 + p] + d1[c * 128 + 64 + p];
        X[(size_t)c * XS_LD + p] = (bf16_t)(cvtpk(hr, 0.f) & 0xffffu); X[(size_t)c * XS_LD + 64 + p] = (bf16_t)(cvtpk(hi_, 0.f) & 0xffffu);
        const float nr = L.x * hr - L.y * hi_ + ar, ni = L.x * hi_ + L.y * hr + ai; hr = nr; hi_ = ni;
    }
    *(f32x2*)(outp(F) + O_HP + ((size_t)(b * 32 + g) * 64 + p) * 2) = (f32x2){hr, hi_};
}
__device__ __forceinline__ void sample_s5_item(Fr& F, int item, LAS unsigned char* lds) {
    const int p = F.lane, sb = item >> 5, g = item & 31;
    LAS float* hs = (LAS float*)lds; LAS float* ul = (LAS float*)(lds + 16384); LAS float* Cl = (LAS float*)(lds + 18432);
    const float* us = wsp<float>(F, WS_US) + (size_t)sb * 32 * 512 + g * 16;
    { const int t = p >> 1, h0 = 8 * (p & 1); const f32x4 a = *(const f32x4*)(us + t * 512 + h0), b = *(const f32x4*)(us + t * 512 + h0 + 4); *(LAS f32x4*)(ul + t * 16 + h0) = a; *(LAS f32x4*)(ul + t * 16 + h0 + 4) = b;
      const float* cr = inp(F, 19) + g * 1024; const float* ci = inp(F, 20) + g * 1024;
#pragma unroll
      for (int i = 0; i < 4; ++i) { const int e = 4 * (p + 64 * i), ho = e >> 6, q = e & 63; const f32x4 x = *(const f32x4*)(cr + e), y = *(const f32x4*)(ci + e);
#pragma unroll
          for (int j = 0; j < 4; ++j) { Cl[ho * 129 + q + j] = x[j]; Cl[ho * 129 + 64 + q + j] = y[j]; } } }
    const float are = inp(F, 14)[g * 64 + p], aim = inp(F, 15)[g * 64 + p], dt = __expf(inp(F, 16)[g]);
    const float x1 = are * dt, y1 = aim * dt, ex1 = expm1f(x1), sh = sinf(0.5f * y1), cy = cosf(y1), sy = sinf(y1);
    const float nr = ex1 * cy - 2.f * sh * sh, ni = (ex1 + 1.f) * sy, den = are * are + aim * aim, fr_ = (nr * are + ni * aim) / den, fi_ = (ni * are - nr * aim) / den;
    const float lr = (ex1 + 1.f) * cy, li = (ex1 + 1.f) * sy;
    float bbr[16], bbi[16];
#pragma unroll
    for (int h = 0; h < 16; ++h) { const float br = inp(F, 17)[(g * 64 + p) * 16 + h], bi = inp(F, 18)[(g * 64 + p) * 16 + h]; bbr[h] = fr_ * br - fi_ * bi; bbi[h] = fr_ * bi + fi_ * br; }
    float hr = inp(F, 4)[((sb * 32 + g) * 64 + p) * 2], hi_ = inp(F, 4)[((sb * 32 + g) * 64 + p) * 2 + 1];
    LDS_WAIT(); asm volatile("" ::: "memory");
#pragma unroll 4
    for (int t = 0; t < 32; ++t) {
        const f32x4 u0 = *(const LAS f32x4*)(ul + t * 16), u1 = *(const LAS f32x4*)(ul + t * 16 + 4), u2 = *(const LAS f32x4*)(ul + t * 16 + 8), u3 = *(const LAS f32x4*)(ul + t * 16 + 12);
        const float uu[16] = {u0[0], u0[1], u0[2], u0[3], u1[0], u1[1], u1[2], u1[3], u2[0], u2[1], u2[2], u2[3], u3[0], u3[1], u3[2], u3[3]};
        float sr = 0.f, si = 0.f;
#pragma unroll
        for (int h = 0; h < 16; ++h) { sr += bbr[h] * uu[h]; si += bbi[h] * uu[h]; }
        const float n_r = lr * hr - li * hi_ + sr, n_i = lr * hi_ + li * hr + si; hr = n_r; hi_ = n_i;
        hs[t * 128 + p] = hr; hs[t * 128 + 64 + p] = hi_;
    }
    *(f32x2*)(outp(F) + O_HS + ((size_t)(sb * 32 + g) * 64 + p) * 2) = (f32x2){hr, hi_};
    LDS_WAIT(); asm volatile("" ::: "memory");
    const int ho = p & 15; const float dsk = inp(F, 21)[g * 16 + ho];
    float y[8];
#pragma unroll
    for (int j = 0; j < 8; ++j) y[j] = 0.f;
#pragma unroll 8
    for (int q = 0; q < 64; ++q) { const float cr = Cl[ho * 129 + q], ci = Cl[ho * 129 + 64 + q];
#pragma unroll
        for (int j = 0; j < 8; ++j) { const int t = (p >> 4) + 4 * j; y[j] += cr * hs[t * 128 + q] - ci * hs[t * 128 + 64 + q]; } }
    bf16_t* Gb = wsp<bf16_t>(F, WS_GB);
#pragma unroll
    for (int j = 0; j < 8; ++j) { const int t = (p >> 4) + 4 * j; const float yy = y[j] + dsk * ul[t * 16 + ho]; Gb[((size_t)MP + sb * 32 + t) * 512 + g * 16 + ho] = (bf16_t)(cvtpk(gelu_tanh(yy), 0.f) & 0xffffu); }
    LDS_WAIT(); asm volatile("" ::: "memory");
}
__device__ __forceinline__ void p2_side(Fr& F) {
    const bool samp = F.wave < 2 && F.vcu >= 16 && F.vcu < 16 + DBT * 16;
    if (samp) sample_s5_item(F, 2 * (F.vcu - 16) + F.wave, F.lds + F.wave * 32768);
    else toeplitz_rows16(F, 16 * (F.vcu * 8 + F.wave));
    if (F.vcu >= 144 && F.vcu < 176) { const int k = (F.vcu - 144) * 8 + F.wave; toeplitz_rows16(F, 16 * ((16 + (k >> 1)) * 8 + (k & 1))); }
}

__device__ __forceinline__ f32x4 mtile(Fr& F, const bf16_t* A, int lda, const bf16_t* B0, const bf16_t* B1, int ldb, int nspw, float first_scale, float second_scale = 1.f) {
    const int r32 = F.lane & 31, h = F.lane >> 5;
    f32x16 c0 = {}, c1 = {};
    const bf16_t* ap = A + (size_t)r32 * lda + 8 * h + (size_t)F.wave * nspw * 16; const bf16_t* b0p = B0 + (size_t)r32 * ldb + 8 * h + (size_t)F.wave * nspw * 16; const bf16_t* b1p = B1 + (size_t)r32 * ldb + 8 * h + (size_t)F.wave * nspw * 16;
    for (int s0 = 0; s0 < nspw; s0 += 8) {
        bf16x8 av[8], b0v[8], b1v[8];
#pragma unroll
        for (int s = 0; s < 8; ++s) if (s0 + s < nspw) { av[s] = *(const bf16x8*)(ap + 16 * (s0 + s)); b0v[s] = *(const bf16x8*)(b0p + 16 * (s0 + s)); b1v[s] = *(const bf16x8*)(b1p + 16 * (s0 + s)); }
        __builtin_amdgcn_sched_barrier(0);
#pragma unroll
        for (int s = 0; s < 8; ++s) if (s0 + s < nspw) { c0 = __builtin_amdgcn_mfma_f32_32x32x16_bf16(av[s], b0v[s], c0, 0, 0, 0); c1 = __builtin_amdgcn_mfma_f32_32x32x16_bf16(av[s], b1v[s], c1, 0, 0, 0); }
        __builtin_amdgcn_sched_barrier(0);
    }
    LAS float* part = (LAS float*)F.lds;
#pragma unroll
    for (int r = 0; r < 16; ++r) { part[((F.wave * 2 + 0) * 16 + r) * 64 + F.lane] = c0[r]; part[((F.wave * 2 + 1) * 16 + r) * 64 + F.lane] = c1[r]; }
    LDS_WAIT(); __syncthreads();
    const int row = F.tid >> 4, cg = F.tid & 15, j = cg >> 3, hi = (row >> 2) & 1, r = (row & 3) + 4 * (row >> 3);
    f32x4 lo = {0.f, 0.f, 0.f, 0.f}, hi4 = {0.f, 0.f, 0.f, 0.f};
#pragma unroll
    for (int w = 0; w < 8; ++w) { const f32x4 p = *(const LAS f32x4*)(part + ((w * 2 + j) * 16 + r) * 64 + 32 * hi + 4 * (cg & 7)); if (w < 4) lo += p; else hi4 += p; }
    LDS_WAIT(); __syncthreads();
    return lo * first_scale + hi4 * second_scale;
}
__device__ __forceinline__ float sum16(float v) { v += __shfl_xor(v, 1); v += __shfl_xor(v, 2); v += __shfl_xor(v, 4); v += __shfl_xor(v, 8); return v; }
__device__ __forceinline__ void bias2_tile(Fr& F, int t) {
    const bf16_t* A = wsp<bf16_t>(F, WS_SH2B); const bf16_t* W = wsp<bf16_t>(F, WS_WGU);
    const f32x4 acc = mtile(F, A, D, W + (size_t)(64 * t) * D, W + (size_t)(64 * t + 32) * D, D, 8, 1.f);
    const int r = F.tid >> 4, col = 64 * t + 4 * (F.tid & 15);
    if (r < 24) *(f32x4*)(wsp<float>(F, WS_BIAS2) + (size_t)r * NGU + col) = acc;
}
__device__ __forceinline__ void samp_inproj(Fr& F, unsigned* q) {
    const bf16_t* A = wsp<bf16_t>(F, WS_XB) + (size_t)MP * D; const bf16_t* W = wsp<bf16_t>(F, WS_WIN);
    BTick T{q, 0u};
    for (int t = bt_first(F, T); t < 8 * 20 + NGU / 64; t = bt_take(F, T)) { bt_issue(F, T);
        if (t >= 8 * 20) { bias2_tile(F, t - 8 * 20); } else {
        const int rt = t / 20, ht = t % 20; int n0, n1;
        if (ht < 8) { n0 = 256 * (ht >> 2) + 32 * (ht & 3); n1 = n0 + 128; } else if (ht < 12) { n0 = 512 + 32 * (ht - 8); n1 = n0 + 128; } else { n0 = 768 + 64 * (ht - 12); n1 = n0 + 32; }
        const int rl = F.tid >> 4, cg = F.tid & 15, dim = 4 * cg, row = MP + rt * 32 + rl, mr = NB + rt;
        const int nb = (dim < 32 ? n0 : n1) + (dim & 31);
        const float r1v = wsp<float>(F, WS_R1)[row]; const f32x4 bv = *(const f32x4*)(wsp<float>(F, WS_BIAS1) + (size_t)mr * NIN + nb);
        const f32x4 gnv = *(const f32x4*)((ht < 8 ? inp(F, 11) : inp(F, 12)) + dim);
        const f32x4 acc = mtile(F, A + (size_t)rt * 32 * D, D, W + (size_t)n0 * D, W + (size_t)n1 * D, D, 8, 1.f);
        const f32x4 v = acc * r1v + bv;
        if (ht >= 12) { *(f32x4*)(wsp<float>(F, WS_US) + (size_t)(row - MP) * 512 + 64 * (ht - 12) + dim) = v; continue; }
        if (ht >= 10) { const int kv = ht - 10; u32x2 pk; pk.x = cvtpk(v[0], v[1]); pk.y = cvtpk(v[2], v[3]); *(u32x2*)(wsp<bf16_t>(F, WS_VB) + (size_t)row * 128 + kv * 64 + dim) = pk;
            *(f32x4*)(outp(F) + O_VS + ((size_t)(row - MP) * 2 + kv) * 64 + dim) = v; continue; }
        const float ss = sum16((v[0] * v[0] + v[1] * v[1]) + (v[2] * v[2] + v[3] * v[3])); const float rn = rsqrtf(ss * (1.f / 64.f) + EPS);
        const f32x4 y = v * rn * gnv;
        f32x4 o, pr;
#pragma unroll
        for (int e = 0; e < 4; ++e) pr[e] = __shfl_xor(y[e], 8);
        const float posf = (float)(PAST + rl);
#pragma unroll
        for (int e = 0; e < 4; ++e) { const float ivr = __builtin_amdgcn_exp2f(-(float)((dim & 31) + e) * (13.287712379549449f / 32.f)) * 0.15915494309189535f; const float fr_ = __builtin_amdgcn_fractf(posf * ivr);
            const float cs = __builtin_amdgcn_cosf(fr_), sn = __builtin_amdgcn_sinf(fr_); o[e] = dim < 32 ? y[e] * cs - pr[e] * sn : y[e] * cs + pr[e] * sn; }
        if (ht < 8) { const f32x4 q = o * QSCALE; u32x2 pk; pk.x = cvtpk(q[0], q[1]); pk.y = cvtpk(q[2], q[3]); *(u32x2*)(wsp<bf16_t>(F, WS_Q) + (size_t)row * 512 + ht * 64 + dim) = pk; }
        else { const int kv = ht - 8; u32x2 pk; pk.x = cvtpk(o[0], o[1]); pk.y = cvtpk(o[2], o[3]); *(u32x2*)(wsp<bf16_t>(F, WS_KB) + (size_t)row * 128 + kv * 64 + dim) = pk;
            *(f32x4*)(outp(F) + O_KS + ((size_t)(row - MP) * 2 + kv) * 64 + dim) = o; }
        }
    }
}
__device__ __forceinline__ void samp_glu(Fr& F, unsigned* q) {
    const bf16_t* A = wsp<bf16_t>(F, WS_GB) + (size_t)MP * 512; const bf16_t* W = wsp<bf16_t>(F, WS_WGLU);
    BTick T{q, 0u};
    for (int t = bt_first(F, T); t < 8 * 8; t = bt_take(F, T)) { bt_issue(F, T);
        const int rt = t >> 3, ct = t & 7;
        const int rl = F.tid >> 4, col = 64 * ct + 4 * (F.tid & 15), row = MP + rt * 32 + rl;
        const u32x2 gw = *(const u32x2*)(wsp<bf16_t>(F, WS_GB) + (size_t)row * 512 + col); const f32x4 gbv = *(const f32x4*)(inp(F, 23) + col), gainv = *(const f32x4*)(inp(F, 25) + col);
        const f32x4 acc = mtile(F, A + (size_t)rt * 32 * 512, 512, W + (size_t)(64 * ct) * 512, W + (size_t)(64 * ct + 32) * 512, 512, 4, 1.f);
        const f32x4 g = {bflo(gw.x), bfhi(gw.x), bflo(gw.y), bfhi(gw.y)};
        const f32x4 z = acc + gbv; f32x4 so; float ss = 0.f;
#pragma unroll
        for (int e = 0; e < 4; ++e) { so[e] = g[e] * sigm_f(z[e]); ss += so[e] * so[e]; }
        ss = sum16(ss); if ((F.tid & 15) == 0) wsp<float>(F, WS_SSQ)[(size_t)row * 8 + ct] = ss;
        const f32x4 w = so * gainv; u32x2 pk; pk.x = cvtpk(w[0], w[1]); pk.y = cvtpk(w[2], w[3]); *(u32x2*)(wsp<bf16_t>(F, WS_MG) + (size_t)row * D + col) = pk;
    }
}
__device__ __forceinline__ void samp_outproj(Fr& F, unsigned* q) {
    const bf16_t* A = wsp<bf16_t>(F, WS_MG) + (size_t)MP * D; const bf16_t* W = wsp<bf16_t>(F, WS_WOUT);
    BTick T{q, 0u};
    for (int t = bt_first(F, T); t < 8 * 16; t = bt_take(F, T)) { bt_issue(F, T);
        const int rt = t >> 4, ct = t & 15, rl = F.tid >> 4, col = 64 * ct + 4 * (F.tid & 15), row = MP + rt * 32 + rl, mr = NB + rt;
        const float* sp = wsp<float>(F, WS_SSQ) + (size_t)row * 8; const f32x4 a = *(const f32x4*)sp, b = *(const f32x4*)(sp + 4);
        const float rs = rsqrtf((((a[0] + a[1]) + (a[2] + a[3])) + ((b[0] + b[1]) + (b[2] + b[3]))) * (1.f / 512.f) + EPS);
        const float* md = wsp<float>(F, WS_MOD) + (size_t)mr * NMOD;
        const f32x4 xv = *(const f32x4*)(inp(F, 1) + (size_t)(row - MP) * D + col), g1v = *(const f32x4*)(md + 2 * D + col), w2v = *(const f32x4*)(inp(F, 27) + col) * (1.f + *(const f32x4*)(md + 4 * D + col));
        const float* spa = wsp<float>(F, WS_SSQA) + (size_t)row * 8; const f32x4 a2 = *(const f32x4*)spa, b2 = *(const f32x4*)(spa + 4);
        const float ra = rsqrtf((((a2[0] + a2[1]) + (a2[2] + a2[3])) + ((b2[0] + b2[1]) + (b2[2] + b2[3]))) * (1.f / 512.f) + EPS);
        const f32x4 acc = mtile(F, A + (size_t)rt * 32 * D, D, W + (size_t)(64 * ct) * D, W + (size_t)(64 * ct + 32) * D, D, 8, rs, ra);
        const f32x4 x1 = xv + g1v * acc;
        const float ss = sum16((x1[0] * x1[0] + x1[1] * x1[1]) + (x1[2] * x1[2] + x1[3] * x1[3])); if ((F.tid & 15) == 0) wsp<float>(F, WS_SSQ2)[(size_t)row * 16 + ct] = ss;
        u32x2 pk; pk.x = cvtpk(x1[0], x1[1]); pk.y = cvtpk(x1[2], x1[3]); *(u32x2*)(wsp<bf16_t>(F, WS_X1B) + (size_t)row * D + col) = pk;
        const f32x4 w = x1 * w2v; pk.x = cvtpk(w[0], w[1]); pk.y = cvtpk(w[2], w[3]); *(u32x2*)(wsp<bf16_t>(F, WS_A2) + (size_t)row * D + col) = pk;
    }
}
__device__ __forceinline__ void samp_up(Fr& F, unsigned* q) {
    const bf16_t* A = wsp<bf16_t>(F, WS_A2) + (size_t)MP * D; const bf16_t* W = wsp<bf16_t>(F, WS_WGU);
    BTick T{q, 0u};
    for (int t = bt_first(F, T); t < 8 * 88; t = bt_take(F, T)) { bt_issue(F, T);
        const int rt = t / 88, ft = t % 88, ff0 = 32 * ft, n0 = 256 * (ff0 >> 7) + (ff0 & 127), rl = F.tid >> 4, cg = F.tid & 15, row = MP + rt * 32 + rl, mr = NB + rt;
        const f32x4 bv = *(const f32x4*)(wsp<float>(F, WS_BIAS2) + (size_t)mr * NGU + n0 + (cg < 8 ? 0 : 128) + 4 * (cg & 7));
        const float* sp = wsp<float>(F, WS_SSQ2) + (size_t)row * 16; const f32x4 a = *(const f32x4*)sp, b = *(const f32x4*)(sp + 4), c = *(const f32x4*)(sp + 8), d = *(const f32x4*)(sp + 12);
        const float r2 = rsqrtf(((((a[0] + a[1]) + (a[2] + a[3])) + ((b[0] + b[1]) + (b[2] + b[3]))) + (((c[0] + c[1]) + (c[2] + c[3])) + ((d[0] + d[1]) + (d[2] + d[3])))) * (1.f / D) + EPS);
        const f32x4 acc = mtile(F, A + (size_t)rt * 32 * D, D, W + (size_t)n0 * D, W + (size_t)(n0 + 128) * D, D, 8, 1.f);
        const f32x4 v = acc * r2 + bv;
        f32x4 up;
#pragma unroll
        for (int e = 0; e < 4; ++e) up[e] = __shfl_xor(v[e], 8);
        if (cg < 8) { u32x2 pk; pk.x = cvtpk(silu_f(v[0]) * up[0], silu_f(v[1]) * up[1]); pk.y = cvtpk(silu_f(v[2]) * up[2], silu_f(v[3]) * up[3]); *(u32x2*)(wsp<bf16_t>(F, WS_ACT) + (size_t)row * FF + ff0 + 4 * cg) = pk; }
    }
}
__device__ __forceinline__ void samp_down(Fr& F, unsigned* q) {
    const bf16_t* A = wsp<bf16_t>(F, WS_ACT) + (size_t)MP * FF; const bf16_t* W = wsp<bf16_t>(F, WS_WD);
    BTick T{q, 0u};
    for (int t = bt_first(F, T); t < 8 * 16; t = bt_take(F, T)) { bt_issue(F, T);
        const int rt = t >> 4, ct = t & 15, rl = F.tid >> 4, col = 64 * ct + 4 * (F.tid & 15), row = MP + rt * 32 + rl, mr = NB + rt;
        const u32x2 xw = *(const u32x2*)(wsp<bf16_t>(F, WS_X1B) + (size_t)row * D + col); const f32x4 g2v = *(const f32x4*)(wsp<float>(F, WS_MOD) + (size_t)mr * NMOD + 5 * D + col);
        const f32x4 acc = mtile(F, A + (size_t)rt * 32 * FF, FF, W + (size_t)(64 * ct) * FF, W + (size_t)(64 * ct + 32) * FF, FF, 22, 1.f);
        const f32x4 x1 = {bflo(xw.x), bfhi(xw.x), bflo(xw.y), bfhi(xw.y)};
        *(f32x4*)(outp(F) + (size_t)row * D + col) = x1 + g2v * acc;
    }
}

__device__ __forceinline__ int r2_table_fill(Fr& F, const pg8::StaticOrder& S) {
    pg8::Unit u; int pmin = 1 << 30, pmax = 0;
    for (int i = 0; S.next(i, u); ++i) { pmin = u.pm < pmin ? u.pm : pmin; pmax = u.pm > pmax ? u.pm : pmax; }
    const float* part = wsp<float>(F, WS_SSQ2); LAS float* tab = (LAS float*)(F.lds + R2TAB_OFF);
    for (int j = 0; pmin + 8 * j <= pmax && j < 6; ++j) { const int row = (pmin + 8 * j) * 256 + (F.tid >> 1); const float* p = part + (size_t)row * 16 + 8 * (F.tid & 1);
        const f32x4 a = *(const f32x4*)p, b = *(const f32x4*)(p + 4); float sum = ((a[0] + a[1]) + (a[2] + a[3])) + ((b[0] + b[1]) + (b[2] + b[3])); sum += __shfl_xor(sum, 1);
        if ((F.tid & 1) == 0) tab[j * 256 + (F.tid >> 1)] = rsqrtf(sum * (1.f / D) + EPS); }
    LDS_WAIT(); __syncthreads();
    return pmin;
}
__device__ __forceinline__ int rsra_table_fill(Fr& F, const pg8::StaticOrder& S) {
    pg8::Unit u; int pmin = 1 << 30, pmax = 0;
    for (int i = 0; S.next(i, u); ++i) { pmin = u.pm < pmin ? u.pm : pmin; pmax = u.pm > pmax ? u.pm : pmax; }
    const float* ps = wsp<float>(F, WS_SSQ); const float* pa = wsp<float>(F, WS_SSQA); LAS float* tab = (LAS float*)(F.lds + R2TAB_OFF);
    for (int j = 0; pmin + 8 * j <= pmax && j < 4; ++j) { const int row = (pmin + 8 * j) * 256 + (F.tid >> 1); const float* p = ((F.tid & 1) ? pa : ps) + (size_t)row * 8;
        const f32x4 a = *(const f32x4*)p, b = *(const f32x4*)(p + 4); const float r = rsqrtf((((a[0] + a[1]) + (a[2] + a[3])) + ((b[0] + b[1]) + (b[2] + b[3]))) * (1.f / 512.f) + EPS);
        const float ra = __shfl_xor(r, 1);
        if ((F.tid & 1) == 0) { tab[j * 512 + (F.tid >> 1)] = r * __builtin_amdgcn_rcpf(ra); tab[j * 512 + 256 + (F.tid >> 1)] = ra; } }
    LDS_WAIT(); __syncthreads();
    return pmin;
}
__global__ void __launch_bounds__(512, 2) mega_fwd(Args args) {
    extern __shared__ __attribute__((aligned(16))) unsigned char lds_raw[];
    Fr F; F.lds = (LAS unsigned char*)lds_raw; F.tid = threadIdx.x; F.lane = F.tid & 63; F.wave = __builtin_amdgcn_readfirstlane(F.tid >> 6);
    F.G = gridDim.x; { const int bx = blockIdx.x; F.vcu = (F.G % 8 == 0) ? (bx % 8) * (F.G / 8) + bx / 8 : bx; }
    volatile LAS unsigned* MISC = (volatile LAS unsigned*)(F.lds + LDSCTL_OFF);
    for (int u = F.tid; u < (LDS_BYTES - LDSCTL_OFF) / 4; u += 512) ((LAS unsigned*)(F.lds + LDSCTL_OFF))[u] = 0u;
    __syncthreads();
    { const unsigned long long* ka = (const unsigned long long*)__builtin_amdgcn_kernarg_segment_ptr(); if (F.tid < 33) ((LAS unsigned long long*)(F.lds + PARAM_OFF))[F.tid] = ka[F.tid]; }
    LDS_WAIT(); __syncthreads();
    unsigned* ctl = wsp<unsigned>(F, WS_CTL);
    XcdBarrier bar = xcd_barrier_post(ctl + CW_BAR, MISC + 8);
    const int bx = (int)blockIdx.x;
#ifdef PROBE_LO
    LAS unsigned long long* tsl = (LAS unsigned long long*)(F.lds + LDSCTL_OFF + 1024); int n_st = 0;
#define STAMP() do { if (F.tid == 0) tsl[n_st] = __builtin_amdgcn_s_memrealtime(); ++n_st; } while (0)
#else
#define STAMP() do {} while (0)
#endif
#define REFRESH() do { int t_ = threadIdx.x; asm volatile("" : "+v"(t_)); F.tid = t_; F.lane = t_ & 63; } while (0)
#ifdef PROBE_BW0
    STAMP();
    REFRESH(); bw_pass<1>(F);
    xcd_barrier(bar);
#endif
    STAMP();
    REFRESH(); p0a(F);
    xcd_barrier(bar); STAMP();
    REFRESH(); p0b(F);
    xcd_barrier(bar); STAMP();
    {
        pg8::Gemm g{wsp<bf16_t>(F, WS_XB), wsp<bf16_t>(F, WS_WIN), D, D, 1}; pg8::StaticOrder S; S.init(MP, NIN, D, D, D, F.G, bx);
        EpiIn E{F};
        pg8::gemm_phase<EpiIn, pg8::StaticOrder>(F.lds, g, S, E);
        REFRESH(); samp_inproj(F, ctl + CW_Q + 64 * 3);
    }
    xcd_barrier(bar); STAMP();
    {
#ifdef PROBE_WHO2
        const unsigned long long w2_t0 = __builtin_amdgcn_s_memrealtime();
#endif
        REFRESH(); P0STAMP(10);
        attn_phase(F, F.vcu, F.G, F.vcu < 2 * DBT ? 2048 + 2 * DBT : 2048); P0STAMP(11);
        pg8::Gemm g{wsp<bf16_t>(F, WS_XS), wsp<bf16_t>(F, WS_BTS), XS_LD, 1024, 0}; StateOrder S{F.vcu}; EpiState E{F};
        pg8::gemm_phase<EpiState, StateOrder>(F.lds, g, S, E); P0STAMP(12);
        REFRESH(); P0STAMP(13);
        P0STAMP(14);
        p2_side(F); P0STAMP(15);
#ifdef PROBE_WHO2
        if (F.lane == 0) { const unsigned d_ = (unsigned)(__builtin_amdgcn_s_memrealtime() - w2_t0); atomicMax(ctl + 12001, (d_ << 12) | (unsigned)(F.vcu * 8 + F.wave)); }
#endif
#ifdef PROBE_SIDE2
        REFRESH(); p2_side(F);
#endif
    }
    xcd_barrier(bar); STAMP();
    {
        REFRESH(); if (F.wave < 4) scan_item(F, 4 * ((F.vcu >> 1) & 3) + F.wave, F.vcu >> 3);
        asm volatile("s_waitcnt vmcnt(0)" ::: "memory"); __syncthreads();
        pg8::Gemm g{wsp<bf16_t>(F, WS_XS), wsp<bf16_t>(F, WS_BTY), XS_LD, XS_LD, 1}; YOrder S{F.vcu}; EpiY E{F};
        pg8::gemm_phase<EpiY, YOrder>(F.lds, g, S, E);
        REFRESH(); samp_glu(F, ctl + CW_Q + 64 * 4);
    }
    xcd_barrier(bar); STAMP();
    {
        pg8::Gemm g{wsp<bf16_t>(F, WS_GB), wsp<bf16_t>(F, WS_WGLU), 512, 512, 1}; pg8::StaticOrder S; S.init(MP, 512, 512, 512, 512, F.G, bx);
        EpiGlu E{F};
        pg8::gemm_phase<EpiGlu, pg8::StaticOrder>(F.lds, g, S, E);
        REFRESH(); samp_outproj(F, ctl + CW_Q + 64 * 5);
    }
    xcd_barrier(bar); STAMP();
    {
        pg8::Gemm g{wsp<bf16_t>(F, WS_MG), wsp<bf16_t>(F, WS_WOUT), D, D, 1}; pg8::StaticOrder S; S.init(MP, D, D, D, D, F.G, bx);
        REFRESH(); EpiOut E{F, rsra_table_fill(F, S)};
        pg8::gemm_phase<EpiOut, pg8::StaticOrder>(F.lds, g, S, E);
        REFRESH(); samp_up(F, ctl + CW_Q + 64 * 6);
    }
    xcd_barrier(bar); STAMP();
    {
        pg8::Gemm g{wsp<bf16_t>(F, WS_A2), wsp<bf16_t>(F, WS_WGU), D, D, 1}; pg8::StaticOrder S; S.init(MP, NGU, D, D, D, F.G, bx);
        REFRESH(); EpiUp E{F, r2_table_fill(F, S)};
        pg8::gemm_phase<EpiUp, pg8::StaticOrder>(F.lds, g, S, E);
        REFRESH(); samp_down(F, ctl + CW_Q + 64 * 7);
    }
    xcd_barrier(bar); STAMP();
    {
        pg8::Gemm g{wsp<bf16_t>(F, WS_ACT), wsp<bf16_t>(F, WS_WD), 64, FF, 1, 32768, 16384}; pg8::StaticOrder S; S.init(MP, D, FF, FF, FF, F.G, bx); S.ta = (size_t)(FF / 64) * 32768;
        EpiDown E{F};
        pg8::gemm_phase<EpiDown, pg8::StaticOrder>(F.lds, g, S, E);
    }
    STAMP();
#ifdef PROBE_BW
    xcd_barrier(bar); STAMP();
    REFRESH(); bw_pass<PROBE_BW>(F);
    xcd_barrier(bar); STAMP();
#endif
#ifdef PROBE_WHO2
    if (bx == 0 && F.tid == 0) { const unsigned v = __hip_atomic_load(ctl + 12001, __ATOMIC_RELAXED, __HIP_MEMORY_SCOPE_AGENT); const unsigned long long d = PROBE_WHO2 ? (unsigned long long)(v & 4095u) * 100ull : (unsigned long long)(v >> 12) * 4ull, t0 = __builtin_amdgcn_s_memrealtime();
        while (__builtin_amdgcn_s_memrealtime() - t0 < d) __builtin_amdgcn_s_sleep(8); }
#endif
#ifdef PROBE_WHO
    if (bx == 0 && F.tid == 0) { const unsigned v = __hip_atomic_load(ctl + 12000, __ATOMIC_RELAXED, __HIP_MEMORY_SCOPE_AGENT); const unsigned long long d = PROBE_WHO ? (unsigned long long)(v & 4095u) * 100ull : (unsigned long long)(v >> 12) * 4ull, t0 = __builtin_amdgcn_s_memrealtime();
        while (__builtin_amdgcn_s_memrealtime() - t0 < d) __builtin_amdgcn_s_sleep(8); }
#endif
#ifdef PROBE_LO
    if (bx == PROBE_BX && F.tid == 0) { asm volatile("s_waitcnt lgkmcnt(0)" ::: "memory"); const unsigned long long d = (tsl[PROBE_HI] - tsl[PROBE_LO]) * PROBE_SCALE, t0 = __builtin_amdgcn_s_memrealtime();
        while (__builtin_amdgcn_s_memrealtime() - t0 < d) __builtin_amdgcn_s_sleep(8); }
#endif
}

extern "C" void kernel_launch(void* const* d_in, const int* in_sizes, int n_in, void* d_out, int out_size, void* d_ws, size_t ws_size, hipStream_t stream) {
    static int ready = 0;
    if (ready == 0) {
        ready = -1;
        if (n_in != 31 || ws_size < WS_END) { fprintf(stderr, "kernel_launch: unexpected n_in %d / ws %zu\n", n_in, ws_size); return; }
        int dev = 0, cus = 0;
        if (hipGetDevice(&dev) != hipSuccess || hipDeviceGetAttribute(&cus, hipDeviceAttributeMultiprocessorCount, dev) != hipSuccess) return;
        if (hipFuncSetAttribute((const void*)mega_fwd, hipFuncAttributeMaxDynamicSharedMemorySize, LDS_BYTES) != hipSuccess) { fprintf(stderr, "kernel_launch: hipFuncSetAttribute failed\n"); return; }
        if (cus != 256) fprintf(stderr, "kernel_launch: %d CUs (built for 256)\n", cus);
        (void)hipGetLastError();
        ready = 1;
    }
    if (ready < 0) return;
    (void)hipMemsetAsync((char*)d_ws + WS_CTL, 0, CTL_ZERO_BYTES, stream);
    Args a{};
    for (int i = 0; i < 31; ++i) a.in[i] = (const float*)d_in[i];
    a.out = (float*)d_out; a.ws = (unsigned char*)d_ws;
    hipLaunchKernelGGL(mega_fwd, dim3(256), dim3(512), LDS_BYTES, stream, a);
}
```
